# Optimizing an MI355X kernel written in HIP

```python
import math
import jax, jax.numpy as jnp
from jax import lax
import numpy as np

D_MODEL = 1024
BATCH = 8
SEQ = 2048
DEPTH = 1
DEC_BATCH = 128
DEC_SEQ = 4
PAST_LEN = 16384
PAGE_SIZE = 128

N_META = 16
HG_HEADS = 8
HG_KDIM = 128
HG_VDIM = 128
HG_QK = HG_HEADS * HG_KDIM
HG_V = HG_HEADS * HG_VDIM
HG_CHUNK = 16
SSM_W = 1024
SSM_GROUP = 16
SSM_G = SSM_W // SSM_GROUP
SSM_P = 64
SSM_MIN_RE = -1e-4
STEP_MIN = 0.001
STEP_MAX = 0.1
IN_COLS = 2 * HG_QK + 2 * HG_V + SSM_W + 2 * D_MODEL
PEER_HEADS = 8
PEER_NKEYS = 128
PEER_EXPERTS = PEER_NKEYS * PEER_NKEYS
PEER_DK = 256
PEER_TOPK = 16
PEER_BLOCK = 128
EPS = 1e-6

kernel_name = "hgrn2_s5_peer_hybrid_step"


def rmsnorm(x, w):
    xf = x.astype(jnp.float32)
    y = xf * lax.rsqrt(jnp.mean(xf * xf, axis=-1, keepdims=True) + EPS)
    return (y * w.astype(jnp.float32)).astype(x.dtype)


def hgrn2_scan(q, k, v, lg, s0):
    n, l, h, kd = q.shape
    vd = v.shape[-1]
    c = math.gcd(l, HG_CHUNK)
    nc = l // c

    def to_chunks(a):
        return jnp.moveaxis(a.reshape(n, nc, c, *a.shape[2:]), 1, 0)

    causal = jnp.tril(jnp.ones((c, c), dtype=bool))[None, :, :, None, None]

    def step(s, blk):
        qc, kc, vc, lgc = blk
        b = jnp.cumsum(lgc, axis=1)
        blast = b[:, -1]
        o_inter = jnp.einsum('nthk,nhkv->nthv', qc * jnp.exp(b), s)
        decay = jnp.exp(jnp.where(causal, b[:, :, None] - b[:, None, :], -jnp.inf))
        att = jnp.einsum('nthk,nshk,ntshk->nhts', qc, kc, decay)
        o_intra = jnp.einsum('nhts,nshv->nthv', att, vc)
        s_new = jnp.exp(blast)[..., None] * s + jnp.einsum(
            'nshk,nshv->nhkv', kc * jnp.exp(blast[:, None] - b), vc)
        return s_new, o_inter + o_intra

    s_fin, o = lax.scan(step, s0, (to_chunks(q), to_chunks(k), to_chunks(v), to_chunks(lg)))
    o = jnp.moveaxis(o, 0, 1).reshape(n, l, h, vd)
    return o, s_fin


def s5_scan(u, x0_re, x0_im, a_re, a_im, log_step, b_re, b_im, c_re, c_im, d_skip):
    n, l, _ = u.shape
    f32 = jnp.float32
    ug = u.astype(f32).reshape(n, l, SSM_G, SSM_GROUP)
    lam = lax.complex(jnp.minimum(a_re.astype(f32), SSM_MIN_RE), a_im.astype(f32))
    delta = jnp.exp(log_step.astype(f32))[:, None]
    a_bar = jnp.exp(lam * delta)
    b_bar = ((a_bar - 1.0) / lam)[..., None] * lax.complex(b_re.astype(f32), b_im.astype(f32))
    bu = jnp.einsum('gpc,nlgc->nlgp', b_bar, ug.astype(jnp.complex64))
    x0 = lax.complex(x0_re.astype(f32), x0_im.astype(f32))
    bu = bu.at[:, 0].add(a_bar * x0)
    a_seq = jnp.broadcast_to(a_bar, bu.shape)

    def combine(e1, e2):
        a1, b1 = e1
        a2, b2 = e2
        return a1 * a2, a2 * b1 + b2

    _, xs = lax.associative_scan(combine, (a_seq, bu), axis=1)
    cc = lax.complex(c_re.astype(f32), c_im.astype(f32))
    y = jnp.real(jnp.einsum('gcp,nlgp->nlgc', cc, xs)) + d_skip.astype(f32).reshape(SSM_G, SSM_GROUP) * ug
    x_last = xs[:, -1]
    return y.reshape(n, l, SSM_W), jnp.real(x_last), jnp.imag(x_last)


def peer(h, wq, k1, k2, u_tab, v_tab):
    n, l, d = h.shape
    f32 = jnp.float32
    t = n * l
    nb = -(-t // PEER_BLOCK)
    hf = jnp.pad(h.reshape(t, d), ((0, nb * PEER_BLOCK - t), (0, 0))).reshape(nb, PEER_BLOCK, d)

    def block(xb):
        qry = (xb @ wq).astype(f32).reshape(PEER_BLOCK, PEER_HEADS, 2, PEER_DK // 2)
        s1 = jnp.einsum('thd,hnd->thn', qry[:, :, 0], k1.astype(f32))
        s2 = jnp.einsum('thd,hnd->thn', qry[:, :, 1], k2.astype(f32))
        v1, i1 = lax.top_k(s1, PEER_TOPK)
        v2, i2 = lax.top_k(s2, PEER_TOPK)
        cand = (v1[..., :, None] + v2[..., None, :]).reshape(PEER_BLOCK, PEER_HEADS, PEER_TOPK * PEER_TOPK)
        sc, pos = lax.top_k(cand, PEER_TOPK)
        e1 = jnp.take_along_axis(i1, pos // PEER_TOPK, axis=-1)
        e2 = jnp.take_along_axis(i2, pos % PEER_TOPK, axis=-1)
        expert = e1 * PEER_NKEYS + e2
        gate = jax.nn.softmax(sc, axis=-1)
        act = jax.nn.gelu(jnp.einsum('thkd,td->thk', u_tab[expert].astype(f32), xb.astype(f32)),
                          approximate=False)
        return jnp.einsum('thk,thkd->td', gate * act, v_tab[expert].astype(f32)).astype(h.dtype)

    out = lax.map(block, hf).reshape(nb * PEER_BLOCK, d)[:t]
    return out.reshape(n, l, d)


def layer(x, s_hg, ssm_re, ssm_im, lb, norm1_w, w_in, g_norm_w, ssm_a_re, ssm_a_im, ssm_log_step,
          ssm_b_re, ssm_b_im, ssm_c_re, ssm_c_im, ssm_d, w_glu, b_glu, w_branch_a, w_branch_b, w_out,
          norm2_w, peer_wq, peer_k1, peer_k2, peer_u, peer_v):
    dt = x.dtype
    f32 = jnp.float32
    n, l, _ = x.shape
    h = rmsnorm(x, norm1_w)
    proj = h @ w_in
    sizes = (HG_QK, HG_QK, HG_V, HG_V, SSM_W, D_MODEL, D_MODEL)
    offs = np.cumsum(sizes)[:-1].tolist()
    q, f, i, g, u, ga, gb = jnp.split(proj, offs, axis=-1)
    qh = jax.nn.silu(q.astype(f32)).reshape(n, l, HG_HEADS, HG_KDIM)
    fg = (lb + (1.0 - lb) * jax.nn.sigmoid(f.astype(f32))).reshape(n, l, HG_HEADS, HG_KDIM)
    kh = 1.0 - fg
    lg = jnp.log(fg)
    vh = i.astype(f32).reshape(n, l, HG_HEADS, HG_VDIM)
    o, s_new = hgrn2_scan(qh, kh, vh, lg, s_hg.astype(f32))
    o = rmsnorm(o, g_norm_w) * jax.nn.silu(g.astype(f32)).reshape(n, l, HG_HEADS, HG_VDIM)
    br_a = o.reshape(n, l, HG_V).astype(dt) @ w_branch_a
    y, x_re, x_im = s5_scan(u, ssm_re, ssm_im, ssm_a_re, ssm_a_im, ssm_log_step,
                            ssm_b_re, ssm_b_im, ssm_c_re, ssm_c_im, ssm_d)
    y = jax.nn.gelu(y, approximate=False)
    y = y * jax.nn.sigmoid(y @ w_glu.astype(f32) + b_glu.astype(f32))
    br_b = y.astype(dt) @ w_branch_b
    mixed = jax.nn.sigmoid(ga) * br_a + jax.nn.sigmoid(gb) * br_b
    x = x + mixed @ w_out
    x = x + peer(rmsnorm(x, norm2_w), peer_wq, peer_k1, peer_k2, peer_u, peer_v)
    sd = s_hg.dtype
    return x, s_new.astype(sd), x_re.astype(ssm_re.dtype), x_im.astype(ssm_im.dtype)


def setup_inputs(seed: int = 0) -> dict:
    key = jax.random.key(seed)
    ks = jax.random.split(key, 32)
    f32 = jnp.float32
    nrm = lambda k, shape, s: jax.random.normal(k, shape, f32) * s
    inp = {}
    inp['x_prompt'] = nrm(ks[0], (BATCH, SEQ, D_MODEL), 1.0)
    inp['x_sample'] = nrm(ks[1], (DEC_BATCH, DEC_SEQ, D_MODEL), 1.0)
    inp['state_hgrn'] = nrm(ks[2], (DEPTH, DEC_BATCH, HG_HEADS, HG_KDIM, HG_VDIM), 0.5)
    inp['state_ssm_re'] = nrm(ks[3], (DEPTH, DEC_BATCH, SSM_G, SSM_P), 0.3)
    inp['state_ssm_im'] = nrm(ks[4], (DEPTH, DEC_BATCH, SSM_G, SSM_P), 0.3)
    inp['meta_tokens'] = nrm(ks[5], (N_META, D_MODEL), 1.0)
    inp['lower_bounds'] = nrm(ks[6], (DEPTH + 1, HG_QK), 0.1)
    inp['norm1_w'] = 1.0 + nrm(ks[7], (DEPTH, D_MODEL), 0.01)
    inp['w_in'] = nrm(ks[8], (DEPTH, D_MODEL, IN_COLS), D_MODEL ** -0.5)
    inp['g_norm_w'] = 1.0 + nrm(ks[9], (DEPTH, HG_VDIM), 0.01)
    inp['ssm_a_re'] = -0.5 + nrm(ks[10], (DEPTH, SSM_G, SSM_P), 0.01)
    inp['ssm_a_im'] = jnp.pi * jnp.arange(SSM_P, dtype=f32) + nrm(ks[11], (DEPTH, SSM_G, SSM_P), 0.01)
    inp['ssm_log_step'] = jax.random.uniform(ks[12], (DEPTH, SSM_G), f32,
                                             minval=math.log(STEP_MIN), maxval=math.log(STEP_MAX))
    inp['ssm_b_re'] = nrm(ks[13], (DEPTH, SSM_G, SSM_P, SSM_GROUP), (2.0 * SSM_GROUP) ** -0.5)
    inp['ssm_b_im'] = nrm(ks[14], (DEPTH, SSM_G, SSM_P, SSM_GROUP), (2.0 * SSM_GROUP) ** -0.5)
    inp['ssm_c_re'] = nrm(ks[15], (DEPTH, SSM_G, SSM_GROUP, SSM_P), 0.5)
    inp['ssm_c_im'] = nrm(ks[16], (DEPTH, SSM_G, SSM_GROUP, SSM_P), 0.5)
    inp['ssm_d'] = nrm(ks[17], (DEPTH, SSM_W), 1.0)
    inp['w_glu'] = nrm(ks[18], (DEPTH, SSM_W, SSM_W), SSM_W ** -0.5)
    inp['b_glu'] = nrm(ks[19], (DEPTH, SSM_W), 0.01)
    inp['w_branch_a'] = nrm(ks[20], (DEPTH, HG_V, D_MODEL), HG_V ** -0.5)
    inp['w_branch_b'] = nrm(ks[21], (DEPTH, SSM_W, D_MODEL), SSM_W ** -0.5)
    inp['w_out'] = nrm(ks[22], (DEPTH, D_MODEL, D_MODEL), D_MODEL ** -0.5)
    inp['norm2_w'] = 1.0 + nrm(ks[23], (DEPTH, D_MODEL), 0.01)
    inp['peer_wq'] = nrm(ks[24], (DEPTH, D_MODEL, PEER_HEADS * PEER_DK), D_MODEL ** -0.5)
    inp['peer_k1'] = nrm(ks[25], (DEPTH, PEER_HEADS, PEER_NKEYS, PEER_DK // 2), (PEER_DK // 2) ** -0.5)
    inp['peer_k2'] = nrm(ks[26], (DEPTH, PEER_HEADS, PEER_NKEYS, PEER_DK // 2), (PEER_DK // 2) ** -0.5)
    inp['peer_u'] = nrm(ks[27], (DEPTH, PEER_EXPERTS, D_MODEL), D_MODEL ** -0.5)
    inp['peer_v'] = nrm(ks[28], (DEPTH, PEER_EXPERTS, D_MODEL), 0.5 * PEER_HEADS ** -0.5)
    inp['final_norm_w'] = 1.0 + nrm(ks[29], (D_MODEL,), 0.01)
    return inp


def reference(x_prompt, x_sample, state_hgrn, state_ssm_re, state_ssm_im, meta_tokens, lower_bounds,
              norm1_w, w_in, g_norm_w, ssm_a_re, ssm_a_im, ssm_log_step, ssm_b_re, ssm_b_im,
              ssm_c_re, ssm_c_im, ssm_d, w_glu, b_glu, w_branch_a, w_branch_b, w_out, norm2_w,
              peer_wq, peer_k1, peer_k2, peer_u, peer_v, final_norm_w):
    lb_all = jnp.cumsum(jax.nn.softmax(lower_bounds.astype(jnp.float32), axis=0), axis=0)
    nb = x_prompt.shape[0]
    meta = jnp.broadcast_to(meta_tokens[None].astype(x_prompt.dtype), (nb, N_META, D_MODEL))
    hp = jnp.concatenate([meta, x_prompt], axis=1)
    hs = x_sample
    hg0 = jnp.zeros((nb, HG_HEADS, HG_KDIM, HG_VDIM), state_hgrn.dtype)
    re0 = jnp.zeros((nb, SSM_G, SSM_P), state_ssm_re.dtype)
    im0 = jnp.zeros((nb, SSM_G, SSM_P), state_ssm_im.dtype)
    p_hg, p_re, p_im, s_hg, s_re, s_im = [], [], [], [], [], []
    for li in range(DEPTH):
        params = (norm1_w[li], w_in[li], g_norm_w[li], ssm_a_re[li], ssm_a_im[li], ssm_log_step[li],
                  ssm_b_re[li], ssm_b_im[li], ssm_c_re[li], ssm_c_im[li], ssm_d[li], w_glu[li], b_glu[li],
                  w_branch_a[li], w_branch_b[li], w_out[li], norm2_w[li], peer_wq[li], peer_k1[li],
                  peer_k2[li], peer_u[li], peer_v[li])
        hp, a1, a2, a3 = layer(hp, hg0, re0, im0, lb_all[li], *params)
        hs, b1, b2, b3 = layer(hs, state_hgrn[li], state_ssm_re[li], state_ssm_im[li], lb_all[li], *params)
        p_hg.append(a1); p_re.append(a2); p_im.append(a3)
        s_hg.append(b1); s_re.append(b2); s_im.append(b3)
    y_prompt = rmsnorm(hp[:, N_META:], final_norm_w)
    y_sample = rmsnorm(hs, final_norm_w)
    return (y_prompt, y_sample, jnp.stack(p_hg), jnp.stack(p_re), jnp.stack(p_im),
            jnp.stack(s_hg), jnp.stack(s_re), jnp.stack(s_im))
```

```cpp
#include <hip/hip_runtime.h>
#include <hip/hip_cooperative_groups.h>
#include <cstdio>
namespace cg = cooperative_groups;

#define DI __device__ __forceinline__
typedef unsigned short u16;
typedef short s16x4 __attribute__((ext_vector_type(4)));
typedef short s16x8 __attribute__((ext_vector_type(8)));
typedef float f32x4 __attribute__((ext_vector_type(4)));
typedef __bf16 bf16x2_t __attribute__((ext_vector_type(2)));
typedef float f32x2_t __attribute__((ext_vector_type(2)));

#ifndef SINGLE_LAUNCH
#define SINGLE_LAUNCH 1
#endif

constexpr int T = 17024, TP = 16512, LP = 2064, NCHK = 129;
constexpr float EPS = 1e-6f;
#ifndef ONLY
#define ONLY -1
#endif
constexpr size_t UNIT = (size_t)T * 1024 * 2;
constexpr size_t OFF_WTIN = 0;
constexpr size_t OFF_WTGLU = OFF_WTIN + (size_t)7168 * 1024 * 2;
constexpr size_t OFF_WTA = OFF_WTGLU + 2097152;
constexpr size_t OFF_WTB = OFF_WTA + 2097152;
constexpr size_t OFF_WTOUT = OFF_WTB + 2097152;
constexpr size_t OFF_WTQ = OFF_WTOUT + 2097152;
constexpr size_t OFF_K1 = OFF_WTQ + 4194304;
constexpr size_t OFF_K2 = OFF_K1 + 262144;
constexpr size_t OFF_LB = OFF_K2 + 262144;
constexpr size_t OFF_ABAR = OFF_LB + 4096;
constexpr size_t OFF_APOW = OFF_ABAR + 32768;
constexpr size_t OFF_BBAR = OFF_APOW + 32768;
constexpr size_t OFF_UNITS = OFF_BBAR + 524288;
constexpr size_t OFF_BAR = OFF_UNITS + 8 * ((size_t)17024 * 1024 * 2);
constexpr size_t OOFF_KTT = 0;
constexpr size_t OOFF_DEC = UNIT;
constexpr size_t OOFF_E = OOFF_DEC + (size_t)1032 * 1024 * 4;
constexpr size_t O_YP = 0, O_YS = 16777216, O_HGP = 17301504, O_SRP = 18350080, O_SIP = 18382848,
                 O_HGS = 18415616, O_SRS = 35192832, O_SIS = 35717120;
constexpr int SMEM_BYTES = 65536;

struct P {
  const float *x_prompt, *x_sample, *state_hgrn, *ssm_re, *ssm_im, *meta, *lower_bounds, *norm1_w, *w_in, *g_norm_w,
      *a_re, *a_im, *log_step, *b_re, *b_im, *c_re, *c_im, *ssm_d, *w_glu, *b_glu, *w_a, *w_b, *w_out, *norm2_w,
      *peer_wq, *k1, *k2, *peer_u, *peer_v, *final_w;
  float* out;
  char* ws;
};

DI unsigned pack2(float a, float b) {
  f32x2_t v = {a, b};
  bf16x2_t r = __builtin_convertvector(v, bf16x2_t);
  return __builtin_bit_cast(unsigned, r);
}
DI u16 f2bf(float a) { return (u16)(pack2(a, 0.f) & 0xffffu); }
DI float bf2f(u16 v) { return __uint_as_float(((unsigned)v) << 16); }
DI float bflo(unsigned v) { return __uint_as_float(v << 16); }
DI float bfhi(unsigned v) { return __uint_as_float(v & 0xffff0000u); }
DI f32x4 mfma32(s16x8 a, s16x8 b, f32x4 c) { return __builtin_amdgcn_mfma_f32_16x16x32_bf16(a, b, c, 0, 0, 0); }
DI f32x4 mfma16(s16x4 a, s16x4 b, f32x4 c) { return __builtin_amdgcn_mfma_f32_16x16x16bf16_1k(a, b, c, 0, 0, 0); }
DI float wave_sum(float v) {
#pragma unroll
  for (int o = 32; o >= 1; o >>= 1) v += __shfl_xor(v, o);
  return v;
}
DI float sigmoidf_(float x) { return 1.f / (1.f + __expf(-x)); }
DI float siluf_(float x) { return x / (1.f + __expf(-x)); }
DI float geluf_(float x) { return 0.5f * x * (1.f + erff(x * 0.70710678118654752f)); }
DI s16x4 pack4(f32x4 v) {
  unsigned a = pack2(v[0], v[1]), b = pack2(v[2], v[3]);
  uint2 u = make_uint2(a, b);
  return __builtin_bit_cast(s16x4, u);
}
DI s16x8 pack8(f32x4 x, f32x4 y) {
  uint4 u = make_uint4(pack2(x[0], x[1]), pack2(x[2], x[3]), pack2(y[0], y[1]), pack2(y[2], y[3]));
  return __builtin_bit_cast(s16x8, u);
}
DI u16* unitp(const P& p, int i) { return (u16*)(p.ws + OFF_UNITS + (size_t)i * UNIT); }
DI const float* xrow(const P& p, int tk) {
  if (tk < TP) {
    int n = tk / LP, l = tk - n * LP;
    return l < 16 ? p.meta + (size_t)l * 1024 : p.x_prompt + ((size_t)n * 2048 + (l - 16)) * 1024;
  }
  return p.x_sample + (size_t)(tk - TP) * 1024;
}

DI void gemm_core(const u16* __restrict__ A, int lda, const u16* __restrict__ Bt, int ldb, int K, int brow, int bcol,
                  char* smem, f32x4 (&acc)[4][4]) {
  const int tid = threadIdx.x, wave = tid >> 6, lane = tid & 63, wr = wave >> 1, wc = wave & 1, fr = lane & 15,
            fq = lane >> 4;
  const int r0 = tid >> 3, cj = tid & 7;
  const u16* ga = A + (size_t)(brow + r0) * lda + cj * 8;
  const u16* gb = Bt + (size_t)(bcol + r0) * ldb + cj * 8;
  const size_t sa = (size_t)32 * lda, sb = (size_t)32 * ldb;
  const int woff = r0 * 128 + ((cj ^ ((r0 >> 1) & 7)) << 4);
  uint4 ra[4], rb[4];
#pragma unroll
  for (int i = 0; i < 4; ++i) { ra[i] = *(const uint4*)(ga + i * sa); rb[i] = *(const uint4*)(gb + i * sb); }
#pragma unroll
  for (int i = 0; i < 4; ++i) {
    *(uint4*)(smem + woff + i * 4096) = ra[i];
    *(uint4*)(smem + 16384 + woff + i * 4096) = rb[i];
  }
  __syncthreads();
  const int arow = wr * 64 + fr, brow_l = wc * 64 + fr;
  const int sw = (fr >> 1) & 7;
  const int nk = K >> 6;
  for (int kt = 0; kt < nk; ++kt) {
    const int s = kt & 1;
    if (kt + 1 < nk) {
#pragma unroll
      for (int i = 0; i < 4; ++i) {
        ra[i] = *(const uint4*)(ga + i * sa + (kt + 1) * 64);
        rb[i] = *(const uint4*)(gb + i * sb + (kt + 1) * 64);
      }
    }
    const char* a = smem + s * 32768;
    const char* b = a + 16384;
#pragma unroll
    for (int ks = 0; ks < 2; ++ks) {
      s16x8 af[4], bfr[4];
      const int co = (((ks * 4 + fq) ^ sw) << 4);
#pragma unroll
      for (int m = 0; m < 4; ++m) af[m] = *(const s16x8*)(a + (arow + m * 16) * 128 + co);
#pragma unroll
      for (int n = 0; n < 4; ++n) bfr[n] = *(const s16x8*)(b + (brow_l + n * 16) * 128 + co);
#pragma unroll
      for (int m = 0; m < 4; ++m)
#pragma unroll
        for (int n = 0; n < 4; ++n) acc[m][n] = mfma32(af[m], bfr[n], acc[m][n]);
    }
    if (kt + 1 < nk) {
      char* a2 = smem + (s ^ 1) * 32768;
#pragma unroll
      for (int i = 0; i < 4; ++i) {
        *(uint4*)(a2 + woff + i * 4096) = ra[i];
        *(uint4*)(a2 + 16384 + woff + i * 4096) = rb[i];
      }
    }
    __syncthreads();
  }
  asm volatile("s_nop 15\n\ts_nop 15" : "+v"(acc[0][0]), "+v"(acc[0][1]), "+v"(acc[0][2]), "+v"(acc[0][3]), "+v"(acc[1][0]), "+v"(acc[1][1]), "+v"(acc[1][2]), "+v"(acc[1][3]), "+v"(acc[2][0]), "+v"(acc[2][1]), "+v"(acc[2][2]), "+v"(acc[2][3]), "+v"(acc[3][0]), "+v"(acc[3][1]), "+v"(acc[3][2]), "+v"(acc[3][3]));
}
#define ZERO_ACC(acc)                              \
  _Pragma("unroll") for (int m = 0; m < 4; ++m)    \
  _Pragma("unroll") for (int n = 0; n < 4; ++n) acc[m][n] = f32x4{0.f, 0.f, 0.f, 0.f};
#define EPI_VARS                                                                                             \
  const int tid = threadIdx.x, wave = tid >> 6, lane = tid & 63, wr = wave >> 1, wc = wave & 1, fr = lane & 15, \
            fq = lane >> 4;
#define EPI_BASE(ld, rb, cbv)                                    \
  int tb_ = (wr * 64 + fq * 4) * (ld) + wc * 64 + fr;           \
  asm volatile("" : "+v"(tb_));                                 \
  const int idx0 = (rb) * (ld) + (cbv) + tb_;
#define EPI_LOOP                                 \
  _Pragma("unroll") for (int m = 0; m < 4; ++m)  \
  _Pragma("unroll") for (int n = 0; n < 4; ++n)

DI void p0_transpose(const float* __restrict__ W, int K, int N, u16* __restrict__ Wt, int tile, char* smem) {
  float* sm = (float*)smem;
  const int ntn = N >> 6;
  const int tk = tile / ntn, tn = tile - tk * ntn;
  const int tid = threadIdx.x;
  const int c = tid & 63, r0 = tid >> 6;
#pragma unroll
  for (int i = 0; i < 16; ++i) {
    int r = r0 + i * 4;
    sm[r * 65 + c] = W[(size_t)(tk * 64 + r) * N + tn * 64 + c];
  }
  __syncthreads();
  const int n = tid >> 2, ks = (tid & 3) * 16;
  unsigned o[8];
#pragma unroll
  for (int i = 0; i < 8; ++i) o[i] = pack2(sm[(ks + 2 * i) * 65 + n], sm[(ks + 2 * i + 1) * 65 + n]);
  uint4* dst = (uint4*)(Wt + (size_t)(tn * 64 + n) * K + tk * 64 + ks);
  dst[0] = make_uint4(o[0], o[1], o[2], o[3]);
  dst[1] = make_uint4(o[4], o[5], o[6], o[7]);
  __syncthreads();
}

DI void p0_convert(const float* __restrict__ src, u16* __restrict__ dst, int job) {
  size_t i = (size_t)job * 2048 + threadIdx.x * 8;
  float4 a = *(const float4*)(src + i), b = *(const float4*)(src + i + 4);
  *(uint4*)(dst + i) = make_uint4(pack2(a.x, a.y), pack2(a.z, a.w), pack2(b.x, b.y), pack2(b.z, b.w));
}

DI void p0_lb(const P& p) {
  float* LB = (float*)(p.ws + OFF_LB);
  for (int c = threadIdx.x; c < 1024; c += 256) {
    float a = p.lower_bounds[c], b = p.lower_bounds[1024 + c];
    LB[c] = 1.f / (1.f + expf(b - a));
  }
}

DI void p0_s5const(const P& p, int job) {
  int idx = job * 256 + threadIdx.x;
  int g = idx >> 6;
  float re = fminf(p.a_re[idx], -1e-4f), im = p.a_im[idx];
  float dl = expf(p.log_step[g]);
  float mag = expf(re * dl);
  float sn, cs;
  sincosf(im * dl, &sn, &cs);
  float ax = mag * cs, ay = mag * sn;
  float nx = ax - 1.f, ny = ay;
  float d2 = re * re + im * im;
  float cr = (nx * re + ny * im) / d2, ci = (ny * re - nx * im) / d2;
  float2* ABAR = (float2*)(p.ws + OFF_ABAR);
  float2* APOW = (float2*)(p.ws + OFF_APOW);
  float2* BBAR = (float2*)(p.ws + OFF_BBAR);
  ABAR[idx] = make_float2(ax, ay);
  float x = ax, y = ay, x16 = 0.f, y16 = 0.f;
#pragma unroll
  for (int i = 0; i < 5; ++i) {
    float nx2 = x * x - y * y, ny2 = 2.f * x * y;
    x = nx2; y = ny2;
    if (i == 3) { x16 = x; y16 = y; }
  }
  APOW[idx] = make_float2(x * x16 - y * y16, x * y16 + y * x16);
#pragma unroll
  for (int c = 0; c < 16; ++c) {
    float br = p.b_re[idx * 16 + c], bi = p.b_im[idx * 16 + c];
    BBAR[idx * 16 + c] = make_float2(cr * br - ci * bi, cr * bi + ci * br);
  }
}

DI void rms_row_to_bf16(const float* __restrict__ src, const float* __restrict__ w, u16* __restrict__ dst, int lane) {
  float4 v[4];
  float ss = 0.f;
#pragma unroll
  for (int i = 0; i < 4; ++i) {
    v[i] = *(const float4*)(src + i * 256 + lane * 4);
    ss += v[i].x * v[i].x + v[i].y * v[i].y + v[i].z * v[i].z + v[i].w * v[i].w;
  }
  ss = wave_sum(ss);
  float rs = rsqrtf(ss * (1.f / 1024.f) + EPS);
#pragma unroll
  for (int i = 0; i < 4; ++i) {
    float4 ww = *(const float4*)(w + i * 256 + lane * 4);
    uint2 o = make_uint2(pack2(v[i].x * rs * ww.x, v[i].y * rs * ww.y), pack2(v[i].z * rs * ww.z, v[i].w * rs * ww.w));
    *(uint2*)(dst + i * 256 + lane * 4) = o;
  }
}

DI void phase0(const P& p, int job, char* smem) {
  if (job < 1792) p0_transpose(p.w_in, 1024, 7168, (u16*)(p.ws + OFF_WTIN), job, smem);
  else if (job < 2048) p0_transpose(p.w_glu, 1024, 1024, (u16*)(p.ws + OFF_WTGLU), job - 1792, smem);
  else if (job < 2304) p0_transpose(p.w_a, 1024, 1024, (u16*)(p.ws + OFF_WTA), job - 2048, smem);
  else if (job < 2560) p0_transpose(p.w_b, 1024, 1024, (u16*)(p.ws + OFF_WTB), job - 2304, smem);
  else if (job < 2816) p0_transpose(p.w_out, 1024, 1024, (u16*)(p.ws + OFF_WTOUT), job - 2560, smem);
  else if (job < 3328) p0_transpose(p.peer_wq, 1024, 2048, (u16*)(p.ws + OFF_WTQ), job - 2816, smem);
  else if (job < 3392) p0_convert(p.k1, (u16*)(p.ws + OFF_K1), job - 3328);
  else if (job < 3456) p0_convert(p.k2, (u16*)(p.ws + OFF_K2), job - 3392);
  else if (job == 3456) p0_lb(p);
  else if (job < 3473) p0_s5const(p, job - 3457);
  else {
    int tk = (job - 3473) * 4 + (threadIdx.x >> 6);
    rms_row_to_bf16(xrow(p, tk), p.norm1_w, unitp(p, 0) + (size_t)tk * 1024, threadIdx.x & 63);
  }
}
constexpr int NJ0 = 3473 + T / 4;

DI void phase1(const P& p, int job, char* smem) {
  const int pm = job / 56, pn = job - pm * 56;
  const int brow = pm * 128, bcol = pn * 128;
  f32x4 acc[4][4];
  ZERO_ACC(acc);
  gemm_core(unitp(p, 0), 1024, (const u16*)(p.ws + OFF_WTIN), 1024, 1024, brow, bcol, smem, acc);
  EPI_VARS;
  const int region = pn >> 3;
  const int cbase = bcol - region * 1024;
  if (region == 2) {
    u16* VT = unitp(p, 3);
    int vb = ((brow >> 4) + wr * 4) * 16384 + (cbase + wc * 64 + fr) * 16 + fq * 4;
    asm volatile("" : "+v"(vb));
    EPI_LOOP { *(s16x4*)(VT + vb + m * 16384 + n * 256) = pack4(acc[m][n]); }
  } else {
    u16* dst = unitp(p, region == 0 ? 1 : region == 1 ? 2 : region + 1);
    EPI_BASE(1024, brow, cbase);
    EPI_LOOP {
#pragma unroll
      for (int j = 0; j < 4; ++j) {
        float v = acc[m][n][j];
        if (region == 0 || region == 3) v = siluf_(v);
        else if (region >= 5) v = sigmoidf_(v);
        dst[idx0 + (m * 16 + j) * 1024 + n * 16] = f2bf(v);
      }
    }
  }
}
constexpr int NJ1 = 133 * 56;

DI void p2_hgrn_pre(const P& p, int job, char* smem) {
  const int tid = threadIdx.x, wave = tid >> 6, lane = tid & 63, fr = lane & 15, fq = lane >> 4;
  const int chunk = job >> 1, h = (job & 1) * 4 + wave;
  const int tok0 = chunk * 16;
  u16* R1 = unitp(p, 1);
  const u16* R2 = unitp(p, 2);
  const u16* VT = unitp(p, 3);
  u16* OIN = unitp(p, 0);
  u16* KTT = (u16*)((char*)p.out + OOFF_KTT);
  float* DEC = (float*)((char*)p.out + OOFF_DEC);
  const float* LB = (const float*)(p.ws + OFF_LB);
  char* sq = smem + wave * 8704;
  char* sk = sq + 4352;
  const int c0 = h * 128 + lane * 2;
  const float lb0 = LB[c0], lb1 = LB[c0 + 1];
  float b0 = 0.f, b1 = 0.f;
  float kn0[16], kn1[16];
#pragma unroll
  for (int t = 0; t < 16; ++t) {
    size_t gi = (size_t)(tok0 + t) * 1024 + c0;
    unsigned q2 = *(const unsigned*)(R1 + gi), f2 = *(const unsigned*)(R2 + gi);
    float f0 = bflo(f2), f1 = bfhi(f2);
    float e0 = __expf(-f0), e1 = __expf(-f1);
    float fg0 = lb0 + (1.f - lb0) / (1.f + e0), fg1 = lb1 + (1.f - lb1) / (1.f + e1);
    float k0 = (1.f - lb0) * e0 / (1.f + e0), k1 = (1.f - lb1) * e1 / (1.f + e1);
    b0 += __logf(fg0);
    b1 += __logf(fg1);
    float qt0 = bflo(q2) * __expf(b0), qt1 = bfhi(q2) * __expf(b1);
    kn0[t] = k0 * __expf(-b0);
    kn1[t] = k1 * __expf(-b1);
    unsigned qp = pack2(qt0, qt1);
    *(unsigned*)(R1 + gi) = qp;
    *(unsigned*)(sq + t * 272 + lane * 4) = qp;
    *(unsigned*)(sk + t * 272 + lane * 4) = pack2(kn0[t], kn1[t]);
  }
  const float eb0 = __expf(b0), eb1 = __expf(b1);
  *(float2*)(DEC + (size_t)chunk * 1024 + c0) = make_float2(eb0, eb1);
  {
    unsigned w0[8], w1[8];
#pragma unroll
    for (int i = 0; i < 8; ++i) {
      w0[i] = pack2(kn0[2 * i] * eb0, kn0[2 * i + 1] * eb0);
      w1[i] = pack2(kn1[2 * i] * eb1, kn1[2 * i + 1] * eb1);
    }
    uint4* kd = (uint4*)(KTT + ((size_t)chunk * 1024 + c0) * 16);
    kd[0] = make_uint4(w0[0], w0[1], w0[2], w0[3]);
    kd[1] = make_uint4(w0[4], w0[5], w0[6], w0[7]);
    kd[2] = make_uint4(w1[0], w1[1], w1[2], w1[3]);
    kd[3] = make_uint4(w1[4], w1[5], w1[6], w1[7]);
  }
  __syncthreads();
  f32x4 at = {0.f, 0.f, 0.f, 0.f};
#pragma unroll
  for (int ks = 0; ks < 4; ++ks) {
    s16x8 a = *(const s16x8*)(sk + fr * 272 + ks * 64 + fq * 16);
    s16x8 b = *(const s16x8*)(sq + fr * 272 + ks * 64 + fq * 16);
    at = mfma32(a, b, at);
  }
  asm volatile("s_nop 15\n\ts_nop 15" : "+v"(at));
#pragma unroll
  for (int j = 0; j < 4; ++j)
    if (4 * fq + j > fr) at[j] = 0.f;
  s16x4 af = pack4(at);
  asm volatile("s_nop 7" : "+v"(af));
#pragma unroll
  for (int nt = 0; nt < 8; ++nt) {
    size_t vi = ((size_t)chunk * 1024 + h * 128 + nt * 16 + fr) * 16 + 4 * fq;
    s16x4 vb = *(const s16x4*)(VT + vi);
    f32x4 o = mfma16(af, vb, f32x4{0.f, 0.f, 0.f, 0.f});
    asm volatile("s_nop 15\n\ts_nop 15" : "+v"(o));
    *(s16x4*)(OIN + vi) = pack4(o);
  }
  __syncthreads();
}

DI void s5_load_bbar(const P& p, int g, int pp, float (&br)[16], float (&bi)[16]) {
  const float4* B = (const float4*)((const float2*)(p.ws + OFF_BBAR) + ((size_t)g * 64 + pp) * 16);
#pragma unroll
  for (int i = 0; i < 8; ++i) {
    float4 v = B[i];
    br[2 * i] = v.x; bi[2 * i] = v.y; br[2 * i + 1] = v.z; bi[2 * i + 1] = v.w;
  }
}
DI void s5_step(const uint4& ua, const uint4& ub, int t, const float (&br)[16], const float (&bi)[16], float ax, float ay,
                float& xr, float& xi) {
  unsigned uu[8] = {(unsigned)__builtin_amdgcn_readlane((int)ua.x, t), (unsigned)__builtin_amdgcn_readlane((int)ua.y, t),
                    (unsigned)__builtin_amdgcn_readlane((int)ua.z, t), (unsigned)__builtin_amdgcn_readlane((int)ua.w, t),
                    (unsigned)__builtin_amdgcn_readlane((int)ub.x, t), (unsigned)__builtin_amdgcn_readlane((int)ub.y, t),
                    (unsigned)__builtin_amdgcn_readlane((int)ub.z, t), (unsigned)__builtin_amdgcn_readlane((int)ub.w, t)};
  float sr = 0.f, si = 0.f;
#pragma unroll
  for (int i = 0; i < 8; ++i) {
    float a = bflo(uu[i]), b = bfhi(uu[i]);
    sr += br[2 * i] * a + br[2 * i + 1] * b;
    si += bi[2 * i] * a + bi[2 * i + 1] * b;
  }
  float nr = ax * xr - ay * xi + sr, ni = ax * xi + ay * xr + si;
  xr = nr; xi = ni;
}

DI void p2_s5a(const P& p, int job) {
  const int gq = job & 15, nc = job >> 4;
  const int n = nc / 43, c = nc - n * 43;
  const int tid = threadIdx.x, g = gq * 4 + (tid >> 6), pp = tid & 63;
  float br[16], bi[16];
  s5_load_bbar(p, g, pp, br, bi);
  const float2 ab = ((const float2*)(p.ws + OFF_ABAR))[g * 64 + pp];
  const u16* U = unitp(p, 5) + (size_t)(n * LP + c * 48) * 1024 + g * 16;
  float xr = 0.f, xi = 0.f;
  uint4 ua, ub;
  {
    const u16* r = U + (size_t)min(pp, 47) * 1024;
    ua = *(const uint4*)r;
    ub = *(const uint4*)(r + 8);
  }
#pragma unroll 4
  for (int t = 0; t < 48; ++t) s5_step(ua, ub, t, br, bi, ab.x, ab.y, xr, xi);
  float2* E = (float2*)((char*)p.out + OOFF_E);
  E[((size_t)(n * 43 + c) * 64 + g) * 64 + pp] = make_float2(xr, xi);
}
constexpr int NJ2_H = 2064, NJ2_S = 8 * 43 * 16;
constexpr int NJ2 = NJ2_H + NJ2_S;

#define SEQ_GLOAD(cg_, P)                                                                              \
  {                                                                                                    \
    const int cgv = (cg_);                                                                             \
    P##rq = *(const uint4*)(QT + (size_t)(cgv * 16 + (tid >> 4)) * 1024 + h * 128 + (tid & 15) * 8);  \
    P##rk = *(const uint4*)(KTT + ((size_t)cgv * 1024 + h * 128) * 16 + tid * 8);                      \
    if (tid < 32) P##rd = *(const float4*)(DEC + (size_t)cgv * 1024 + h * 128 + tid * 4);              \
    size_t vi0 = ((size_t)cgv * 1024 + h * 128 + wave * 32 + fr) * 16 + 4 * fq;                        \
    P##rv0 = *(const s16x4*)(VT + vi0);                                                                \
    P##rv1 = *(const s16x4*)(VT + vi0 + 256);                                                          \
    P##ro0 = *(const s16x4*)(OIN + vi0);                                                               \
    P##ro1 = *(const s16x4*)(OIN + vi0 + 256);                                                         \
  }
#define SEQ_LSTORE(b_, P)                                                  \
  {                                                                        \
    char* lb_ = smem + (b_) * 8960;                                        \
    *(uint4*)(lb_ + (tid >> 4) * 272 + (tid & 15) * 16) = P##rq;           \
    *(uint4*)(lb_ + 4352 + tid * 16) = P##rk;                              \
    if (tid < 32) *(float4*)(lb_ + 8448 + tid * 16) = P##rd;               \
  }
#define SEQ_BODY(c_, X, Y)                                                                                   \
  {                                                                                                          \
    const int c = (c_);                                                                                      \
    const int b = c & 1;                                                                                     \
    const int tok0 = (cg0 + c) * 16;                                                                         \
    if (c + 2 < NCHK) SEQ_GLOAD(cg0 + c + 2, X)                                                              \
    const char* base = smem + b * 8960;                                                                      \
    f32x4 o0 = f32x4{0.f, 0.f, 0.f, 0.f}, o1 = f32x4{0.f, 0.f, 0.f, 0.f};                                    \
    _Pragma("unroll") for (int ks = 0; ks < 4; ++ks) {                                                       \
      s16x4 qa = *(const s16x4*)(base + fr * 272 + (ks * 32 + 4 * fq) * 2);                                  \
      s16x4 qb = *(const s16x4*)(base + fr * 272 + (ks * 32 + 16 + 4 * fq) * 2);                             \
      s16x8 Af = __builtin_shufflevector(qa, qb, 0, 1, 2, 3, 4, 5, 6, 7);                                    \
      s16x8 B0 = pack8(S[2 * ks][0], S[2 * ks + 1][0]), B1 = pack8(S[2 * ks][1], S[2 * ks + 1][1]);          \
      asm volatile("s_nop 7" : "+v"(B0), "+v"(B1), "+v"(Af));                                                \
      o0 = mfma32(Af, B0, o0);                                                                               \
      o1 = mfma32(Af, B1, o1);                                                                               \
    }                                                                                                        \
    asm volatile("s_nop 15\n\ts_nop 15" : "+v"(o0), "+v"(o1));                                               \
    _Pragma("unroll") for (int j = 0; j < 4; ++j) {                                                          \
      u16* orow = ORAW + (size_t)(tok0 + 4 * fq + j) * 1024 + h * 128 + wave * 32 + fr;                      \
      orow[0] = f2bf(o0[j] + bf2f((u16)co0[j]));                                                             \
      orow[16] = f2bf(o1[j] + bf2f((u16)co1[j]));                                                            \
    }                                                                                                        \
    _Pragma("unroll") for (int mt = 0; mt < 8; ++mt) {                                                       \
      f32x4 d = *(const f32x4*)(base + 8448 + (mt * 16 + 4 * fq) * 4);                                       \
      s16x4 ka = *(const s16x4*)(base + 4352 + (mt * 16 + fr) * 32 + fq * 8);                                \
      f32x4 s0 = S[mt][0] * d, s1 = S[mt][1] * d;                                                            \
      asm volatile("s_nop 7" : "+v"(s0), "+v"(s1), "+v"(ka));                                                \
      S[mt][0] = mfma16(ka, cv0, s0);                                                                        \
      S[mt][1] = mfma16(ka, cv1, s1);                                                                        \
    }                                                                                                        \
    asm volatile("s_nop 15\n\ts_nop 15" : "+v"(S[0][0]), "+v"(S[0][1]), "+v"(S[1][0]), "+v"(S[1][1]), "+v"(S[2][0]), "+v"(S[2][1]), "+v"(S[3][0]), "+v"(S[3][1]), "+v"(S[4][0]), "+v"(S[4][1]), "+v"(S[5][0]), "+v"(S[5][1]), "+v"(S[6][0]), "+v"(S[6][1]), "+v"(S[7][0]), "+v"(S[7][1])); \
    if (c + 1 < NCHK) SEQ_LSTORE(b ^ 1, Y)                                                                   \
    asm volatile("s_waitcnt lgkmcnt(0)\n\ts_barrier" ::: "memory");                                         \
    if (c + 1 < NCHK) { cv0 = Y##rv0; cv1 = Y##rv1; co0 = Y##ro0; co1 = Y##ro1; }                            \
  }
DI void p3_hgrn_seq(const P& p, int job, char* smem) {
  const int tid = threadIdx.x, wave = tid >> 6, lane = tid & 63, fr = lane & 15, fq = lane >> 4;
  const int n = job >> 3, h = job & 7;
  const u16* QT = unitp(p, 1);
  const u16* KTT = (const u16*)((const char*)p.out + OOFF_KTT);
  const float* DEC = (const float*)((const char*)p.out + OOFF_DEC);
  const u16* VT = unitp(p, 3);
  const u16* OIN = unitp(p, 0);
  u16* ORAW = unitp(p, 2);
  f32x4 S[8][2];
#pragma unroll
  for (int mt = 0; mt < 8; ++mt) { S[mt][0] = f32x4{0.f, 0.f, 0.f, 0.f}; S[mt][1] = f32x4{0.f, 0.f, 0.f, 0.f}; }
  const int cg0 = n * NCHK;
  uint4 Arq, Ark, Brq, Brk;
  float4 Ard = make_float4(0.f, 0.f, 0.f, 0.f), Brd = make_float4(0.f, 0.f, 0.f, 0.f);
  s16x4 Arv0, Arv1, Aro0, Aro1, Brv0, Brv1, Bro0, Bro1, cv0, cv1, co0, co1;
  SEQ_GLOAD(cg0, A)
  SEQ_LSTORE(0, A)
  cv0 = Arv0; cv1 = Arv1; co0 = Aro0; co1 = Aro1;
  SEQ_GLOAD(cg0 + 1, B)
  __syncthreads();
  for (int cc = 0; cc < NCHK - 1; cc += 2) {
    SEQ_BODY(cc, A, B)
    SEQ_BODY(cc + 1, B, A)
  }
  SEQ_BODY(NCHK - 1, A, B)
  float* HG = p.out + O_HGP + ((size_t)(n * 8 + h) * 128) * 128;
#pragma unroll
  for (int mt = 0; mt < 8; ++mt)
#pragma unroll
    for (int nt = 0; nt < 2; ++nt)
#pragma unroll
      for (int j = 0; j < 4; ++j) HG[(size_t)(mt * 16 + 4 * fq + j) * 128 + wave * 32 + nt * 16 + fr] = S[mt][nt][j];
}

DI void p3_hgrn_sample(const P& p, int job, char* smem) {
  const int tid = threadIdx.x;
  const int ns = job >> 3, h = job & 7;
  const int v = tid & 127, kh = tid >> 7;
  const u16* R1 = unitp(p, 1);
  const u16* R2 = unitp(p, 2 + 0);
  const u16* VT = unitp(p, 3);
  u16* ORAW = unitp(p, 2);
  const float* LB = (const float*)(p.ws + OFF_LB);
  float* sg = (float*)smem;
  float* skk = sg + 512;
  float* sq = skk + 512;
  float* so = sq + 512;
  const int tokb = TP + ns * 4;
  float fraw[4];
  if (tid < 128) {
    const float lb = LB[h * 128 + tid];
#pragma unroll
    for (int t = 0; t < 4; ++t) {
      size_t gi = (size_t)(tokb + t) * 1024 + h * 128 + tid;
      float f = bf2f(R2[gi]);
      fraw[t] = f;
      float e = __expf(-f);
      sg[t * 128 + tid] = lb + (1.f - lb) / (1.f + e);
      skk[t * 128 + tid] = (1.f - lb) * e / (1.f + e);
      sq[t * 128 + tid] = bf2f(R1[gi]);
    }
  }
  (void)fraw;
  float S[64];
  const float* st = p.state_hgrn + ((size_t)(ns * 8 + h) * 128 + kh * 64) * 128 + v;
#pragma unroll
  for (int i = 0; i < 64; ++i) S[i] = st[(size_t)i * 128];
  float vt[4];
#pragma unroll
  for (int t = 0; t < 4; ++t) {
    int tok = tokb + t;
    vt[t] = bf2f(VT[((size_t)(tok >> 4) * 1024 + h * 128 + v) * 16 + (tok & 15)]);
  }
  __syncthreads();
#pragma unroll
  for (int t = 0; t < 4; ++t) {
    float op = 0.f;
#pragma unroll
    for (int i = 0; i < 64; ++i) {
      int k = t * 128 + kh * 64 + i;
      S[i] = sg[k] * S[i] + skk[k] * vt[t];
      op += sq[k] * S[i];
    }
    so[(t * 2 + kh) * 128 + v] = op;
  }
  float* HG = p.out + O_HGS + ((size_t)(ns * 8 + h) * 128 + kh * 64) * 128 + v;
#pragma unroll
  for (int i = 0; i < 64; ++i) HG[(size_t)i * 128] = S[i];
  __syncthreads();
  if (tid < 128) {
#pragma unroll
    for (int t = 0; t < 4; ++t)
      ORAW[(size_t)(tokb + t) * 1024 + h * 128 + tid] = f2bf(so[(t * 2) * 128 + tid] + so[(t * 2 + 1) * 128 + tid]);
  }
  __syncthreads();
}

DI void p3_s5c(const P& p, int mode, int seq, int c, int gq, char* smem) {
  const int tid = threadIdx.x, wave = tid >> 6, lane = tid & 63, fr = lane & 15, fq = lane >> 4;
  const int g = gq * 4 + wave, pp = lane;
  float br[16], bi[16];
  s5_load_bbar(p, g, pp, br, bi);
  const float2 ab = ((const float2*)(p.ws + OFF_ABAR))[g * 64 + pp];
  float xr, xi;
  int tok0, ntok;
  if (mode == 0) {
    const float2 ap = ((const float2*)(p.ws + OFF_APOW))[g * 64 + pp];
    const float2* E = (const float2*)((const char*)p.out + OOFF_E) + ((size_t)(seq * 43) * 64 + g) * 64 + pp;
    xr = 0.f; xi = 0.f;
    for (int j0 = 0; j0 < c; j0 += 8) {
      float2 e[8];
#pragma unroll
      for (int i = 0; i < 8; ++i) e[i] = E[(size_t)min(j0 + i, c - 1) * 4096];
#pragma unroll
      for (int i = 0; i < 8; ++i)
        if (j0 + i < c) {
          float nr = ap.x * xr - ap.y * xi + e[i].x, ni = ap.x * xi + ap.y * xr + e[i].y;
          xr = nr; xi = ni;
        }
    }
    tok0 = seq * LP + c * 48;
    ntok = 48;
  } else {
    xr = p.ssm_re[((size_t)seq * 64 + g) * 64 + pp];
    xi = p.ssm_im[((size_t)seq * 64 + g) * 64 + pp];
    tok0 = TP + seq * 4;
    ntok = 4;
  }
  s16x8 cf[4];
#pragma unroll
  for (int ks = 0; ks < 4; ++ks) {
    int p0 = ks * 32 + fq * 8;
    const float* src = (p0 < 64 ? p.c_re : p.c_im) + ((size_t)g * 16 + fr) * 64 + (p0 & 63);
    float sgn = p0 < 64 ? 1.f : -1.f;
    float4 a = *(const float4*)src, b = *(const float4*)(src + 4);
    uint4 u = make_uint4(pack2(sgn * a.x, sgn * a.y), pack2(sgn * a.z, sgn * a.w), pack2(sgn * b.x, sgn * b.y),
                         pack2(sgn * b.z, sgn * b.w));
    cf[ks] = __builtin_bit_cast(s16x8, u);
  }
  const float dsk = p.ssm_d[g * 16 + fr];
  u16* U = unitp(p, 5);
  char* xs = smem + wave * 4352;
  const int nsub = (ntok + 15) >> 4;
  uint4 ua, ub;
  {
    const u16* r = U + (size_t)(tok0 + min(pp, ntok - 1)) * 1024 + g * 16;
    ua = *(const uint4*)r;
    ub = *(const uint4*)(r + 8);
  }
  for (int sc = 0; sc < nsub; ++sc) {
    const int tb = tok0 + sc * 16;
    const int nt = min(16, ntok - sc * 16);
#pragma unroll 4
    for (int t = 0; t < 16; ++t) {
      if (t < nt) {
        s5_step(ua, ub, sc * 16 + t, br, bi, ab.x, ab.y, xr, xi);
        *(u16*)(xs + t * 272 + pp * 2) = f2bf(xr);
        *(u16*)(xs + t * 272 + 128 + pp * 2) = f2bf(xi);
      } else {
        *(u16*)(xs + t * 272 + pp * 2) = 0;
        *(u16*)(xs + t * 272 + 128 + pp * 2) = 0;
      }
    }
    __syncthreads();
    f32x4 y = {0.f, 0.f, 0.f, 0.f};
#pragma unroll
    for (int ks = 0; ks < 4; ++ks) {
      s16x8 a = *(const s16x8*)(xs + fr * 272 + ks * 64 + fq * 16);
      y = mfma32(a, cf[ks], y);
    }
    asm volatile("s_nop 15\n\ts_nop 15" : "+v"(y));
#pragma unroll
    for (int j = 0; j < 4; ++j) {
      int t = 4 * fq + j;
      if (t < nt) {
        size_t gi = (size_t)(tb + t) * 1024 + g * 16 + fr;
        float uu = bf2f(U[gi]);
        U[gi] = f2bf(geluf_(y[j] + dsk * uu));
      }
    }
    __syncthreads();
  }
  if (mode == 0) {
    if (c == 42) {
      p.out[O_SRP + ((size_t)seq * 64 + g) * 64 + pp] = xr;
      p.out[O_SIP + ((size_t)seq * 64 + g) * 64 + pp] = xi;
    }
  } else {
    p.out[O_SRS + ((size_t)seq * 64 + g) * 64 + pp] = xr;
    p.out[O_SIS + ((size_t)seq * 64 + g) * 64 + pp] = xi;
  }
}
DI void p3_s5chain(const P& p, int job, char* smem) {
  const int tid = threadIdx.x, wave = tid >> 6, lane = tid & 63, fr = lane & 15, fq = lane >> 4;
  const int n = job >> 4, gq = job & 15;
  const int g = gq * 4 + wave, pp = lane;
  const float2 ab = ((const float2*)(p.ws + OFF_ABAR))[g * 64 + pp];
  s16x4 bb[8];
#pragma unroll
  for (int nt = 0; nt < 8; ++nt) {
    const float4* src = (const float4*)((const float2*)(p.ws + OFF_BBAR) + ((size_t)g * 64 + (nt & 3) * 16 + fr) * 16 + 4 * fq);
    float4 v0 = src[0], v1 = src[1];
    f32x4 sel = (nt < 4) ? f32x4{v0.x, v0.z, v1.x, v1.z} : f32x4{v0.y, v0.w, v1.y, v1.w};
    bb[nt] = pack4(sel);
  }
  s16x8 cf[4];
#pragma unroll
  for (int ks = 0; ks < 4; ++ks) {
    int p0 = ks * 32 + fq * 8;
    const float* src = (p0 < 64 ? p.c_re : p.c_im) + ((size_t)g * 16 + fr) * 64 + (p0 & 63);
    float sgn = p0 < 64 ? 1.f : -1.f;
    float4 a = *(const float4*)src, b = *(const float4*)(src + 4);
    uint4 u = make_uint4(pack2(sgn * a.x, sgn * a.y), pack2(sgn * a.z, sgn * a.w), pack2(sgn * b.x, sgn * b.y),
                         pack2(sgn * b.z, sgn * b.w));
    cf[ks] = __builtin_bit_cast(s16x8, u);
  }
  const float dsk = p.ssm_d[g * 16 + fr];
  u16* U = unitp(p, 5);
  char* xs = smem + wave * 12800;
  float* bu = (float*)(xs + 4352);
  float xr = 0.f, xi = 0.f;
  const int tokb = n * LP;
  s16x4 ua[3], na[3];
  u16 us[3][4], ns[3][4];
#pragma unroll
  for (int sc = 0; sc < 3; ++sc) {
    ua[sc] = *(const s16x4*)(U + (size_t)(tokb + sc * 16 + fr) * 1024 + g * 16 + 4 * fq);
#pragma unroll
    for (int j = 0; j < 4; ++j) us[sc][j] = U[(size_t)(tokb + sc * 16 + 4 * fq + j) * 1024 + g * 16 + fr];
  }
  for (int c = 0; c < 43; ++c) {
#pragma unroll
    for (int sc = 0; sc < 3; ++sc) {
      na[sc] = ua[sc];
#pragma unroll
      for (int j = 0; j < 4; ++j) ns[sc][j] = us[sc][j];
      if (c + 1 < 43) {
        na[sc] = *(const s16x4*)(U + (size_t)(tokb + (c + 1) * 48 + sc * 16 + fr) * 1024 + g * 16 + 4 * fq);
#pragma unroll
        for (int j = 0; j < 4; ++j) ns[sc][j] = U[(size_t)(tokb + (c + 1) * 48 + sc * 16 + 4 * fq + j) * 1024 + g * 16 + fr];
      }
    }
#pragma unroll
    for (int sc = 0; sc < 3; ++sc) {
      const int tb = tokb + c * 48 + sc * 16;
      s16x4 au = ua[sc];
      asm volatile("s_nop 3" : "+v"(au));
      f32x4 r[8];
#pragma unroll
      for (int nt = 0; nt < 8; ++nt) r[nt] = mfma16(au, bb[nt], f32x4{0.f, 0.f, 0.f, 0.f});
      asm volatile("s_nop 15" : "+v"(r[0]), "+v"(r[1]), "+v"(r[2]), "+v"(r[3]), "+v"(r[4]), "+v"(r[5]), "+v"(r[6]), "+v"(r[7]));
#pragma unroll
      for (int nt = 0; nt < 8; ++nt)
#pragma unroll
        for (int j = 0; j < 4; ++j) bu[(4 * fq + j) * 132 + nt * 16 + fr] = r[nt][j];
      __builtin_amdgcn_wave_barrier();
      float bre[16], bim[16];
#pragma unroll
      for (int t = 0; t < 16; ++t) { bre[t] = bu[t * 132 + pp]; bim[t] = bu[t * 132 + 64 + pp]; }
#pragma unroll
      for (int t = 0; t < 16; ++t) {
        float nr = ab.x * xr - ab.y * xi + bre[t], ni = ab.x * xi + ab.y * xr + bim[t];
        xr = nr; xi = ni;
        *(u16*)(xs + t * 272 + pp * 2) = f2bf(xr);
        *(u16*)(xs + t * 272 + 128 + pp * 2) = f2bf(xi);
      }
      __builtin_amdgcn_wave_barrier();
      f32x4 y = {0.f, 0.f, 0.f, 0.f};
#pragma unroll
      for (int ks = 0; ks < 4; ++ks) {
        s16x8 a = *(const s16x8*)(xs + fr * 272 + ks * 64 + fq * 16);
        y = mfma32(a, cf[ks], y);
      }
      asm volatile("s_nop 15\n\ts_nop 15" : "+v"(y));
#pragma unroll
      for (int j = 0; j < 4; ++j) {
        size_t gi = (size_t)(tb + 4 * fq + j) * 1024 + g * 16 + fr;
        U[gi] = f2bf(geluf_(y[j] + dsk * bf2f(us[sc][j])));
      }
    }
#pragma unroll
    for (int sc = 0; sc < 3; ++sc) {
      ua[sc] = na[sc];
#pragma unroll
      for (int j = 0; j < 4; ++j) us[sc][j] = ns[sc][j];
    }
  }
  p.out[O_SRP + ((size_t)n * 64 + g) * 64 + pp] = xr;
  p.out[O_SIP + ((size_t)n * 64 + g) * 64 + pp] = xi;
}
constexpr int NJ3_A = 64, NJ3_CH = 128, NJ3_B = 1024, NJ3_D = 128 * 16;
constexpr int NJ3_REST = NJ3_B + NJ3_D;
DI void phase3rest(const P& p, int job, char* smem) {
  if (job < NJ3_B) p3_hgrn_sample(p, job, smem);
  else { int j = job - NJ3_B; p3_s5c(p, 1, j >> 4, 0, j & 15, smem); }
}

DI void p4_onorm(const P& p, int job) {
  const int lane = threadIdx.x & 63;
  const int tk = job * 4 + (threadIdx.x >> 6);
  u16* O = unitp(p, 2) + (size_t)tk * 1024 + lane * 16;
  const u16* SG = unitp(p, 4) + (size_t)tk * 1024 + lane * 16;
  uint4 a0 = *(const uint4*)O, a1 = *(const uint4*)(O + 8);
  uint4 g0 = *(const uint4*)SG, g1 = *(const uint4*)(SG + 8);
  unsigned ov[8] = {a0.x, a0.y, a0.z, a0.w, a1.x, a1.y, a1.z, a1.w};
  unsigned gv[8] = {g0.x, g0.y, g0.z, g0.w, g1.x, g1.y, g1.z, g1.w};
  float ss = 0.f;
#pragma unroll
  for (int i = 0; i < 8; ++i) { float a = bflo(ov[i]), b = bfhi(ov[i]); ss += a * a + b * b; }
  ss += __shfl_xor(ss, 1);
  ss += __shfl_xor(ss, 2);
  ss += __shfl_xor(ss, 4);
  const float rs = rsqrtf(ss * (1.f / 128.f) + EPS);
  const float* gw = p.g_norm_w + (lane & 7) * 16;
  unsigned r[8];
#pragma unroll
  for (int i = 0; i < 8; ++i) {
    float a = bflo(ov[i]) * rs * gw[2 * i] * bflo(gv[i]);
    float b = bfhi(ov[i]) * rs * gw[2 * i + 1] * bfhi(gv[i]);
    r[i] = pack2(a, b);
  }
  *(uint4*)O = make_uint4(r[0], r[1], r[2], r[3]);
  *(uint4*)(O + 8) = make_uint4(r[4], r[5], r[6], r[7]);
}
DI void p4_glu(const P& p, int job, char* smem) {
  const int pm = job >> 3, pn = job & 7;
  const int brow = pm * 128, bcol = pn * 128;
  f32x4 acc[4][4];
  ZERO_ACC(acc);
  const u16* Y = unitp(p, 5);
  gemm_core(Y, 1024, (const u16*)(p.ws + OFF_WTGLU), 1024, 1024, brow, bcol, smem, acc);
  EPI_VARS;
  u16* Z = unitp(p, 1);
  EPI_BASE(1024, brow, bcol);
  EPI_LOOP {
    float bb = p.b_glu[bcol + wc * 64 + n * 16 + fr];
#pragma unroll
    for (int j = 0; j < 4; ++j) {
      int gi = idx0 + (m * 16 + j) * 1024 + n * 16;
      Z[gi] = f2bf(bf2f(Y[gi]) * sigmoidf_(acc[m][n][j] + bb));
    }
  }
}
constexpr int NJ4_A = T / 4, NJ4 = NJ4_A + 133 * 8;

DI void phase5(const P& p, int job, char* smem) {
  const int pm = job >> 3, pn = job & 7;
  const int brow = pm * 128, bcol = pn * 128;
  EPI_VARS;
  u16* MX = unitp(p, 3);
#pragma unroll 1
  for (int pass = 0; pass < 2; ++pass) {
    f32x4 acc[4][4];
    ZERO_ACC(acc);
    gemm_core(unitp(p, pass ? 1 : 2), 1024, (const u16*)(p.ws + (pass ? OFF_WTB : OFF_WTA)), 1024, 1024, brow, bcol,
              smem, acc);
    const u16* GT = unitp(p, 6 + pass);
    EPI_BASE(1024, brow, bcol);
    EPI_LOOP {
#pragma unroll
      for (int j = 0; j < 4; ++j) {
        int gi = idx0 + (m * 16 + j) * 1024 + n * 16;
        float prev = pass ? bf2f(MX[gi]) : 0.f;
        MX[gi] = f2bf(prev + acc[m][n][j] * bf2f(GT[gi]));
      }
    }
  }
}
constexpr int NJ5 = 133 * 8;

DI void phase6(const P& p, int job, char* smem) {
  const int pm = job >> 3, pn = job & 7;
  const int brow = pm * 128, bcol = pn * 128;
  EPI_VARS;
  f32x4 acc[4][4];
  ZERO_ACC(acc);
  gemm_core(unitp(p, 3), 1024, (const u16*)(p.ws + OFF_WTOUT), 1024, 1024, brow, bcol, smem, acc);
  float* X1 = (float*)unitp(p, 0);
  int rb = brow + wr * 64 + fq * 4, cbv = bcol + wc * 64 + fr;
  asm volatile("" : "+v"(rb), "+v"(cbv));
#pragma unroll
  for (int m = 0; m < 4; ++m) {
#pragma unroll
    for (int j = 0; j < 4; ++j) {
      const int row = rb + m * 16 + j;
      const float* xr = xrow(p, row) + cbv;
      float* xo = X1 + (size_t)row * 1024 + cbv;
#pragma unroll
      for (int n = 0; n < 4; ++n) xo[n * 16] = xr[n * 16] + acc[m][n][j];
    }
  }
}
constexpr int NJ6 = 133 * 8;

DI void phase7(const P& p, int job) {
  int tk = job * 4 + (threadIdx.x >> 6);
  rms_row_to_bf16((const float*)unitp(p, 0) + (size_t)tk * 1024, p.norm2_w, unitp(p, 2) + (size_t)tk * 1024,
                  threadIdx.x & 63);
}
constexpr int NJ7 = T / 4;
DI void convert_tables(const P& p, int j) {
  const float* src = (j < 4096 ? p.peer_u : p.peer_v) + (size_t)(j & 4095) * 4096 + threadIdx.x * 16;
  const float sc = j < 4096 ? 64.f : 16.f;
  unsigned char* dst = (unsigned char*)unitp(p, 6) + (size_t)j * 4096 + threadIdx.x * 16;
  unsigned w[4];
#pragma unroll
  for (int i = 0; i < 4; ++i) {
    float4 a = *(const float4*)(src + 4 * i);
    int d = __builtin_amdgcn_cvt_pk_fp8_f32(a.x * sc, a.y * sc, 0, false);
    d = __builtin_amdgcn_cvt_pk_fp8_f32(a.z * sc, a.w * sc, d, true);
    w[i] = (unsigned)d;
  }
  *(uint4*)dst = make_uint4(w[0], w[1], w[2], w[3]);
}

DI void phase8(const P& p, int job, char* smem) {
  const int pm = job >> 4, pn = job & 15;
  const int brow = pm * 128, bcol = pn * 128;
  EPI_VARS;
  f32x4 acc[4][4];
  ZERO_ACC(acc);
  gemm_core(unitp(p, 2), 1024, (const u16*)(p.ws + OFF_WTQ), 1024, 1024, brow, bcol, smem, acc);
  u16* Q = unitp(p, 3);
  EPI_BASE(2048, brow, bcol);
  EPI_LOOP {
#pragma unroll
    for (int j = 0; j < 4; ++j) Q[idx0 + (m * 16 + j) * 2048 + n * 16] = f2bf(acc[m][n][j]);
  }
}
constexpr int NJ8 = 133 * 16;

DI int f2key(float f) { int s = __float_as_int(f); return s ^ ((s >> 31) & 0x7fffffff); }
DI float key2f(int k) { return __int_as_float(k ^ ((k >> 31) & 0x7fffffff)); }
DI int rowmax16(int x) {
  x = max(x, __builtin_amdgcn_update_dpp(0, x, 0x128, 0xf, 0xf, false));
  x = max(x, __builtin_amdgcn_update_dpp(0, x, 0x124, 0xf, 0xf, false));
  x = max(x, __builtin_amdgcn_update_dpp(0, x, 0x122, 0xf, 0xf, false));
  x = max(x, __builtin_amdgcn_update_dpp(0, x, 0x121, 0xf, 0xf, false));
  return x;
}
DI void phase9(const P& p, int job) {
  const int tid = threadIdx.x, wave = tid >> 6, lane = tid & 63, fr = lane & 15, fq = lane >> 4;
  const int tile = job >> 1, h = (job & 1) * 4 + wave;
  const int tok0 = tile * 16;
  const u16* QRY = unitp(p, 3);
  int* EXPI = (int*)unitp(p, 5);
  float* GATE = (float*)((char*)unitp(p, 5) + (size_t)T * 128 * 4);
  float v12[2][4];
  int i12[2][4];
#pragma unroll
  for (int half = 0; half < 2; ++half) {
    f32x4 acc[8];
#pragma unroll
    for (int nt = 0; nt < 8; ++nt) acc[nt] = f32x4{0.f, 0.f, 0.f, 0.f};
    const u16* Kb = (const u16*)(p.ws + (half ? OFF_K2 : OFF_K1)) + (size_t)h * 128 * 128;
#pragma unroll
    for (int ks = 0; ks < 4; ++ks) {
      s16x8 a = *(const s16x8*)(QRY + (size_t)(tok0 + fr) * 2048 + h * 256 + half * 128 + ks * 32 + fq * 8);
#pragma unroll
      for (int nt = 0; nt < 8; ++nt) {
        s16x8 b = *(const s16x8*)(Kb + (size_t)(nt * 16 + fr) * 128 + ks * 32 + fq * 8);
        acc[nt] = mfma32(a, b, acc[nt]);
      }
    }
    asm volatile("s_nop 15\n\ts_nop 15" : "+v"(acc[0]), "+v"(acc[1]), "+v"(acc[2]), "+v"(acc[3]), "+v"(acc[4]), "+v"(acc[5]), "+v"(acc[6]), "+v"(acc[7]));
#pragma unroll
    for (int j = 0; j < 4; ++j) {
      int keys[8];
#pragma unroll
      for (int nt = 0; nt < 8; ++nt) keys[nt] = (f2key(acc[nt][j]) & ~127) | (127 - (nt * 16 + fr));
      int mine = 0;
      for (int r = 0; r < 16; ++r) {
        int bk = keys[0];
#pragma unroll
        for (int nt = 1; nt < 8; ++nt) bk = max(bk, keys[nt]);
        int wk = rowmax16(bk);
        if (fr == r) mine = wk;
#pragma unroll
        for (int nt = 0; nt < 8; ++nt)
          if (keys[nt] == wk) keys[nt] = (int)0x80000000;
      }
      v12[half][j] = key2f(mine & ~127);
      i12[half][j] = 127 - (mine & 127);
    }
  }
#pragma unroll
  for (int j = 0; j < 4; ++j) {
    const float v1 = v12[0][j], v2 = v12[1][j];
    const int e1 = i12[0][j], e2 = i12[1][j];
    int ptr = 0;
    float sc = 0.f;
    int ex = 0;
    const int gbase = lane & ~15;
    for (int r = 0; r < 16; ++r) {
      int pc = min(ptr, 15);
      float v2p = __shfl(v2, gbase + pc);
      int e2p = __shfl(e2, gbase + pc);
      int key = ptr < 16 ? ((f2key(v1 + v2p) & ~255) | (255 - (fr * 16 + ptr))) : (int)0x80000000;
      int wk = rowmax16(key);
      int pos = 255 - (wk & 255);
      int wi = pos >> 4;
      int myexp = e1 * 128 + e2p;
      int wexp = __shfl(myexp, gbase + wi);
      if (fr == r) { sc = key2f(wk & ~255); ex = wexp; }
      if (fr == wi) ptr++;
    }
    float mx = sc;
    mx = fmaxf(mx, __shfl_xor(mx, 1));
    mx = fmaxf(mx, __shfl_xor(mx, 2));
    mx = fmaxf(mx, __shfl_xor(mx, 4));
    mx = fmaxf(mx, __shfl_xor(mx, 8));
    float e = __expf(sc - mx);
    float sm = e;
    sm += __shfl_xor(sm, 1);
    sm += __shfl_xor(sm, 2);
    sm += __shfl_xor(sm, 4);
    sm += __shfl_xor(sm, 8);
    size_t oi = (size_t)(tok0 + 4 * fq + j) * 128 + h * 16 + fr;
    EXPI[oi] = ex;
    GATE[oi] = e / sm;
  }
}
constexpr int NJ9 = 1064 * 2;

typedef float f32x2v __attribute__((ext_vector_type(2)));
DI void unpack16(const uint4& a, float (&x)[16]) {
  const unsigned w[4] = {a.x, a.y, a.z, a.w};
#pragma unroll
  for (int i = 0; i < 4; ++i) {
    f32x2v lo = __builtin_amdgcn_cvt_pk_f32_fp8((int)w[i], false);
    f32x2v hi = __builtin_amdgcn_cvt_pk_f32_fp8((int)w[i], true);
    x[4 * i] = lo[0]; x[4 * i + 1] = lo[1]; x[4 * i + 2] = hi[0]; x[4 * i + 3] = hi[1];
  }
}
#define LANE_OF(k) ((((k) >> 3) & 1) * 32 + (((k) >> 2) & 1) * 16 + (((k) >> 1) & 1) * 8 + ((k)&1) * 4)
DI void phase10(const P& p, int job) {
  const int lane = threadIdx.x & 63;
  const int tk = job * 4 + (threadIdx.x >> 6);
  float* dst;
  if (tk < TP) {
    int n = tk / LP, l = tk - n * LP;
    if (l < 16) return;
    dst = p.out + O_YP + ((size_t)n * 2048 + (l - 16)) * 1024;
  } else {
    dst = p.out + O_YS + (size_t)(tk - TP) * 1024;
  }
  const float* X1 = (const float*)unitp(p, 0) + (size_t)tk * 1024;
  const u16* H2 = unitp(p, 2) + (size_t)tk * 1024;
  const int* EXPI = (const int*)unitp(p, 5) + (size_t)tk * 128;
  const float* GATE = (const float*)((const char*)unitp(p, 5) + (size_t)T * 128 * 4) + (size_t)tk * 128;
  const unsigned char* UT = (const unsigned char*)unitp(p, 6);
  const unsigned char* VTB = UT + (size_t)16384 * 1024;
  float hv[16];
  {
    uint4 a = *(const uint4*)(H2 + lane * 16), b = *(const uint4*)(H2 + lane * 16 + 8);
    hv[0] = bflo(a.x); hv[1] = bfhi(a.x); hv[2] = bflo(a.y); hv[3] = bfhi(a.y);
    hv[4] = bflo(a.z); hv[5] = bfhi(a.z); hv[6] = bflo(a.w); hv[7] = bfhi(a.w);
    hv[8] = bflo(b.x); hv[9] = bfhi(b.x); hv[10] = bflo(b.y); hv[11] = bfhi(b.y);
    hv[12] = bflo(b.z); hv[13] = bfhi(b.z); hv[14] = bflo(b.w); hv[15] = bfhi(b.w);
  }
  float ov[16];
#pragma unroll
  for (int i = 0; i < 16; ++i) ov[i] = 0.f;
  const int kmine = ((lane >> 5) & 1) * 8 + ((lane >> 4) & 1) * 4 + ((lane >> 3) & 1) * 2 + ((lane >> 2) & 1);
  const bool b5 = lane & 32, b4 = lane & 16, b3 = lane & 8, b2 = lane & 4;
  for (int h = 0; h < 8; ++h) {
    const int e_l = EXPI[h * 16 + kmine];
    const float g_l = GATE[h * 16 + kmine];
    float part[16];
#pragma unroll
    for (int k = 0; k < 16; ++k) {
      int e = __builtin_amdgcn_readlane(e_l, LANE_OF(k));
      uint4 a = *(const uint4*)(UT + (size_t)e * 1024 + lane * 16);
      float x[16];
      unpack16(a, x);
      float d = 0.f;
#pragma unroll
      for (int i = 0; i < 16; ++i) d += x[i] * hv[i];
      part[k] = d;
    }
    float r8[8], r4[4], r2[2];
#pragma unroll
    for (int i = 0; i < 8; ++i) {
      float send = b5 ? part[i] : part[i + 8], keep = b5 ? part[i + 8] : part[i];
      r8[i] = keep + __shfl_xor(send, 32);
    }
#pragma unroll
    for (int i = 0; i < 4; ++i) {
      float send = b4 ? r8[i] : r8[i + 4], keep = b4 ? r8[i + 4] : r8[i];
      r4[i] = keep + __shfl_xor(send, 16);
    }
#pragma unroll
    for (int i = 0; i < 2; ++i) {
      float send = b3 ? r4[i] : r4[i + 2], keep = b3 ? r4[i + 2] : r4[i];
      r2[i] = keep + __shfl_xor(send, 8);
    }
    float d;
    {
      float send = b2 ? r2[0] : r2[1], keep = b2 ? r2[1] : r2[0];
      d = keep + __shfl_xor(send, 4);
    }
    d += __shfl_xor(d, 2);
    d += __shfl_xor(d, 1);
    const float w_l = g_l * geluf_(d * (1.f / 64.f)) * (1.f / 16.f);
#pragma unroll
    for (int k = 0; k < 16; ++k) {
      int e = __builtin_amdgcn_readlane(e_l, LANE_OF(k));
      float w = __builtin_bit_cast(float, __builtin_amdgcn_readlane(__builtin_bit_cast(int, w_l), LANE_OF(k)));
      uint4 a = *(const uint4*)(VTB + (size_t)e * 1024 + lane * 16);
      float x[16];
      unpack16(a, x);
#pragma unroll
      for (int i = 0; i < 16; ++i) ov[i] += w * x[i];
    }
  }
  float ss = 0.f;
#pragma unroll
  for (int i = 0; i < 4; ++i) {
    float4 x = *(const float4*)(X1 + lane * 16 + i * 4);
    ov[4 * i] += x.x; ov[4 * i + 1] += x.y; ov[4 * i + 2] += x.z; ov[4 * i + 3] += x.w;
    ss += ov[4 * i] * ov[4 * i] + ov[4 * i + 1] * ov[4 * i + 1] + ov[4 * i + 2] * ov[4 * i + 2] + ov[4 * i + 3] * ov[4 * i + 3];
  }
  ss = wave_sum(ss);
  const float rs = rsqrtf(ss * (1.f / 1024.f) + EPS);
#pragma unroll
  for (int i = 0; i < 4; ++i) {
    int eo = lane * 16 + i * 4;
    float4 w = *(const float4*)(p.final_w + eo);
    *(float4*)(dst + eo) =
        make_float4(ov[4 * i] * rs * w.x, ov[4 * i + 1] * rs * w.y, ov[4 * i + 2] * rs * w.z, ov[4 * i + 3] * rs * w.w);
  }
}
constexpr int NJ10 = T / 4;


#define XB_TMO      128
#define XB_XCNT(j)  (256  + 64 * (j))
#define XB_XSUB(j)  (1280 + 64 * (j))
#define XB_XGEN(j)  (2304 + 64 * (j))
#define XB_TOP      3328
#define XB_TOPGEN   3392
#define XCD_BAR_WORDS 3456
#define XB_SPIN_CAP (1u << 18)
#define LAS __attribute__((address_space(3)))

__device__ __forceinline__ unsigned xb_ld(unsigned* p)              { return __hip_atomic_load(p, __ATOMIC_RELAXED, __HIP_MEMORY_SCOPE_AGENT); }
__device__ __forceinline__ unsigned xb_add(unsigned* p, unsigned v) { return __hip_atomic_fetch_add(p, v, __ATOMIC_RELAXED, __HIP_MEMORY_SCOPE_AGENT); }
__device__ __forceinline__ unsigned xb_xcc_id() { return (unsigned)__builtin_amdgcn_s_getreg((3 << 11) | 20) & 0xFu; }
#define XB_SPIN(cond, bar) do { unsigned _sp = 0; while (cond) { __builtin_amdgcn_s_sleep(1); \
    if ((++_sp & 255u) == 0u) { if (xb_ld(&(bar)[XB_TMO])) break; if (_sp > XB_SPIN_CAP) { atomicAdd(&(bar)[XB_TMO], 1u); break; } } } } while (0)

struct XcdBarrier {
    unsigned* bar; unsigned x;
    volatile LAS unsigned* st;
};

__device__ __forceinline__ XcdBarrier xcd_barrier_post(unsigned* bar, volatile LAS unsigned* st) {
    XcdBarrier b; b.bar = bar; b.x = xb_xcc_id(); b.st = st;
    if (threadIdx.x == 0) (void)xb_add(&bar[XB_XCNT(b.x)], 1u);
    return b;
}
__device__ __forceinline__ void xcd_barrier_complete(unsigned* bar, unsigned x, unsigned& nloc, unsigned& nx) {
    const unsigned G = gridDim.x * gridDim.y * gridDim.z;
    unsigned sum, cnt, mine, sp = 0u;
    for (;;) {
        sum = 0u; cnt = 0u; mine = 0u;
#pragma unroll
        for (unsigned j = 0; j < 16; ++j) { const unsigned c = xb_ld(&bar[XB_XCNT(j)]); sum += c; cnt += (c > 0u) ? 1u : 0u; mine = (j == x) ? c : mine; }
        if (sum == G) break;
        __builtin_amdgcn_s_sleep(1);
        if ((++sp & 255u) == 0u) { if (xb_ld(&bar[XB_TMO])) break; if (sp > XB_SPIN_CAP) { atomicAdd(&bar[XB_TMO], 1u); break; } }
    }
    nloc = mine > 0u ? mine : 1u; nx = cnt > 0u ? cnt : 1u;
}

__device__ __forceinline__ void xcd_barrier(const XcdBarrier& b) {
    asm volatile("s_waitcnt vmcnt(0)" ::: "memory");
    __syncthreads();
    if (threadIdx.x == 0) {
        unsigned* bar = b.bar;
        __builtin_amdgcn_s_waitcnt(0);
        unsigned nloc = b.st[0], nx = b.st[1];
        if (nloc == 0u) { xcd_barrier_complete(bar, b.x, nloc, nx); b.st[0] = nloc; b.st[1] = nx; }
        const unsigned old = xb_add(&bar[XB_XSUB(b.x)], 1u);
        const unsigned gen = old / nloc;
        if (old + 1u == (gen + 1u) * nloc) {
            __builtin_amdgcn_fence(__ATOMIC_RELEASE, "agent");
            asm volatile("s_waitcnt vmcnt(0)" ::: "memory");
            const unsigned og = xb_add(&bar[XB_TOP], 1u);
            const unsigned tg = og / nx;
            if (og + 1u == (tg + 1u) * nx) xb_add(&bar[XB_TOPGEN], 1u);
            else XB_SPIN(xb_ld(&bar[XB_TOPGEN]) == tg, bar);
            __builtin_amdgcn_fence(__ATOMIC_ACQUIRE, "agent");
            xb_add(&bar[XB_XGEN(b.x)], 1u);
            asm volatile("s_waitcnt vmcnt(0)" ::: "memory");
        } else {
            XB_SPIN(xb_ld(&bar[XB_XGEN(b.x)]) == gen, bar);
            __builtin_amdgcn_fence(__ATOMIC_ACQUIRE, "agent");
            asm volatile("s_waitcnt vmcnt(0)" ::: "memory");
        }
    }
    __syncthreads();
}


DI void my_sync(unsigned* bar, unsigned target) {
  asm volatile("s_waitcnt vmcnt(0)" ::: "memory");
  __syncthreads();
  if (threadIdx.x == 0) {
    __builtin_amdgcn_fence(__ATOMIC_RELEASE, "agent");
    asm volatile("s_waitcnt vmcnt(0)" ::: "memory");
    __hip_atomic_fetch_add(bar, 1u, __ATOMIC_RELAXED, __HIP_MEMORY_SCOPE_AGENT);
    while (__hip_atomic_load(bar, __ATOMIC_RELAXED, __HIP_MEMORY_SCOPE_AGENT) < target) __builtin_amdgcn_s_sleep(2);
    __builtin_amdgcn_fence(__ATOMIC_ACQUIRE, "agent");
    asm volatile("s_waitcnt vmcnt(0)" ::: "memory");
  }
  __syncthreads();
}
__global__ void __launch_bounds__(256, 2) mega(P p, int ph_lo, int ph_hi) {
  __shared__ __attribute__((aligned(16))) char smem[SMEM_BYTES];
  cg::grid_group grid = cg::this_grid();
  const int G = gridDim.x, B = blockIdx.x;
#define RUN_PHASE(n) if ((ONLY < 0 || ONLY == n) && ph_lo <= n && n < ph_hi)
  __shared__ uint4 xb_words;
  if (threadIdx.x == 0) xb_words = make_uint4(0u, 0u, 0u, 0u);
  __syncthreads();
  XcdBarrier xb = xcd_barrier_post((unsigned*)(p.ws + OFF_BAR), (volatile LAS unsigned*)&xb_words);
  if (ph_hi > 1000) grid.sync();
#define SYNC_IF(n) if (n > ph_lo) { xcd_barrier(xb); }
  RUN_PHASE(0) { for (int j = B; j < NJ0; j += G) phase0(p, j, smem); }
  RUN_PHASE(1) { SYNC_IF(1) for (int j = B; j < NJ1; j += G) phase1(p, j, smem); }
  RUN_PHASE(2) { SYNC_IF(2)
    for (int j = B; j < NJ2_H; j += G) p2_hgrn_pre(p, j, smem); }
  RUN_PHASE(3) { SYNC_IF(3)
    if (B < NJ3_A) p3_hgrn_seq(p, B, smem);
    else if (B < NJ3_A + NJ3_CH) p3_s5chain(p, B - NJ3_A, smem);
    else for (int j = B - (NJ3_A + NJ3_CH); j < NJ3_REST; j += G - (NJ3_A + NJ3_CH)) phase3rest(p, j, smem); }
  RUN_PHASE(4) { SYNC_IF(4)
    for (int j = B; j < NJ4; j += G) { if (j < NJ4_A) p4_onorm(p, j); else p4_glu(p, j - NJ4_A, smem); } }
  RUN_PHASE(5) { SYNC_IF(5) for (int j = B; j < NJ5; j += G) phase5(p, j, smem); }
  RUN_PHASE(6) { SYNC_IF(6) for (int j = B; j < NJ6; j += G) phase6(p, j, smem);
    { const int extra = NJ6 % G;
      if (B >= extra) for (int j = B - extra; j < 8192; j += G - extra) convert_tables(p, j); } }
  RUN_PHASE(7) { SYNC_IF(7) for (int j = B; j < NJ7; j += G) phase7(p, j); }
  RUN_PHASE(8) { SYNC_IF(8) for (int j = B; j < NJ8; j += G) phase8(p, j, smem); }
  RUN_PHASE(9) { SYNC_IF(9) for (int j = B; j < NJ9; j += G) phase9(p, j); }
  RUN_PHASE(10) { SYNC_IF(10) for (int j = B; j < NJ10; j += G) phase10(p, j); }
}

extern "C" void kernel_launch(void* const* d_in, const int* in_sizes, int n_in, void* d_out, int out_size, void* d_ws,
                              size_t ws_size, hipStream_t stream) {
  static int grid_blocks = 0;
  if (!grid_blocks) {
    int dev = 0, cus = 0, per_cu = 0;
    hipGetDevice(&dev);
    hipDeviceGetAttribute(&cus, hipDeviceAttributeMultiprocessorCount, dev);
    hipOccupancyMaxActiveBlocksPerMultiprocessor(&per_cu, mega, 256, 0);
    if (per_cu < 1) per_cu = 1;
    grid_blocks = cus * per_cu;
  }
  P p{};
  const float** pf = (const float**)&p;
  for (int i = 0; i < 30; ++i) pf[i] = (const float*)d_in[i];
  p.out = (float*)d_out;
  p.ws = (char*)d_ws;
#if SINGLE_LAUNCH
  hipMemsetAsync((char*)d_ws + OFF_BAR, 0, XCD_BAR_WORDS * sizeof(unsigned), stream);
  int lo = 0, hi = 11;
  void* args[] = {&p, &lo, &hi};
  hipError_t e = hipLaunchCooperativeKernel((void*)mega, dim3(grid_blocks), dim3(256), args, 0, stream);
  if (e != hipSuccess) fprintf(stderr, "cooperative launch failed: %s (grid %d)\n", hipGetErrorString(e), grid_blocks);
#else
  for (int ph = 0; ph < 11; ++ph) hipLaunchKernelGGL(mega, dim3(grid_blocks), dim3(256), 0, stream, p, ph, ph + 1);
#endif
}
```

```cpp
#include <hip/hip_runtime.h>
#include <hip/hip_cooperative_groups.h>
#include <cstdio>
namespace cg = cooperative_groups;

#define DI __device__ __forceinline__
typedef unsigned short u16;
typedef short s16x4 __attribute__((ext_vector_type(4)));
typedef short s16x8 __attribute__((ext_vector_type(8)));
typedef float f32x4 __attribute__((ext_vector_type(4)));
typedef __bf16 bf16x2_t __attribute__((ext_vector_type(2)));
typedef float f32x2_t __attribute__((ext_vector_type(2)));

#ifndef SINGLE_LAUNCH
#define SINGLE_LAUNCH 1
#endif

constexpr int T = 17024, TP = 16512, LP = 2064, NCHK = 129;
constexpr float EPS = 1e-6f;
#ifndef ONLY
#define ONLY -1
#endif
constexpr size_t UNIT = (size_t)T * 1024 * 2;
constexpr size_t OFF_WTIN = 0;
constexpr size_t OFF_WTGLU = OFF_WTIN + (size_t)7168 * 1024 * 2;
constexpr size_t OFF_WTA = OFF_WTGLU + 2097152;
constexpr size_t OFF_WTB = OFF_WTA + 2097152;
constexpr size_t OFF_WTOUT = OFF_WTB + 2097152;
constexpr size_t OFF_WTQ = OFF_WTOUT + 2097152;
constexpr size_t OFF_K1 = OFF_WTQ + 4194304;
constexpr size_t OFF_K2 = OFF_K1 + 262144;
constexpr size_t OFF_LB = OFF_K2 + 262144;
constexpr size_t OFF_ABAR = OFF_LB + 4096;
constexpr size_t OFF_APOW = OFF_ABAR + 32768;
constexpr size_t OFF_BBAR = OFF_APOW + 32768;
constexpr size_t OFF_UNITS = OFF_BBAR + 524288;
constexpr size_t OFF_BAR = OFF_UNITS + 8 * ((size_t)17024 * 1024 * 2);
constexpr size_t OOFF_KTT = 0;
constexpr size_t OOFF_DEC = UNIT;
constexpr size_t OOFF_E = OOFF_DEC + (size_t)1032 * 1024 * 4;
constexpr size_t O_YP = 0, O_YS = 16777216, O_HGP = 17301504, O_SRP = 18350080, O_SIP = 18382848,
                 O_HGS = 18415616, O_SRS = 35192832, O_SIS = 35717120;
constexpr int SMEM_BYTES = 65536;

struct P {
  const float *x_prompt, *x_sample, *state_hgrn, *ssm_re, *ssm_im, *meta, *lower_bounds, *norm1_w, *w_in, *g_norm_w,
      *a_re, *a_im, *log_step, *b_re, *b_im, *c_re, *c_im, *ssm_d, *w_glu, *b_glu, *w_a, *w_b, *w_out, *norm2_w,
      *peer_wq, *k1, *k2, *peer_u, *peer_v, *final_w;
  float* out;
  char* ws;
};

DI unsigned pack2(float a, float b) {
  f32x2_t v = {a, b};
  bf16x2_t r = __builtin_convertvector(v, bf16x2_t);
  return __builtin_bit_cast(unsigned, r);
}
DI u16 f2bf(float a) { return (u16)(pack2(a, 0.f) & 0xffffu); }
DI float bf2f(u16 v) { return __uint_as_float(((unsigned)v) << 16); }
DI float bflo(unsigned v) { return __uint_as_float(v << 16); }
DI float bfhi(unsigned v) { return __uint_as_float(v & 0xffff0000u); }
DI f32x4 mfma32(s16x8 a, s16x8 b, f32x4 c) { return __builtin_amdgcn_mfma_f32_16x16x32_bf16(a, b, c, 0, 0, 0); }
DI f32x4 mfma16(s16x4 a, s16x4 b, f32x4 c) { return __builtin_amdgcn_mfma_f32_16x16x16bf16_1k(a, b, c, 0, 0, 0); }
DI float wave_sum(float v) {
#pragma unroll
  for (int o = 32; o >= 1; o >>= 1) v += __shfl_xor(v, o);
  return v;
}
DI float sigmoidf_(float x) { return 1.f / (1.f + __expf(-x)); }
DI float siluf_(float x) { return x / (1.f + __expf(-x)); }
DI float geluf_(float x) { return 0.5f * x * (1.f + erff(x * 0.70710678118654752f)); }
DI s16x4 pack4(f32x4 v) {
  unsigned a = pack2(v[0], v[1]), b = pack2(v[2], v[3]);
  uint2 u = make_uint2(a, b);
  return __builtin_bit_cast(s16x4, u);
}
DI s16x8 pack8(f32x4 x, f32x4 y) {
  uint4 u = make_uint4(pack2(x[0], x[1]), pack2(x[2], x[3]), pack2(y[0], y[1]), pack2(y[2], y[3]));
  return __builtin_bit_cast(s16x8, u);
}
DI u16* unitp(const P& p, int i) { return (u16*)(p.ws + OFF_UNITS + (size_t)i * UNIT); }
DI const float* xrow(const P& p, int tk) {
  if (tk < TP) {
    int n = tk / LP, l = tk - n * LP;
    return l < 16 ? p.meta + (size_t)l * 1024 : p.x_prompt + ((size_t)n * 2048 + (l - 16)) * 1024;
  }
  return p.x_sample + (size_t)(tk - TP) * 1024;
}

DI void gemm_core(const u16* __restrict__ A, int lda, const u16* __restrict__ Bt, int ldb, int K, int brow, int bcol,
                  char* smem, f32x4 (&acc)[4][4]) {
  const int tid = threadIdx.x, wave = tid >> 6, lane = tid & 63, wr = wave >> 1, wc = wave & 1, fr = lane & 15,
            fq = lane >> 4;
  const int r0 = tid >> 3, cj = tid & 7;
  const u16* ga = A + (size_t)(brow + r0) * lda + cj * 8;
  const u16* gb = Bt + (size_t)(bcol + r0) * ldb + cj * 8;
  const size_t sa = (size_t)32 * lda, sb = (size_t)32 * ldb;
  const int woff = r0 * 128 + ((cj ^ ((r0 >> 1) & 7)) << 4);
  uint4 ra[4], rb[4];
#pragma unroll
  for (int i = 0; i < 4; ++i) { ra[i] = *(const uint4*)(ga + i * sa); rb[i] = *(const uint4*)(gb + i * sb); }
#pragma unroll
  for (int i = 0; i < 4; ++i) {
    *(uint4*)(smem + woff + i * 4096) = ra[i];
    *(uint4*)(smem + 16384 + woff + i * 4096) = rb[i];
  }
  __syncthreads();
  const int arow = wr * 64 + fr, brow_l = wc * 64 + fr;
  const int sw = (fr >> 1) & 7;
  const int nk = K >> 6;
  for (int kt = 0; kt < nk; ++kt) {
    const int s = kt & 1;
    if (kt + 1 < nk) {
#pragma unroll
      for (int i = 0; i < 4; ++i) {
        ra[i] = *(const uint4*)(ga + i * sa + (kt + 1) * 64);
        rb[i] = *(const uint4*)(gb + i * sb + (kt + 1) * 64);
      }
    }
    const char* a = smem + s * 32768;
    const char* b = a + 16384;
#pragma unroll
    for (int ks = 0; ks < 2; ++ks) {
      s16x8 af[4], bfr[4];
      const int co = (((ks * 4 + fq) ^ sw) << 4);
#pragma unroll
      for (int m = 0; m < 4; ++m) af[m] = *(const s16x8*)(a + (arow + m * 16) * 128 + co);
#pragma unroll
      for (int n = 0; n < 4; ++n) bfr[n] = *(const s16x8*)(b + (brow_l + n * 16) * 128 + co);
#pragma unroll
      for (int m = 0; m < 4; ++m)
#pragma unroll
        for (int n = 0; n < 4; ++n) acc[m][n] = mfma32(af[m], bfr[n], acc[m][n]);
    }
    if (kt + 1 < nk) {
      char* a2 = smem + (s ^ 1) * 32768;
#pragma unroll
      for (int i = 0; i < 4; ++i) {
        *(uint4*)(a2 + woff + i * 4096) = ra[i];
        *(uint4*)(a2 + 16384 + woff + i * 4096) = rb[i];
      }
    }
    __syncthreads();
  }
  asm volatile("s_nop 15\n\ts_nop 15" : "+v"(acc[0][0]), "+v"(acc[0][1]), "+v"(acc[0][2]), "+v"(acc[0][3]), "+v"(acc[1][0]), "+v"(acc[1][1]), "+v"(acc[1][2]), "+v"(acc[1][3]), "+v"(acc[2][0]), "+v"(acc[2][1]), "+v"(acc[2][2]), "+v"(acc[2][3]), "+v"(acc[3][0]), "+v"(acc[3][1]), "+v"(acc[3][2]), "+v"(acc[3][3]));
}
#define ZERO_ACC(acc)                              \
  _Pragma("unroll") for (int m = 0; m < 4; ++m)    \
  _Pragma("unroll") for (int n = 0; n < 4; ++n) acc[m][n] = f32x4{0.f, 0.f, 0.f, 0.f};
#define EPI_VARS                                                                                             \
  const int tid = threadIdx.x, wave = tid >> 6, lane = tid & 63, wr = wave >> 1, wc = wave & 1, fr = lane & 15, \
            fq = lane >> 4;
#define EPI_BASE(ld, rb, cbv)                                    \
  int tb_ = (wr * 64 + fq * 4) * (ld) + wc * 64 + fr;           \
  asm volatile("" : "+v"(tb_));                                 \
  const int idx0 = (rb) * (ld) + (cbv) + tb_;
#define EPI_LOOP                                 \
  _Pragma("unroll") for (int m = 0; m < 4; ++m)  \
  _Pragma("unroll") for (int n = 0; n < 4; ++n)

DI void p0_transpose(const float* __restrict__ W, int K, int N, u16* __restrict__ Wt, int tile, char* smem) {
  float* sm = (float*)smem;
  const int ntn = N >> 6;
  const int tk = tile / ntn, tn = tile - tk * ntn;
  const int tid = threadIdx.x;
  const int c = tid & 63, r0 = tid >> 6;
#pragma unroll
  for (int i = 0; i < 16; ++i) {
    int r = r0 + i * 4;
    sm[r * 65 + c] = W[(size_t)(tk * 64 + r) * N + tn * 64 + c];
  }
  __syncthreads();
  const int n = tid >> 2, ks = (tid & 3) * 16;
  unsigned o[8];
#pragma unroll
  for (int i = 0; i < 8; ++i) o[i] = pack2(sm[(ks + 2 * i) * 65 + n], sm[(ks + 2 * i + 1) * 65 + n]);
  uint4* dst = (uint4*)(Wt + (size_t)(tn * 64 + n) * K + tk * 64 + ks);
  dst[0] = make_uint4(o[0], o[1], o[2], o[3]);
  dst[1] = make_uint4(o[4], o[5], o[6], o[7]);
  __syncthreads();
}

DI void p0_convert(const float* __restrict__ src, u16* __restrict__ dst, int job) {
  size_t i = (size_t)job * 2048 + threadIdx.x * 8;
  float4 a = *(const float4*)(src + i), b = *(const float4*)(src + i + 4);
  *(uint4*)(dst + i) = make_uint4(pack2(a.x, a.y), pack2(a.z, a.w), pack2(b.x, b.y), pack2(b.z, b.w));
}

DI void p0_lb(const P& p) {
  float* LB = (float*)(p.ws + OFF_LB);
  for (int c = threadIdx.x; c < 1024; c += 256) {
    float a = p.lower_bounds[c], b = p.lower_bounds[1024 + c];
    LB[c] = 1.f / (1.f + expf(b - a));
  }
}

DI void p0_s5const(const P& p, int job) {
  int idx = job * 256 + threadIdx.x;
  int g = idx >> 6;
  float re = fminf(p.a_re[idx], -1e-4f), im = p.a_im[idx];
  float dl = expf(p.log_step[g]);
  float mag = expf(re * dl);
  float sn, cs;
  sincosf(im * dl, &sn, &cs);
  float ax = mag * cs, ay = mag * sn;
  float nx = ax - 1.f, ny = ay;
  float d2 = re * re + im * im;
  float cr = (nx * re + ny * im) / d2, ci = (ny * re - nx * im) / d2;
  float2* ABAR = (float2*)(p.ws + OFF_ABAR);
  float2* APOW = (float2*)(p.ws + OFF_APOW);
  float2* BBAR = (float2*)(p.ws + OFF_BBAR);
  ABAR[idx] = make_float2(ax, ay);
  float x = ax, y = ay, x16 = 0.f, y16 = 0.f;
#pragma unroll
  for (int i = 0; i < 5; ++i) {
    float nx2 = x * x - y * y, ny2 = 2.f * x * y;
    x = nx2; y = ny2;
    if (i == 3) { x16 = x; y16 = y; }
  }
  APOW[idx] = make_float2(x * x16 - y * y16, x * y16 + y * x16);
#pragma unroll
  for (int c = 0; c < 16; ++c) {
    float br = p.b_re[idx * 16 + c], bi = p.b_im[idx * 16 + c];
    BBAR[idx * 16 + c] = make_float2(cr * br - ci * bi, cr * bi + ci * br);
  }
}

DI void rms_row_to_bf16(const float* __restrict__ src, const float* __restrict__ w, u16* __restrict__ dst, int lane) {
  float4 v[4];
  float ss = 0.f;
#pragma unroll
  for (int i = 0; i < 4; ++i) {
    v[i] = *(const float4*)(src + i * 256 + lane * 4);
    ss += v[i].x * v[i].x + v[i].y * v[i].y + v[i].z * v[i].z + v[i].w * v[i].w;
  }
  ss = wave_sum(ss);
  float rs = rsqrtf(ss * (1.f / 1024.f) + EPS);
#pragma unroll
  for (int i = 0; i < 4; ++i) {
    float4 ww = *(const float4*)(w + i * 256 + lane * 4);
    uint2 o = make_uint2(pack2(v[i].x * rs * ww.x, v[i].y * rs * ww.y), pack2(v[i].z * rs * ww.z, v[i].w * rs * ww.w));
    *(uint2*)(dst + i * 256 + lane * 4) = o;
  }
}

DI void phase0(const P& p, int job, char* smem) {
  if (job < 1792) p0_transpose(p.w_in, 1024, 7168, (u16*)(p.ws + OFF_WTIN), job, smem);
  else if (job < 2048) p0_transpose(p.w_glu, 1024, 1024, (u16*)(p.ws + OFF_WTGLU), job - 1792, smem);
  else if (job < 2304) p0_transpose(p.w_a, 1024, 1024, (u16*)(p.ws + OFF_WTA), job - 2048, smem);
  else if (job < 2560) p0_transpose(p.w_b, 1024, 1024, (u16*)(p.ws + OFF_WTB), job - 2304, smem);
  else if (job < 2816) p0_transpose(p.w_out, 1024, 1024, (u16*)(p.ws + OFF_WTOUT), job - 2560, smem);
  else if (job < 3328) p0_transpose(p.peer_wq, 1024, 2048, (u16*)(p.ws + OFF_WTQ), job - 2816, smem);
  else if (job < 3392) p0_convert(p.k1, (u16*)(p.ws + OFF_K1), job - 3328);
  else if (job < 3456) p0_convert(p.k2, (u16*)(p.ws + OFF_K2), job - 3392);
  else if (job == 3456) p0_lb(p);
  else if (job < 3473) p0_s5const(p, job - 3457);
  else {
    int tk = (job - 3473) * 4 + (threadIdx.x >> 6);
    rms_row_to_bf16(xrow(p, tk), p.norm1_w, unitp(p, 0) + (size_t)tk * 1024, threadIdx.x & 63);
  }
}
constexpr int NJ0 = 3473 + T / 4;

DI void phase1(const P& p, int job, char* smem) {
  const int pm = job / 56, pn = job - pm * 56;
  const int brow = pm * 128, bcol = pn * 128;
  f32x4 acc[4][4];
  ZERO_ACC(acc);
  gemm_core(unitp(p, 0), 1024, (const u16*)(p.ws + OFF_WTIN), 1024, 1024, brow, bcol, smem, acc);
  EPI_VARS;
  const int region = pn >> 3;
  const int cbase = bcol - region * 1024;
  if (region == 2) {
    u16* VT = unitp(p, 3);
    int vb = ((brow >> 4) + wr * 4) * 16384 + (cbase + wc * 64 + fr) * 16 + fq * 4;
    asm volatile("" : "+v"(vb));
    EPI_LOOP { *(s16x4*)(VT + vb + m * 16384 + n * 256) = pack4(acc[m][n]); }
  } else {
    u16* dst = unitp(p, region == 0 ? 1 : region == 1 ? 2 : region + 1);
    EPI_BASE(1024, brow, cbase);
    EPI_LOOP {
#pragma unroll
      for (int j = 0; j < 4; ++j) {
        float v = acc[m][n][j];
        if (region == 0 || region == 3) v = siluf_(v);
        else if (region >= 5) v = sigmoidf_(v);
        dst[idx0 + (m * 16 + j) * 1024 + n * 16] = f2bf(v);
      }
    }
  }
}
constexpr int NJ1 = 133 * 56;

DI void p2_hgrn_pre(const P& p, int job, char* smem) {
  const int tid = threadIdx.x, wave = tid >> 6, lane = tid & 63, fr = lane & 15, fq = lane >> 4;
  const int chunk = job >> 1, h = (job & 1) * 4 + wave;
  const int tok0 = chunk * 16;
  u16* R1 = unitp(p, 1);
  const u16* R2 = unitp(p, 2);
  const u16* VT = unitp(p, 3);
  u16* OIN = unitp(p, 0);
  u16* KTT = (u16*)((char*)p.out + OOFF_KTT);
  float* DEC = (float*)((char*)p.out + OOFF_DEC);
  const float* LB = (const float*)(p.ws + OFF_LB);
  char* sq = smem + wave * 8704;
  char* sk = sq + 4352;
  const int c0 = h * 128 + lane * 2;
  const float lb0 = LB[c0], lb1 = LB[c0 + 1];
  float b0 = 0.f, b1 = 0.f;
  float kn0[16], kn1[16];
#pragma unroll
  for (int t = 0; t < 16; ++t) {
    size_t gi = (size_t)(tok0 + t) * 1024 + c0;
    unsigned q2 = *(const unsigned*)(R1 + gi), f2 = *(const unsigned*)(R2 + gi);
    float f0 = bflo(f2), f1 = bfhi(f2);
    float e0 = __expf(-f0), e1 = __expf(-f1);
    float fg0 = lb0 + (1.f - lb0) / (1.f + e0), fg1 = lb1 + (1.f - lb1) / (1.f + e1);
    float k0 = (1.f - lb0) * e0 / (1.f + e0), k1 = (1.f - lb1) * e1 / (1.f + e1);
    b0 += __logf(fg0);
    b1 += __logf(fg1);
    float qt0 = bflo(q2) * __expf(b0), qt1 = bfhi(q2) * __expf(b1);
    kn0[t] = k0 * __expf(-b0);
    kn1[t] = k1 * __expf(-b1);
    unsigned qp = pack2(qt0, qt1);
    *(unsigned*)(R1 + gi) = qp;
    *(unsigned*)(sq + t * 272 + lane * 4) = qp;
    *(unsigned*)(sk + t * 272 + lane * 4) = pack2(kn0[t], kn1[t]);
  }
  const float eb0 = __expf(b0), eb1 = __expf(b1);
  *(float2*)(DEC + (size_t)chunk * 1024 + c0) = make_float2(eb0, eb1);
  {
    unsigned w0[8], w1[8];
#pragma unroll
    for (int i = 0; i < 8; ++i) {
      w0[i] = pack2(kn0[2 * i] * eb0, kn0[2 * i + 1] * eb0);
      w1[i] = pack2(kn1[2 * i] * eb1, kn1[2 * i + 1] * eb1);
    }
    uint4* kd = (uint4*)(KTT + ((size_t)chunk * 1024 + c0) * 16);
    kd[0] = make_uint4(w0[0], w0[1], w0[2], w0[3]);
    kd[1] = make_uint4(w0[4], w0[5], w0[6], w0[7]);
    kd[2] = make_uint4(w1[0], w1[1], w1[2], w1[3]);
    kd[3] = make_uint4(w1[4], w1[5], w1[6], w1[7]);
  }
  __syncthreads();
  f32x4 at = {0.f, 0.f, 0.f, 0.f};
#pragma unroll
  for (int ks = 0; ks < 4; ++ks) {
    s16x8 a = *(const s16x8*)(sk + fr * 272 + ks * 64 + fq * 16);
    s16x8 b = *(const s16x8*)(sq + fr * 272 + ks * 64 + fq * 16);
    at = mfma32(a, b, at);
  }
  asm volatile("s_nop 15\n\ts_nop 15" : "+v"(at));
#pragma unroll
  for (int j = 0; j < 4; ++j)
    if (4 * fq + j > fr) at[j] = 0.f;
  s16x4 af = pack4(at);
  asm volatile("s_nop 7" : "+v"(af));
#pragma unroll
  for (int nt = 0; nt < 8; ++nt) {
    size_t vi = ((size_t)chunk * 1024 + h * 128 + nt * 16 + fr) * 16 + 4 * fq;
    s16x4 vb = *(const s16x4*)(VT + vi);
    f32x4 o = mfma16(af, vb, f32x4{0.f, 0.f, 0.f, 0.f});
    asm volatile("s_nop 15\n\ts_nop 15" : "+v"(o));
    *(s16x4*)(OIN + vi) = pack4(o);
  }
  __syncthreads();
}

DI void s5_load_bbar(const P& p, int g, int pp, float (&br)[16], float (&bi)[16]) {
  const float4* B = (const float4*)((const float2*)(p.ws + OFF_BBAR) + ((size_t)g * 64 + pp) * 16);
#pragma unroll
  for (int i = 0; i < 8; ++i) {
    float4 v = B[i];
    br[2 * i] = v.x; bi[2 * i] = v.y; br[2 * i + 1] = v.z; bi[2 * i + 1] = v.w;
  }
}
DI void s5_step(const uint4& ua, const uint4& ub, int t, const float (&br)[16], const float (&bi)[16], float ax, float ay,
                float& xr, float& xi) {
  unsigned uu[8] = {(unsigned)__builtin_amdgcn_readlane((int)ua.x, t), (unsigned)__builtin_amdgcn_readlane((int)ua.y, t),
                    (unsigned)__builtin_amdgcn_readlane((int)ua.z, t), (unsigned)__builtin_amdgcn_readlane((int)ua.w, t),
                    (unsigned)__builtin_amdgcn_readlane((int)ub.x, t), (unsigned)__builtin_amdgcn_readlane((int)ub.y, t),
                    (unsigned)__builtin_amdgcn_readlane((int)ub.z, t), (unsigned)__builtin_amdgcn_readlane((int)ub.w, t)};
  float sr = 0.f, si = 0.f;
#pragma unroll
  for (int i = 0; i < 8; ++i) {
    float a = bflo(uu[i]), b = bfhi(uu[i]);
    sr += br[2 * i] * a + br[2 * i + 1] * b;
    si += bi[2 * i] * a + bi[2 * i + 1] * b;
  }
  float nr = ax * xr - ay * xi + sr, ni = ax * xi + ay * xr + si;
  xr = nr; xi = ni;
}

DI void p2_s5a(const P& p, int job) {
  const int gq = job & 15, nc = job >> 4;
  const int n = nc / 43, c = nc - n * 43;
  const int tid = threadIdx.x, g = gq * 4 + (tid >> 6), pp = tid & 63;
  float br[16], bi[16];
  s5_load_bbar(p, g, pp, br, bi);
  const float2 ab = ((const float2*)(p.ws + OFF_ABAR))[g * 64 + pp];
  const u16* U = unitp(p, 5) + (size_t)(n * LP + c * 48) * 1024 + g * 16;
  float xr = 0.f, xi = 0.f;
  uint4 ua, ub;
  {
    const u16* r = U + (size_t)min(pp, 47) * 1024;
    ua = *(const uint4*)r;
    ub = *(const uint4*)(r + 8);
  }
#pragma unroll 4
  for (int t = 0; t < 48; ++t) s5_step(ua, ub, t, br, bi, ab.x, ab.y, xr, xi);
  float2* E = (float2*)((char*)p.out + OOFF_E);
  E[((size_t)(n * 43 + c) * 64 + g) * 64 + pp] = make_float2(xr, xi);
}
constexpr int NJ2_H = 2064, NJ2_S = 8 * 43 * 16;
constexpr int NJ2 = NJ2_H + NJ2_S;

#define SEQ_GLOAD(cg_, P)                                                                              \
  {                                                                                                    \
    const int cgv = (cg_);                                                                             \
    P##rq = *(const uint4*)(QT + (size_t)(cgv * 16 + (tid >> 4)) * 1024 + h * 128 + (tid & 15) * 8);  \
    P##rk = *(const uint4*)(KTT + ((size_t)cgv * 1024 + h * 128) * 16 + tid * 8);                      \
    if (tid < 32) P##rd = *(const float4*)(DEC + (size_t)cgv * 1024 + h * 128 + tid * 4);              \
    size_t vi0 = ((size_t)cgv * 1024 + h * 128 + wave * 32 + fr) * 16 + 4 * fq;                        \
    P##rv0 = *(const s16x4*)(VT + vi0);                                                                \
    P##rv1 = *(const s16x4*)(VT + vi0 + 256);                                                          \
    P##ro0 = *(const s16x4*)(OIN + vi0);                                                               \
    P##ro1 = *(const s16x4*)(OIN + vi0 + 256);                                                         \
  }
#define SEQ_LSTORE(b_, P)                                                  \
  {                                                                        \
    char* lb_ = smem + (b_) * 8960;                                        \
    *(uint4*)(lb_ + (tid >> 4) * 272 + (tid & 15) * 16) = P##rq;           \
    *(uint4*)(lb_ + 4352 + tid * 16) = P##rk;                              \
    if (tid < 32) *(float4*)(lb_ + 8448 + tid * 16) = P##rd;               \
  }
#define SEQ_BODY(c_, X, Y)                                                                                   \
  {                                                                                                          \
    const int c = (c_);                                                                                      \
    const int b = c & 1;                                                                                     \
    const int tok0 = (cg0 + c) * 16;                                                                         \
    if (c + 2 < NCHK) SEQ_GLOAD(cg0 + c + 2, X)                                                              \
    const char* base = smem + b * 8960;                                                                      \
    f32x4 o0 = f32x4{0.f, 0.f, 0.f, 0.f}, o1 = f32x4{0.f, 0.f, 0.f, 0.f};                                    \
    _Pragma("unroll") for (int ks = 0; ks < 4; ++ks) {                                                       \
      s16x4 qa = *(const s16x4*)(base + fr * 272 + (ks * 32 + 4 * fq) * 2);                                  \
      s16x4 qb = *(const s16x4*)(base + fr * 272 + (ks * 32 + 16 + 4 * fq) * 2);                             \
      s16x8 Af = __builtin_shufflevector(qa, qb, 0, 1, 2, 3, 4, 5, 6, 7);                                    \
      s16x8 B0 = pack8(S[2 * ks][0], S[2 * ks + 1][0]), B1 = pack8(S[2 * ks][1], S[2 * ks + 1][1]);          \
      asm volatile("s_nop 7" : "+v"(B0), "+v"(B1), "+v"(Af));                                                \
      o0 = mfma32(Af, B0, o0);                                                                               \
      o1 = mfma32(Af, B1, o1);                                                                               \
    }                                                                                                        \
    asm volatile("s_nop 15\n\ts_nop 15" : "+v"(o0), "+v"(o1));                                               \
    _Pragma("unroll") for (int j = 0; j < 4; ++j) {                                                          \
      u16* orow = ORAW + (size_t)(tok0 + 4 * fq + j) * 1024 + h * 128 + wave * 32 + fr;                      \
      orow[0] = f2bf(o0[j] + bf2f((u16)co0[j]));                                                             \
      orow[16] = f2bf(o1[j] + bf2f((u16)co1[j]));                                                            \
    }                                                                                                        \
    _Pragma("unroll") for (int mt = 0; mt < 8; ++mt) {                                                       \
      f32x4 d = *(const f32x4*)(base + 8448 + (mt * 16 + 4 * fq) * 4);                                       \
      s16x4 ka = *(const s16x4*)(base + 4352 + (mt * 16 + fr) * 32 + fq * 8);                                \
      f32x4 s0 = S[mt][0] * d, s1 = S[mt][1] * d;                                                            \
      asm volatile("s_nop 7" : "+v"(s0), "+v"(s1), "+v"(ka));                                                \
      S[mt][0] = mfma16(ka, cv0, s0);                                                                        \
      S[mt][1] = mfma16(ka, cv1, s1);                                                                        \
    }                                                                                                        \
    asm volatile("s_nop 15\n\ts_nop 15" : "+v"(S[0][0]), "+v"(S[0][1]), "+v"(S[1][0]), "+v"(S[1][1]), "+v"(S[2][0]), "+v"(S[2][1]), "+v"(S[3][0]), "+v"(S[3][1]), "+v"(S[4][0]), "+v"(S[4][1]), "+v"(S[5][0]), "+v"(S[5][1]), "+v"(S[6][0]), "+v"(S[6][1]), "+v"(S[7][0]), "+v"(S[7][1])); \
    if (c + 1 < NCHK) SEQ_LSTORE(b ^ 1, Y)                                                                   \
    asm volatile("s_waitcnt lgkmcnt(0)\n\ts_barrier" ::: "memory");                                         \
    if (c + 1 < NCHK) { cv0 = Y##rv0; cv1 = Y##rv1; co0 = Y##ro0; co1 = Y##ro1; }                            \
  }
DI void p3_hgrn_seq(const P& p, int job, char* smem) {
  const int tid = threadIdx.x, wave = tid >> 6, lane = tid & 63, fr = lane & 15, fq = lane >> 4;
  const int n = job >> 3, h = job & 7;
  const u16* QT = unitp(p, 1);
  const u16* KTT = (const u16*)((const char*)p.out + OOFF_KTT);
  const float* DEC = (const float*)((const char*)p.out + OOFF_DEC);
  const u16* VT = unitp(p, 3);
  const u16* OIN = unitp(p, 0);
  u16* ORAW = unitp(p, 2);
  f32x4 S[8][2];
#pragma unroll
  for (int mt = 0; mt < 8; ++mt) { S[mt][0] = f32x4{0.f, 0.f, 0.f, 0.f}; S[mt][1] = f32x4{0.f, 0.f, 0.f, 0.f}; }
  const int cg0 = n * NCHK;
  uint4 Arq, Ark, Brq, Brk;
  float4 Ard = make_float4(0.f, 0.f, 0.f, 0.f), Brd = make_float4(0.f, 0.f, 0.f, 0.f);
  s16x4 Arv0, Arv1, Aro0, Aro1, Brv0, Brv1, Bro0, Bro1, cv0, cv1, co0, co1;
  SEQ_GLOAD(cg0, A)
  SEQ_LSTORE(0, A)
  cv0 = Arv0; cv1 = Arv1; co0 = Aro0; co1 = Aro1;
  SEQ_GLOAD(cg0 + 1, B)
  __syncthreads();
  for (int cc = 0; cc < NCHK - 1; cc += 2) {
    SEQ_BODY(cc, A, B)
    SEQ_BODY(cc + 1, B, A)
  }
  SEQ_BODY(NCHK - 1, A, B)
  float* HG = p.out + O_HGP + ((size_t)(n * 8 + h) * 128) * 128;
#pragma unroll
  for (int mt = 0; mt < 8; ++mt)
#pragma unroll
    for (int nt = 0; nt < 2; ++nt)
#pragma unroll
      for (int j = 0; j < 4; ++j) HG[(size_t)(mt * 16 + 4 * fq + j) * 128 + wave * 32 + nt * 16 + fr] = S[mt][nt][j];
}

DI void p3_hgrn_sample(const P& p, int job, char* smem) {
  const int tid = threadIdx.x;
  const int ns = job >> 3, h = job & 7;
  const int v = tid & 127, kh = tid >> 7;
  const u16* R1 = unitp(p, 1);
  const u16* R2 = unitp(p, 2 + 0);
  const u16* VT = unitp(p, 3);
  u16* ORAW = unitp(p, 2);
  const float* LB = (const float*)(p.ws + OFF_LB);
  float* sg = (float*)smem;
  float* skk = sg + 512;
  float* sq = skk + 512;
  float* so = sq + 512;
  const int tokb = TP + ns * 4;
  float fraw[4];
  if (tid < 128) {
    const float lb = LB[h * 128 + tid];
#pragma unroll
    for (int t = 0; t < 4; ++t) {
      size_t gi = (size_t)(tokb + t) * 1024 + h * 128 + tid;
      float f = bf2f(R2[gi]);
      fraw[t] = f;
      float e = __expf(-f);
      sg[t * 128 + tid] = lb + (1.f - lb) / (1.f + e);
      skk[t * 128 + tid] = (1.f - lb) * e / (1.f + e);
      sq[t * 128 + tid] = bf2f(R1[gi]);
    }
  }
  (void)fraw;
  float S[64];
  const float* st = p.state_hgrn + ((size_t)(ns * 8 + h) * 128 + kh * 64) * 128 + v;
#pragma unroll
  for (int i = 0; i < 64; ++i) S[i] = st[(size_t)i * 128];
  float vt[4];
#pragma unroll
  for (int t = 0; t < 4; ++t) {
    int tok = tokb + t;
    vt[t] = bf2f(VT[((size_t)(tok >> 4) * 1024 + h * 128 + v) * 16 + (tok & 15)]);
  }
  __syncthreads();
#pragma unroll
  for (int t = 0; t < 4; ++t) {
    float op = 0.f;
#pragma unroll
    for (int i = 0; i < 64; ++i) {
      int k = t * 128 + kh * 64 + i;
      S[i] = sg[k] * S[i] + skk[k] * vt[t];
      op += sq[k] * S[i];
    }
    so[(t * 2 + kh) * 128 + v] = op;
  }
  float* HG = p.out + O_HGS + ((size_t)(ns * 8 + h) * 128 + kh * 64) * 128 + v;
#pragma unroll
  for (int i = 0; i < 64; ++i) HG[(size_t)i * 128] = S[i];
  __syncthreads();
  if (tid < 128) {
#pragma unroll
    for (int t = 0; t < 4; ++t)
      ORAW[(size_t)(tokb + t) * 1024 + h * 128 + tid] = f2bf(so[(t * 2) * 128 + tid] + so[(t * 2 + 1) * 128 + tid]);
  }
  __syncthreads();
}

DI void p3_s5c(const P& p, int mode, int seq, int c, int gq, char* smem) {
  const int tid = threadIdx.x, wave = tid >> 6, lane = tid & 63, fr = lane & 15, fq = lane >> 4;
  const int g = gq * 4 + wave, pp = lane;
  float br[16], bi[16];
  s5_load_bbar(p, g, pp, br, bi);
  const float2 ab = ((const float2*)(p.ws + OFF_ABAR))[g * 64 + pp];
  float xr, xi;
  int tok0, ntok;
  if (mode == 0) {
    const float2 ap = ((const float2*)(p.ws + OFF_APOW))[g * 64 + pp];
    const float2* E = (const float2*)((const char*)p.out + OOFF_E) + ((size_t)(seq * 43) * 64 + g) * 64 + pp;
    xr = 0.f; xi = 0.f;
    for (int j0 = 0; j0 < c; j0 += 8) {
      float2 e[8];
#pragma unroll
      for (int i = 0; i < 8; ++i) e[i] = E[(size_t)min(j0 + i, c - 1) * 4096];
#pragma unroll
      for (int i = 0; i < 8; ++i)
        if (j0 + i < c) {
          float nr = ap.x * xr - ap.y * xi + e[i].x, ni = ap.x * xi + ap.y * xr + e[i].y;
          xr = nr; xi = ni;
        }
    }
    tok0 = seq * LP + c * 48;
    ntok = 48;
  } else {
    xr = p.ssm_re[((size_t)seq * 64 + g) * 64 + pp];
    xi = p.ssm_im[((size_t)seq * 64 + g) * 64 + pp];
    tok0 = TP + seq * 4;
    ntok = 4;
  }
  s16x8 cf[4];
#pragma unroll
  for (int ks = 0; ks < 4; ++ks) {
    int p0 = ks * 32 + fq * 8;
    const float* src = (p0 < 64 ? p.c_re : p.c_im) + ((size_t)g * 16 + fr) * 64 + (p0 & 63);
    float sgn = p0 < 64 ? 1.f : -1.f;
    float4 a = *(const float4*)src, b = *(const float4*)(src + 4);
    uint4 u = make_uint4(pack2(sgn * a.x, sgn * a.y), pack2(sgn * a.z, sgn * a.w), pack2(sgn * b.x, sgn * b.y),
                         pack2(sgn * b.z, sgn * b.w));
    cf[ks] = __builtin_bit_cast(s16x8, u);
  }
  const float dsk = p.ssm_d[g * 16 + fr];
  u16* U = unitp(p, 5);
  char* xs = smem + wave * 4352;
  const int nsub = (ntok + 15) >> 4;
  uint4 ua, ub;
  {
    const u16* r = U + (size_t)(tok0 + min(pp, ntok - 1)) * 1024 + g * 16;
    ua = *(const uint4*)r;
    ub = *(const uint4*)(r + 8);
  }
  for (int sc = 0; sc < nsub; ++sc) {
    const int tb = tok0 + sc * 16;
    const int nt = min(16, ntok - sc * 16);
#pragma unroll 4
    for (int t = 0; t < 16; ++t) {
      if (t < nt) {
        s5_step(ua, ub, sc * 16 + t, br, bi, ab.x, ab.y, xr, xi);
        *(u16*)(xs + t * 272 + pp * 2) = f2bf(xr);
        *(u16*)(xs + t * 272 + 128 + pp * 2) = f2bf(xi);
      } else {
        *(u16*)(xs + t * 272 + pp * 2) = 0;
        *(u16*)(xs + t * 272 + 128 + pp * 2) = 0;
      }
    }
    __syncthreads();
    f32x4 y = {0.f, 0.f, 0.f, 0.f};
#pragma unroll
    for (int ks = 0; ks < 4; ++ks) {
      s16x8 a = *(const s16x8*)(xs + fr * 272 + ks * 64 + fq * 16);
      y = mfma32(a, cf[ks], y);
    }
    asm volatile("s_nop 15\n\ts_nop 15" : "+v"(y));
#pragma unroll
    for (int j = 0; j < 4; ++j) {
      int t = 4 * fq + j;
      if (t < nt) {
        size_t gi = (size_t)(tb + t) * 1024 + g * 16 + fr;
        float uu = bf2f(U[gi]);
        U[gi] = f2bf(geluf_(y[j] + dsk * uu));
      }
    }
    __syncthreads();
  }
  if (mode == 0) {
    if (c == 42) {
      p.out[O_SRP + ((size_t)seq * 64 + g) * 64 + pp] = xr;
      p.out[O_SIP + ((size_t)seq * 64 + g) * 64 + pp] = xi;
    }
  } else {
    p.out[O_SRS + ((size_t)seq * 64 + g) * 64 + pp] = xr;
    p.out[O_SIS + ((size_t)seq * 64 + g) * 64 + pp] = xi;
  }
}
DI void p3_s5chain(const P& p, int job, char* smem) {
  const int tid = threadIdx.x, wave = tid >> 6, lane = tid & 63, fr = lane & 15, fq = lane >> 4;
  const int n = job >> 4, gq = job & 15;
  const int g = gq * 4 + wave, pp = lane;
  const float2 ab = ((const float2*)(p.ws + OFF_ABAR))[g * 64 + pp];
  s16x4 bb[8];
#pragma unroll
  for (int nt = 0; nt < 8; ++nt) {
    const float4* src = (const float4*)((const float2*)(p.ws + OFF_BBAR) + ((size_t)g * 64 + (nt & 3) * 16 + fr) * 16 + 4 * fq);
    float4 v0 = src[0], v1 = src[1];
    f32x4 sel = (nt < 4) ? f32x4{v0.x, v0.z, v1.x, v1.z} : f32x4{v0.y, v0.w, v1.y, v1.w};
    bb[nt] = pack4(sel);
  }
  s16x8 cf[4];
#pragma unroll
  for (int ks = 0; ks < 4; ++ks) {
    int p0 = ks * 32 + fq * 8;
    const float* src = (p0 < 64 ? p.c_re : p.c_im) + ((size_t)g * 16 + fr) * 64 + (p0 & 63);
    float sgn = p0 < 64 ? 1.f : -1.f;
    float4 a = *(const float4*)src, b = *(const float4*)(src + 4);
    uint4 u = make_uint4(pack2(sgn * a.x, sgn * a.y), pack2(sgn * a.z, sgn * a.w), pack2(sgn * b.x, sgn * b.y),
                         pack2(sgn * b.z, sgn * b.w));
    cf[ks] = __builtin_bit_cast(s16x8, u);
  }
  const float dsk = p.ssm_d[g * 16 + fr];
  u16* U = unitp(p, 5);
  char* xs = smem + wave * 12800;
  float* bu = (float*)(xs + 4352);
  float xr = 0.f, xi = 0.f;
  const int tokb = n * LP;
  s16x4 ua[3], na[3];
  u16 us[3][4], ns[3][4];
#pragma unroll
  for (int sc = 0; sc < 3; ++sc) {
    ua[sc] = *(const s16x4*)(U + (size_t)(tokb + sc * 16 + fr) * 1024 + g * 16 + 4 * fq);
#pragma unroll
    for (int j = 0; j < 4; ++j) us[sc][j] = U[(size_t)(tokb + sc * 16 + 4 * fq + j) * 1024 + g * 16 + fr];
  }
  for (int c = 0; c < 43; ++c) {
#pragma unroll
    for (int sc = 0; sc < 3; ++sc) {
      na[sc] = ua[sc];
#pragma unroll
      for (int j = 0; j < 4; ++j) ns[sc][j] = us[sc][j];
      if (c + 1 < 43) {
        na[sc] = *(const s16x4*)(U + (size_t)(tokb + (c + 1) * 48 + sc * 16 + fr) * 1024 + g * 16 + 4 * fq);
#pragma unroll
        for (int j = 0; j < 4; ++j) ns[sc][j] = U[(size_t)(tokb + (c + 1) * 48 + sc * 16 + 4 * fq + j) * 1024 + g * 16 + fr];
      }
    }
#pragma unroll
    for (int sc = 0; sc < 3; ++sc) {
      const int tb = tokb + c * 48 + sc * 16;
      s16x4 au = ua[sc];
      asm volatile("s_nop 3" : "+v"(au));
      f32x4 r[8];
#pragma unroll
      for (int nt = 0; nt < 8; ++nt) r[nt] = mfma16(au, bb[nt], f32x4{0.f, 0.f, 0.f, 0.f});
      asm volatile("s_nop 15" : "+v"(r[0]), "+v"(r[1]), "+v"(r[2]), "+v"(r[3]), "+v"(r[4]), "+v"(r[5]), "+v"(r[6]), "+v"(r[7]));
#pragma unroll
      for (int nt = 0; nt < 8; ++nt)
#pragma unroll
        for (int j = 0; j < 4; ++j) bu[(4 * fq + j) * 132 + nt * 16 + fr] = r[nt][j];
      __builtin_amdgcn_wave_barrier();
      float bre[16], bim[16];
#pragma unroll
      for (int t = 0; t < 16; ++t) { bre[t] = bu[t * 132 + pp]; bim[t] = bu[t * 132 + 64 + pp]; }
#pragma unroll
      for (int t = 0; t < 16; ++t) {
        float nr = ab.x * xr - ab.y * xi + bre[t], ni = ab.x * xi + ab.y * xr + bim[t];
        xr = nr; xi = ni;
        *(u16*)(xs + t * 272 + pp * 2) = f2bf(xr);
        *(u16*)(xs + t * 272 + 128 + pp * 2) = f2bf(xi);
      }
      __builtin_amdgcn_wave_barrier();
      f32x4 y = {0.f, 0.f, 0.f, 0.f};
#pragma unroll
      for (int ks = 0; ks < 4; ++ks) {
        s16x8 a = *(const s16x8*)(xs + fr * 272 + ks * 64 + fq * 16);
        y = mfma32(a, cf[ks], y);
      }
      asm volatile("s_nop 15\n\ts_nop 15" : "+v"(y));
#pragma unroll
      for (int j = 0; j < 4; ++j) {
        size_t gi = (size_t)(tb + 4 * fq + j) * 1024 + g * 16 + fr;
        U[gi] = f2bf(geluf_(y[j] + dsk * bf2f(us[sc][j])));
      }
    }
#pragma unroll
    for (int sc = 0; sc < 3; ++sc) {
      ua[sc] = na[sc];
#pragma unroll
      for (int j = 0; j < 4; ++j) us[sc][j] = ns[sc][j];
    }
  }
  p.out[O_SRP + ((size_t)n * 64 + g) * 64 + pp] = xr;
  p.out[O_SIP + ((size_t)n * 64 + g) * 64 + pp] = xi;
}
constexpr int NJ3_A = 64, NJ3_CH = 128, NJ3_B = 1024, NJ3_D = 128 * 16;
constexpr int NJ3_REST = NJ3_B + NJ3_D;
DI void phase3rest(const P& p, int job, char* smem) {
  if (job < NJ3_B) p3_hgrn_sample(p, job, smem);
  else { int j = job - NJ3_B; p3_s5c(p, 1, j >> 4, 0, j & 15, smem); }
}

DI void p4_onorm(const P& p, int job) {
  const int lane = threadIdx.x & 63;
  const int tk = job * 4 + (threadIdx.x >> 6);
  u16* O = unitp(p, 2) + (size_t)tk * 1024 + lane * 16;
  const u16* SG = unitp(p, 4) + (size_t)tk * 1024 + lane * 16;
  uint4 a0 = *(const uint4*)O, a1 = *(const uint4*)(O + 8);
  uint4 g0 = *(const uint4*)SG, g1 = *(const uint4*)(SG + 8);
  unsigned ov[8] = {a0.x, a0.y, a0.z, a0.w, a1.x, a1.y, a1.z, a1.w};
  unsigned gv[8] = {g0.x, g0.y, g0.z, g0.w, g1.x, g1.y, g1.z, g1.w};
  float ss = 0.f;
#pragma unroll
  for (int i = 0; i < 8; ++i) { float a = bflo(ov[i]), b = bfhi(ov[i]); ss += a * a + b * b; }
  ss += __shfl_xor(ss, 1);
  ss += __shfl_xor(ss, 2);
  ss += __shfl_xor(ss, 4);
  const float rs = rsqrtf(ss * (1.f / 128.f) + EPS);
  const float* gw = p.g_norm_w + (lane & 7) * 16;
  unsigned r[8];
#pragma unroll
  for (int i = 0; i < 8; ++i) {
    float a = bflo(ov[i]) * rs * gw[2 * i] * bflo(gv[i]);
    float b = bfhi(ov[i]) * rs * gw[2 * i + 1] * bfhi(gv[i]);
    r[i] = pack2(a, b);
  }
  *(uint4*)O = make_uint4(r[0], r[1], r[2], r[3]);
  *(uint4*)(O + 8) = make_uint4(r[4], r[5], r[6], r[7]);
}
DI void p4_glu(const P& p, int job, char* smem) {
  const int pm = job >> 3, pn = job & 7;
  const int brow = pm * 128, bcol = pn * 128;
  f32x4 acc[4][4];
  ZERO_ACC(acc);
  const u16* Y = unitp(p, 5);
  gemm_core(Y, 1024, (const u16*)(p.ws + OFF_WTGLU), 1024, 1024, brow, bcol, smem, acc);
  EPI_VARS;
  u16* Z = unitp(p, 1);
  EPI_BASE(1024, brow, bcol);
  EPI_LOOP {
    float bb = p.b_glu[bcol + wc * 64 + n * 16 + fr];
#pragma unroll
    for (int j = 0; j < 4; ++j) {
      int gi = idx0 + (m * 16 + j) * 1024 + n * 16;
      Z[gi] = f2bf(bf2f(Y[gi]) * sigmoidf_(acc[m][n][j] + bb));
    }
  }
}
constexpr int NJ4_A = T / 4, NJ4 = NJ4_A + 133 * 8;

DI void phase5(const P& p, int job, char* smem) {
  const int pm = job >> 3, pn = job & 7;
  const int brow = pm * 128, bcol = pn * 128;
  EPI_VARS;
  u16* MX = unitp(p, 3);
#pragma unroll 1
  for (int pass = 0; pass < 2; ++pass) {
    f32x4 acc[4][4];
    ZERO_ACC(acc);
    gemm_core(unitp(p, pass ? 1 : 2), 1024, (const u16*)(p.ws + (pass ? OFF_WTB : OFF_WTA)), 1024, 1024, brow, bcol,
              smem, acc);
    const u16* GT = unitp(p, 6 + pass);
    EPI_BASE(1024, brow, bcol);
    EPI_LOOP {
#pragma unroll
      for (int j = 0; j < 4; ++j) {
        int gi = idx0 + (m * 16 + j) * 1024 + n * 16;
        float prev = pass ? bf2f(MX[gi]) : 0.f;
        MX[gi] = f2bf(prev + acc[m][n][j] * bf2f(GT[gi]));
      }
    }
  }
}
constexpr int NJ5 = 133 * 8;

DI void phase6(const P& p, int job, char* smem) {
  const int pm = job >> 3, pn = job & 7;
  const int brow = pm * 128, bcol = pn * 128;
  EPI_VARS;
  f32x4 acc[4][4];
  ZERO_ACC(acc);
  gemm_core(unitp(p, 3), 1024, (const u16*)(p.ws + OFF_WTOUT), 1024, 1024, brow, bcol, smem, acc);
  float* X1 = (float*)unitp(p, 0);
  int rb = brow + wr * 64 + fq * 4, cbv = bcol + wc * 64 + fr;
  asm volatile("" : "+v"(rb), "+v"(cbv));
#pragma unroll
  for (int m = 0; m < 4; ++m) {
#pragma unroll
    for (int j = 0; j < 4; ++j) {
      const int row = rb + m * 16 + j;
      const float* xr = xrow(p, row) + cbv;
      float* xo = X1 + (size_t)row * 1024 + cbv;
#pragma unroll
      for (int n = 0; n < 4; ++n) xo[n * 16] = xr[n * 16] + acc[m][n][j];
    }
  }
}
constexpr int NJ6 = 133 * 8;

DI void phase7(const P& p, int job) {
  int tk = job * 4 + (threadIdx.x >> 6);
  rms_row_to_bf16((const float*)unitp(p, 0) + (size_t)tk * 1024, p.norm2_w, unitp(p, 2) + (size_t)tk * 1024,
                  threadIdx.x & 63);
}
constexpr int NJ7 = T / 4;
DI void convert_tables(const P& p, int j) {
  const float* src = (j < 4096 ? p.peer_u : p.peer_v) + (size_t)(j & 4095) * 4096 + threadIdx.x * 16;
  const float sc = j < 4096 ? 64.f : 16.f;
  unsigned char* dst = (unsigned char*)unitp(p, 6) + (size_t)j * 4096 + threadIdx.x * 16;
  unsigned w[4];
#pragma unroll
  for (int i = 0; i < 4; ++i) {
    float4 a = *(const float4*)(src + 4 * i);
    int d = __builtin_amdgcn_cvt_pk_fp8_f32(a.x * sc, a.y * sc, 0, false);
    d = __builtin_amdgcn_cvt_pk_fp8_f32(a.z * sc, a.w * sc, d, true);
    w[i] = (unsigned)d;
  }
  *(uint4*)dst = make_uint4(w[0], w[1], w[2], w[3]);
}

DI void phase8(const P& p, int job, char* smem) {
  const int pm = job >> 4, pn = job & 15;
  const int brow = pm * 128, bcol = pn * 128;
  EPI_VARS;
  f32x4 acc[4][4];
  ZERO_ACC(acc);
  gemm_core(unitp(p, 2), 1024, (const u16*)(p.ws + OFF_WTQ), 1024, 1024, brow, bcol, smem, acc);
  u16* Q = unitp(p, 3);
  EPI_BASE(2048, brow, bcol);
  EPI_LOOP {
#pragma unroll
    for (int j = 0; j < 4; ++j) Q[idx0 + (m * 16 + j) * 2048 + n * 16] = f2bf(acc[m][n][j]);
  }
}
constexpr int NJ8 = 133 * 16;

DI int f2key(float f) { int s = __float_as_int(f); return s ^ ((s >> 31) & 0x7fffffff); }
DI float key2f(int k) { return __int_as_float(k ^ ((k >> 31) & 0x7fffffff)); }
DI int rowmax16(int x) {
  x = max(x, __builtin_amdgcn_update_dpp(0, x, 0x128, 0xf, 0xf, false));
  x = max(x, __builtin_amdgcn_update_dpp(0, x, 0x124, 0xf, 0xf, false));
  x = max(x, __builtin_amdgcn_update_dpp(0, x, 0x122, 0xf, 0xf, false));
  x = max(x, __builtin_amdgcn_update_dpp(0, x, 0x121, 0xf, 0xf, false));
  return x;
}
DI void phase9(const P& p, int job) {
  const int tid = threadIdx.x, wave = tid >> 6, lane = tid & 63, fr = lane & 15, fq = lane >> 4;
  const int tile = job >> 1, h = (job & 1) * 4 + wave;
  const int tok0 = tile * 16;
  const u16* QRY = unitp(p, 3);
  int* EXPI = (int*)unitp(p, 5);
  float* GATE = (float*)((char*)unitp(p, 5) + (size_t)T * 128 * 4);
  float v12[2][4];
  int i12[2][4];
#pragma unroll
  for (int half = 0; half < 2; ++half) {
    f32x4 acc[8];
#pragma unroll
    for (int nt = 0; nt < 8; ++nt) acc[nt] = f32x4{0.f, 0.f, 0.f, 0.f};
    const u16* Kb = (const u16*)(p.ws + (half ? OFF_K2 : OFF_K1)) + (size_t)h * 128 * 128;
#pragma unroll
    for (int ks = 0; ks < 4; ++ks) {
      s16x8 a = *(const s16x8*)(QRY + (size_t)(tok0 + fr) * 2048 + h * 256 + half * 128 + ks * 32 + fq * 8);
#pragma unroll
      for (int nt = 0; nt < 8; ++nt) {
        s16x8 b = *(const s16x8*)(Kb + (size_t)(nt * 16 + fr) * 128 + ks * 32 + fq * 8);
        acc[nt] = mfma32(a, b, acc[nt]);
      }
    }
    asm volatile("s_nop 15\n\ts_nop 15" : "+v"(acc[0]), "+v"(acc[1]), "+v"(acc[2]), "+v"(acc[3]), "+v"(acc[4]), "+v"(acc[5]), "+v"(acc[6]), "+v"(acc[7]));
#pragma unroll
    for (int j = 0; j < 4; ++j) {
      int keys[8];
#pragma unroll
      for (int nt = 0; nt < 8; ++nt) keys[nt] = (f2key(acc[nt][j]) & ~127) | (127 - (nt * 16 + fr));
#define CX(a, b) { int hi_ = max(keys[a], keys[b]), lo_ = min(keys[a], keys[b]); keys[a] = hi_; keys[b] = lo_; }
      CX(0, 1) CX(2, 3) CX(4, 5) CX(6, 7)
      CX(0, 2) CX(1, 3) CX(4, 6) CX(5, 7)
      CX(1, 2) CX(5, 6)
      CX(0, 4) CX(1, 5) CX(2, 6) CX(3, 7)
      CX(2, 4) CX(3, 5)
      CX(1, 2) CX(3, 4) CX(5, 6)
#undef CX
      int mine = 0;
      for (int r = 0; r < 16; ++r) {
        int wk = rowmax16(keys[0]);
        if (fr == r) mine = wk;
        if (keys[0] == wk) {
#pragma unroll
          for (int nt = 0; nt < 7; ++nt) keys[nt] = keys[nt + 1];
          keys[7] = (int)0x80000000;
        }
      }
      v12[half][j] = key2f(mine & ~127);
      i12[half][j] = 127 - (mine & 127);
    }
  }
#pragma unroll
  for (int j = 0; j < 4; ++j) {
    const float v1 = v12[0][j], v2 = v12[1][j];
    const int e1 = i12[0][j], e2 = i12[1][j];
    int ptr = 0;
    float sc = 0.f;
    int ex = 0;
    const int gbase = lane & ~15;
    for (int r = 0; r < 16; ++r) {
      int pc = min(ptr, 15);
      float v2p = __shfl(v2, gbase + pc);
      int e2p = __shfl(e2, gbase + pc);
      int key = ptr < 16 ? ((f2key(v1 + v2p) & ~255) | (255 - (fr * 16 + ptr))) : (int)0x80000000;
      int wk = rowmax16(key);
      int pos = 255 - (wk & 255);
      int wi = pos >> 4;
      int myexp = e1 * 128 + e2p;
      int wexp = __shfl(myexp, gbase + wi);
      if (fr == r) { sc = key2f(wk & ~255); ex = wexp; }
      if (fr == wi) ptr++;
    }
    float mx = sc;
    mx = fmaxf(mx, __shfl_xor(mx, 1));
    mx = fmaxf(mx, __shfl_xor(mx, 2));
    mx = fmaxf(mx, __shfl_xor(mx, 4));
    mx = fmaxf(mx, __shfl_xor(mx, 8));
    float e = __expf(sc - mx);
    float sm = e;
    sm += __shfl_xor(sm, 1);
    sm += __shfl_xor(sm, 2);
    sm += __shfl_xor(sm, 4);
    sm += __shfl_xor(sm, 8);
    size_t oi = (size_t)(tok0 + 4 * fq + j) * 128 + h * 16 + fr;
    EXPI[oi] = ex;
    GATE[oi] = e / sm;
  }
}
constexpr int NJ9 = 1064 * 2;

typedef float f32x2v __attribute__((ext_vector_type(2)));
DI void unpack16(const uint4& a, float (&x)[16]) {
  const unsigned w[4] = {a.x, a.y, a.z, a.w};
#pragma unroll
  for (int i = 0; i < 4; ++i) {
    f32x2v lo = __builtin_amdgcn_cvt_pk_f32_fp8((int)w[i], false);
    f32x2v hi = __builtin_amdgcn_cvt_pk_f32_fp8((int)w[i], true);
    x[4 * i] = lo[0]; x[4 * i + 1] = lo[1]; x[4 * i + 2] = hi[0]; x[4 * i + 3] = hi[1];
  }
}
#define LANE_OF(k) ((((k) >> 3) & 1) * 32 + (((k) >> 2) & 1) * 16 + (((k) >> 1) & 1) * 8 + ((k)&1) * 4)
DI void phase10(const P& p, int job) {
  const int lane = threadIdx.x & 63;
  const int tk = job * 4 + (threadIdx.x >> 6);
  float* dst;
  if (tk < TP) {
    int n = tk / LP, l = tk - n * LP;
    if (l < 16) return;
    dst = p.out + O_YP + ((size_t)n * 2048 + (l - 16)) * 1024;
  } else {
    dst = p.out + O_YS + (size_t)(tk - TP) * 1024;
  }
  const float* X1 = (const float*)unitp(p, 0) + (size_t)tk * 1024;
  const u16* H2 = unitp(p, 2) + (size_t)tk * 1024;
  const int* EXPI = (const int*)unitp(p, 5) + (size_t)tk * 128;
  const float* GATE = (const float*)((const char*)unitp(p, 5) + (size_t)T * 128 * 4) + (size_t)tk * 128;
  const unsigned char* UT = (const unsigned char*)unitp(p, 6);
  const unsigned char* VTB = UT + (size_t)16384 * 1024;
  float hv[16];
  {
    uint4 a = *(const uint4*)(H2 + lane * 16), b = *(const uint4*)(H2 + lane * 16 + 8);
    hv[0] = bflo(a.x); hv[1] = bfhi(a.x); hv[2] = bflo(a.y); hv[3] = bfhi(a.y);
    hv[4] = bflo(a.z); hv[5] = bfhi(a.z); hv[6] = bflo(a.w); hv[7] = bfhi(a.w);
    hv[8] = bflo(b.x); hv[9] = bfhi(b.x); hv[10] = bflo(b.y); hv[11] = bfhi(b.y);
    hv[12] = bflo(b.z); hv[13] = bfhi(b.z); hv[14] = bflo(b.w); hv[15] = bfhi(b.w);
  }
  float ov[16];
#pragma unroll
  for (int i = 0; i < 16; ++i) ov[i] = 0.f;
  const int kmine = ((lane >> 5) & 1) * 8 + ((lane >> 4) & 1) * 4 + ((lane >> 3) & 1) * 2 + ((lane >> 2) & 1);
  const bool b5 = lane & 32, b4 = lane & 16, b3 = lane & 8, b2 = lane & 4;
  for (int h = 0; h < 8; ++h) {
    const int e_l = EXPI[h * 16 + kmine];
    const float g_l = GATE[h * 16 + kmine];
    float part[16];
#pragma unroll
    for (int k = 0; k < 16; ++k) {
      int e = __builtin_amdgcn_readlane(e_l, LANE_OF(k));
      uint4 a = *(const uint4*)(UT + (size_t)e * 1024 + lane * 16);
      float x[16];
      unpack16(a, x);
      float d = 0.f;
#pragma unroll
      for (int i = 0; i < 16; ++i) d += x[i] * hv[i];
      part[k] = d;
    }
    float r8[8], r4[4], r2[2];
#pragma unroll
    for (int i = 0; i < 8; ++i) {
      float send = b5 ? part[i] : part[i + 8], keep = b5 ? part[i + 8] : part[i];
      r8[i] = keep + __shfl_xor(send, 32);
    }
#pragma unroll
    for (int i = 0; i < 4; ++i) {
      float send = b4 ? r8[i] : r8[i + 4], keep = b4 ? r8[i + 4] : r8[i];
      r4[i] = keep + __shfl_xor(send, 16);
    }
#pragma unroll
    for (int i = 0; i < 2; ++i) {
      float send = b3 ? r4[i] : r4[i + 2], keep = b3 ? r4[i + 2] : r4[i];
      r2[i] = keep + __shfl_xor(send, 8);
    }
    float d;
    {
      float send = b2 ? r2[0] : r2[1], keep = b2 ? r2[1] : r2[0];
      d = keep + __shfl_xor(send, 4);
    }
    d += __shfl_xor(d, 2);
    d += __shfl_xor(d, 1);
    const float w_l = g_l * geluf_(d * (1.f / 64.f)) * (1.f / 16.f);
#pragma unroll
    for (int k = 0; k < 16; ++k) {
      int e = __builtin_amdgcn_readlane(e_l, LANE_OF(k));
      float w = __builtin_bit_cast(float, __builtin_amdgcn_readlane(__builtin_bit_cast(int, w_l), LANE_OF(k)));
      uint4 a = *(const uint4*)(VTB + (size_t)e * 1024 + lane * 16);
      float x[16];
      unpack16(a, x);
#pragma unroll
      for (int i = 0; i < 16; ++i) ov[i] += w * x[i];
    }
  }
  float ss = 0.f;
#pragma unroll
  for (int i = 0; i < 4; ++i) {
    float4 x = *(const float4*)(X1 + lane * 16 + i * 4);
    ov[4 * i] += x.x; ov[4 * i + 1] += x.y; ov[4 * i + 2] += x.z; ov[4 * i + 3] += x.w;
    ss += ov[4 * i] * ov[4 * i] + ov[4 * i + 1] * ov[4 * i + 1] + ov[4 * i + 2] * ov[4 * i + 2] + ov[4 * i + 3] * ov[4 * i + 3];
  }
  ss = wave_sum(ss);
  const float rs = rsqrtf(ss * (1.f / 1024.f) + EPS);
#pragma unroll
  for (int i = 0; i < 4; ++i) {
    int eo = lane * 16 + i * 4;
    float4 w = *(const float4*)(p.final_w + eo);
    *(float4*)(dst + eo) =
        make_float4(ov[4 * i] * rs * w.x, ov[4 * i + 1] * rs * w.y, ov[4 * i + 2] * rs * w.z, ov[4 * i + 3] * rs * w.w);
  }
}
constexpr int NJ10 = T / 4;


#define XB_TMO      128
#define XB_XCNT(j)  (256  + 64 * (j))
#define XB_XSUB(j)  (1280 + 64 * (j))
#define XB_XGEN(j)  (2304 + 64 * (j))
#define XB_TOP      3328
#define XB_TOPGEN   3392
#define XCD_BAR_WORDS 3456
#define XB_SPIN_CAP (1u << 18)
#define LAS __attribute__((address_space(3)))

__device__ __forceinline__ unsigned xb_ld(unsigned* p)              { return __hip_atomic_load(p, __ATOMIC_RELAXED, __HIP_MEMORY_SCOPE_AGENT); }
__device__ __forceinline__ unsigned xb_add(unsigned* p, unsigned v) { return __hip_atomic_fetch_add(p, v, __ATOMIC_RELAXED, __HIP_MEMORY_SCOPE_AGENT); }
__device__ __forceinline__ unsigned xb_xcc_id() { return (unsigned)__builtin_amdgcn_s_getreg((3 << 11) | 20) & 0xFu; }
#define XB_SPIN(cond, bar) do { unsigned _sp = 0; while (cond) { __builtin_amdgcn_s_sleep(1); \
    if ((++_sp & 255u) == 0u) { if (xb_ld(&(bar)[XB_TMO])) break; if (_sp > XB_SPIN_CAP) { atomicAdd(&(bar)[XB_TMO], 1u); break; } } } } while (0)

struct XcdBarrier {
    unsigned* bar; unsigned x;
    volatile LAS unsigned* st;
};

__device__ __forceinline__ XcdBarrier xcd_barrier_post(unsigned* bar, volatile LAS unsigned* st) {
    XcdBarrier b; b.bar = bar; b.x = xb_xcc_id(); b.st = st;
    if (threadIdx.x == 0) (void)xb_add(&bar[XB_XCNT(b.x)], 1u);
    return b;
}
__device__ __forceinline__ void xcd_barrier_complete(unsigned* bar, unsigned x, unsigned& nloc, unsigned& nx) {
    const unsigned G = gridDim.x * gridDim.y * gridDim.z;
    unsigned sum, cnt, mine, sp = 0u;
    for (;;) {
        sum = 0u; cnt = 0u; mine = 0u;
#pragma unroll
        for (unsigned j = 0; j < 16; ++j) { const unsigned c = xb_ld(&bar[XB_XCNT(j)]); sum += c; cnt += (c > 0u) ? 1u : 0u; mine = (j == x) ? c : mine; }
        if (sum == G) break;
        __builtin_amdgcn_s_sleep(1);
        if ((++sp & 255u) == 0u) { if (xb_ld(&bar[XB_TMO])) break; if (sp > XB_SPIN_CAP) { atomicAdd(&bar[XB_TMO], 1u); break; } }
    }
    nloc = mine > 0u ? mine : 1u; nx = cnt > 0u ? cnt : 1u;
}

__device__ __forceinline__ void xcd_barrier(const XcdBarrier& b) {
    asm volatile("s_waitcnt vmcnt(0)" ::: "memory");
    __syncthreads();
    if (threadIdx.x == 0) {
        unsigned* bar = b.bar;
        __builtin_amdgcn_s_waitcnt(0);
        unsigned nloc = b.st[0], nx = b.st[1];
        if (nloc == 0u) { xcd_barrier_complete(bar, b.x, nloc, nx); b.st[0] = nloc; b.st[1] = nx; }
        const unsigned old = xb_add(&bar[XB_XSUB(b.x)], 1u);
        const unsigned gen = old / nloc;
        if (old + 1u == (gen + 1u) * nloc) {
            __builtin_amdgcn_fence(__ATOMIC_RELEASE, "agent");
            asm volatile("s_waitcnt vmcnt(0)" ::: "memory");
            const unsigned og = xb_add(&bar[XB_TOP], 1u);
            const unsigned tg = og / nx;
            if (og + 1u == (tg + 1u) * nx) xb_add(&bar[XB_TOPGEN], 1u);
            else XB_SPIN(xb_ld(&bar[XB_TOPGEN]) == tg, bar);
            __builtin_amdgcn_fence(__ATOMIC_ACQUIRE, "agent");
            xb_add(&bar[XB_XGEN(b.x)], 1u);
            asm volatile("s_waitcnt vmcnt(0)" ::: "memory");
        } else {
            XB_SPIN(xb_ld(&bar[XB_XGEN(b.x)]) == gen, bar);
            __builtin_amdgcn_fence(__ATOMIC_ACQUIRE, "agent");
            asm volatile("s_waitcnt vmcnt(0)" ::: "memory");
        }
    }
    __syncthreads();
}


DI void my_sync(unsigned* bar, unsigned target) {
  asm volatile("s_waitcnt vmcnt(0)" ::: "memory");
  __syncthreads();
  if (threadIdx.x == 0) {
    __builtin_amdgcn_fence(__ATOMIC_RELEASE, "agent");
    asm volatile("s_waitcnt vmcnt(0)" ::: "memory");
    __hip_atomic_fetch_add(bar, 1u, __ATOMIC_RELAXED, __HIP_MEMORY_SCOPE_AGENT);
    while (__hip_atomic_load(bar, __ATOMIC_RELAXED, __HIP_MEMORY_SCOPE_AGENT) < target) __builtin_amdgcn_s_sleep(2);
    __builtin_amdgcn_fence(__ATOMIC_ACQUIRE, "agent");
    asm volatile("s_waitcnt vmcnt(0)" ::: "memory");
  }
  __syncthreads();
}
__global__ void __launch_bounds__(256, 2) mega(P p, int ph_lo, int ph_hi) {
  __shared__ __attribute__((aligned(16))) char smem[SMEM_BYTES];
  cg::grid_group grid = cg::this_grid();
  const int G = gridDim.x, B = blockIdx.x;
#define RUN_PHASE(n) if ((ONLY < 0 || ONLY == n) && ph_lo <= n && n < ph_hi)
  __shared__ uint4 xb_words;
  if (threadIdx.x == 0) xb_words = make_uint4(0u, 0u, 0u, 0u);
  __syncthreads();
  XcdBarrier xb = xcd_barrier_post((unsigned*)(p.ws + OFF_BAR), (volatile LAS unsigned*)&xb_words);
  if (ph_hi > 1000) grid.sync();
#define SYNC_IF(n) if (n > ph_lo) { xcd_barrier(xb); }
  RUN_PHASE(0) { for (int j = B; j < NJ0; j += G) phase0(p, j, smem); }
  RUN_PHASE(1) { SYNC_IF(1) for (int j = B; j < NJ1; j += G) phase1(p, j, smem); }
  RUN_PHASE(2) { SYNC_IF(2)
    for (int j = B; j < NJ2_H; j += G) p2_hgrn_pre(p, j, smem); }
  RUN_PHASE(3) { SYNC_IF(3)
    if (B < NJ3_A) p3_hgrn_seq(p, B, smem);
    else if (B < NJ3_A + NJ3_CH) p3_s5chain(p, B - NJ3_A, smem);
    else for (int j = B - (NJ3_A + NJ3_CH); j < NJ3_REST; j += G - (NJ3_A + NJ3_CH)) phase3rest(p, j, smem); }
  RUN_PHASE(4) { SYNC_IF(4)
    for (int j = B; j < NJ4; j += G) { if (j < NJ4_A) p4_onorm(p, j); else p4_glu(p, j - NJ4_A, smem); } }
  RUN_PHASE(5) { SYNC_IF(5) for (int j = B; j < NJ5; j += G) phase5(p, j, smem); }
  RUN_PHASE(6) { SYNC_IF(6) for (int j = B; j < NJ6; j += G) phase6(p, j, smem);
    { const int extra = NJ6 % G;
      if (B >= extra) for (int j = B - extra; j < 8192; j += G - extra) convert_tables(p, j); } }
  RUN_PHASE(7) { SYNC_IF(7) for (int j = B; j < NJ7; j += G) phase7(p, j); }
  RUN_PHASE(8) { SYNC_IF(8) for (int j = B; j < NJ8; j += G) phase8(p, j, smem); }
  RUN_PHASE(9) { SYNC_IF(9) for (int j = B; j < NJ9; j += G) phase9(p, j); }
  RUN_PHASE(10) { SYNC_IF(10) for (int j = B; j < NJ10; j += G) phase10(p, j); }
}

extern "C" void kernel_launch(void* const* d_in, const int* in_sizes, int n_in, void* d_out, int out_size, void* d_ws,
                              size_t ws_size, hipStream_t stream) {
  static int grid_blocks = 0;
  if (!grid_blocks) {
    int dev = 0, cus = 0, per_cu = 0;
    hipGetDevice(&dev);
    hipDeviceGetAttribute(&cus, hipDeviceAttributeMultiprocessorCount, dev);
    hipOccupancyMaxActiveBlocksPerMultiprocessor(&per_cu, mega, 256, 0);
    if (per_cu < 1) per_cu = 1;
    grid_blocks = cus * per_cu;
  }
  P p{};
  const float** pf = (const float**)&p;
  for (int i = 0; i < 30; ++i) pf[i] = (const float*)d_in[i];
  p.out = (float*)d_out;
  p.ws = (char*)d_ws;
#if SINGLE_LAUNCH
  hipMemsetAsync((char*)d_ws + OFF_BAR, 0, XCD_BAR_WORDS * sizeof(unsigned), stream);
  int lo = 0, hi = 11;
  void* args[] = {&p, &lo, &hi};
  hipError_t e = hipLaunchCooperativeKernel((void*)mega, dim3(grid_blocks), dim3(256), args, 0, stream);
  if (e != hipSuccess) fprintf(stderr, "cooperative launch failed: %s (grid %d)\n", hipGetErrorString(e), grid_blocks);
#else
  for (int ph = 0; ph < 11; ++ph) hipLaunchKernelGGL(mega, dim3(grid_blocks), dim3(256), 0, stream, p, ph, ph + 1);
#endif
}
```

```cpp
#include <hip/hip_runtime.h>
#include <hip/hip_cooperative_groups.h>
#include <cstdio>
namespace cg = cooperative_groups;

#define DI __device__ __forceinline__
typedef unsigned short u16;
typedef short s16x4 __attribute__((ext_vector_type(4)));
typedef short s16x8 __attribute__((ext_vector_type(8)));
typedef float f32x4 __attribute__((ext_vector_type(4)));
typedef __bf16 bf16x2_t __attribute__((ext_vector_type(2)));
typedef float f32x2_t __attribute__((ext_vector_type(2)));

#ifndef SINGLE_LAUNCH
#define SINGLE_LAUNCH 1
#endif

constexpr int T = 17024, TP = 16512, LP = 2064, NCHK = 129;
constexpr float EPS = 1e-6f;
#ifndef ONLY
#define ONLY -1
#endif
constexpr size_t UNIT = (size_t)T * 1024 * 2;
constexpr size_t OFF_WTIN = 0;
constexpr size_t OFF_WTGLU = OFF_WTIN + (size_t)7168 * 1024 * 2;
constexpr size_t OFF_WTA = OFF_WTGLU + 2097152;
constexpr size_t OFF_WTB = OFF_WTA + 2097152;
constexpr size_t OFF_WTOUT = OFF_WTB + 2097152;
constexpr size_t OFF_WTQ = OFF_WTOUT + 2097152;
constexpr size_t OFF_K1 = OFF_WTQ + 4194304;
constexpr size_t OFF_K2 = OFF_K1 + 262144;
constexpr size_t OFF_LB = OFF_K2 + 262144;
constexpr size_t OFF_ABAR = OFF_LB + 4096;
constexpr size_t OFF_APOW = OFF_ABAR + 32768;
constexpr size_t OFF_BBAR = OFF_APOW + 32768;
constexpr size_t OFF_UNITS = OFF_BBAR + 524288;
constexpr size_t OFF_BAR = OFF_UNITS + 8 * ((size_t)17024 * 1024 * 2);
constexpr size_t OOFF_KTT = 0;
constexpr size_t OOFF_DEC = UNIT;
constexpr size_t OOFF_E = OOFF_DEC + (size_t)1032 * 1024 * 4;
constexpr size_t O_YP = 0, O_YS = 16777216, O_HGP = 17301504, O_SRP = 18350080, O_SIP = 18382848,
                 O_HGS = 18415616, O_SRS = 35192832, O_SIS = 35717120;
constexpr int SMEM_BYTES = 65536;

struct P {
  const float *x_prompt, *x_sample, *state_hgrn, *ssm_re, *ssm_im, *meta, *lower_bounds, *norm1_w, *w_in, *g_norm_w,
      *a_re, *a_im, *log_step, *b_re, *b_im, *c_re, *c_im, *ssm_d, *w_glu, *b_glu, *w_a, *w_b, *w_out, *norm2_w,
      *peer_wq, *k1, *k2, *peer_u, *peer_v, *final_w;
  float* out;
  char* ws;
};

DI unsigned pack2(float a, float b) {
  f32x2_t v = {a, b};
  bf16x2_t r = __builtin_convertvector(v, bf16x2_t);
  return __builtin_bit_cast(unsigned, r);
}
DI u16 f2bf(float a) { return (u16)(pack2(a, 0.f) & 0xffffu); }
DI float bf2f(u16 v) { return __uint_as_float(((unsigned)v) << 16); }
DI float bflo(unsigned v) { return __uint_as_float(v << 16); }
DI float bfhi(unsigned v) { return __uint_as_float(v & 0xffff0000u); }
DI f32x4 mfma32(s16x8 a, s16x8 b, f32x4 c) { return __builtin_amdgcn_mfma_f32_16x16x32_bf16(a, b, c, 0, 0, 0); }
DI f32x4 mfma16(s16x4 a, s16x4 b, f32x4 c) { return __builtin_amdgcn_mfma_f32_16x16x16bf16_1k(a, b, c, 0, 0, 0); }
DI float wave_sum(float v) {
#pragma unroll
  for (int o = 32; o >= 1; o >>= 1) v += __shfl_xor(v, o);
  return v;
}
DI float sigmoidf_(float x) { return 1.f / (1.f + __expf(-x)); }
DI float siluf_(float x) { return x / (1.f + __expf(-x)); }
DI float geluf_(float x) { return 0.5f * x * (1.f + erff(x * 0.70710678118654752f)); }
DI s16x4 pack4(f32x4 v) {
  unsigned a = pack2(v[0], v[1]), b = pack2(v[2], v[3]);
  uint2 u = make_uint2(a, b);
  return __builtin_bit_cast(s16x4, u);
}
DI s16x8 pack8(f32x4 x, f32x4 y) {
  uint4 u = make_uint4(pack2(x[0], x[1]), pack2(x[2], x[3]), pack2(y[0], y[1]), pack2(y[2], y[3]));
  return __builtin_bit_cast(s16x8, u);
}
DI u16* unitp(const P& p, int i) { return (u16*)(p.ws + OFF_UNITS + (size_t)i * UNIT); }
DI const float* xrow(const P& p, int tk) {
  if (tk < TP) {
    int n = tk / LP, l = tk - n * LP;
    return l < 16 ? p.meta + (size_t)l * 1024 : p.x_prompt + ((size_t)n * 2048 + (l - 16)) * 1024;
  }
  return p.x_sample + (size_t)(tk - TP) * 1024;
}

DI void gemm_core(const u16* __restrict__ A, int lda, const u16* __restrict__ Bt, int ldb, int K, int brow, int bcol,
                  char* smem, f32x4 (&acc)[4][4]) {
  const int tid = threadIdx.x, wave = tid >> 6, lane = tid & 63, wr = wave >> 1, wc = wave & 1, fr = lane & 15,
            fq = lane >> 4;
  const int r0 = tid >> 3, cj = tid & 7;
  const u16* ga = A + (size_t)(brow + r0) * lda + cj * 8;
  const u16* gb = Bt + (size_t)(bcol + r0) * ldb + cj * 8;
  const size_t sa = (size_t)32 * lda, sb = (size_t)32 * ldb;
  const int woff = r0 * 128 + ((cj ^ ((r0 >> 1) & 7)) << 4);
  uint4 xa0, xa1, xa2, xa3, xb0, xb1, xb2, xb3, ya0, ya1, ya2, ya3, yb0, yb1, yb2, yb3;
#define G_LOAD(S, kk)                                                                          \
  {                                                                                            \
    S##a0 = *(const uint4*)(ga + (kk) * 64);          S##b0 = *(const uint4*)(gb + (kk) * 64);            \
    S##a1 = *(const uint4*)(ga + sa + (kk) * 64);     S##b1 = *(const uint4*)(gb + sb + (kk) * 64);       \
    S##a2 = *(const uint4*)(ga + 2 * sa + (kk) * 64); S##b2 = *(const uint4*)(gb + 2 * sb + (kk) * 64);   \
    S##a3 = *(const uint4*)(ga + 3 * sa + (kk) * 64); S##b3 = *(const uint4*)(gb + 3 * sb + (kk) * 64);   \
  }
#define G_STORE(S, st)                                                                         \
  {                                                                                            \
    char* sp_ = smem + (st) * 32768 + woff;                                                    \
    *(uint4*)(sp_) = S##a0;         *(uint4*)(sp_ + 16384) = S##b0;                            \
    *(uint4*)(sp_ + 4096) = S##a1;  *(uint4*)(sp_ + 16384 + 4096) = S##b1;                     \
    *(uint4*)(sp_ + 8192) = S##a2;  *(uint4*)(sp_ + 16384 + 8192) = S##b2;                     \
    *(uint4*)(sp_ + 12288) = S##a3; *(uint4*)(sp_ + 16384 + 12288) = S##b3;                    \
  }
  const int arow = wr * 64 + fr, brow_l = wc * 64 + fr;
  const int sw = (fr >> 1) & 7;
  const int nk = K >> 6;
#define G_COMPUTE(st)                                                                          \
  {                                                                                            \
    const char* a = smem + (st) * 32768;                                                       \
    const char* b = a + 16384;                                                                 \
    _Pragma("unroll") for (int ks = 0; ks < 2; ++ks) {                                         \
      s16x8 af[4], bfr[4];                                                                     \
      const int co = (((ks * 4 + fq) ^ sw) << 4);                                              \
      _Pragma("unroll") for (int m = 0; m < 4; ++m) af[m] = *(const s16x8*)(a + (arow + m * 16) * 128 + co);     \
      _Pragma("unroll") for (int n = 0; n < 4; ++n) bfr[n] = *(const s16x8*)(b + (brow_l + n * 16) * 128 + co);  \
      _Pragma("unroll") for (int m = 0; m < 4; ++m)                                            \
      _Pragma("unroll") for (int n = 0; n < 4; ++n) acc[m][n] = mfma32(af[m], bfr[n], acc[m][n]);                \
    }                                                                                          \
  }
  G_LOAD(x, 0)
  G_STORE(x, 0)
  G_LOAD(y, 1)
  __syncthreads();
  for (int kt = 0; kt < nk; kt += 2) {
    if (kt + 2 < nk) G_LOAD(x, kt + 2)
    G_COMPUTE(0)
    G_STORE(y, 1)
    __syncthreads();
    if (kt + 3 < nk) G_LOAD(y, kt + 3)
    G_COMPUTE(1)
    if (kt + 2 < nk) G_STORE(x, 0)
    __syncthreads();
  }
#undef G_LOAD
#undef G_STORE
#undef G_COMPUTE
  asm volatile("s_nop 15\n\ts_nop 15" : "+v"(acc[0][0]), "+v"(acc[0][1]), "+v"(acc[0][2]), "+v"(acc[0][3]), "+v"(acc[1][0]), "+v"(acc[1][1]), "+v"(acc[1][2]), "+v"(acc[1][3]), "+v"(acc[2][0]), "+v"(acc[2][1]), "+v"(acc[2][2]), "+v"(acc[2][3]), "+v"(acc[3][0]), "+v"(acc[3][1]), "+v"(acc[3][2]), "+v"(acc[3][3]));
}
#define ZERO_ACC(acc)                              \
  _Pragma("unroll") for (int m = 0; m < 4; ++m)    \
  _Pragma("unroll") for (int n = 0; n < 4; ++n) acc[m][n] = f32x4{0.f, 0.f, 0.f, 0.f};
#define EPI_VARS                                                                                             \
  const int tid = threadIdx.x, wave = tid >> 6, lane = tid & 63, wr = wave >> 1, wc = wave & 1, fr = lane & 15, \
            fq = lane >> 4;
#define EPI_BASE(ld, rb, cbv)                                    \
  int tb_ = (wr * 64 + fq * 4) * (ld) + wc * 64 + fr;           \
  asm volatile("" : "+v"(tb_));                                 \
  const int idx0 = (rb) * (ld) + (cbv) + tb_;
#define EPI_LOOP                                 \
  _Pragma("unroll") for (int m = 0; m < 4; ++m)  \
  _Pragma("unroll") for (int n = 0; n < 4; ++n)

DI void p0_transpose(const float* __restrict__ W, int K, int N, u16* __restrict__ Wt, int tile, char* smem) {
  float* sm = (float*)smem;
  const int ntn = N >> 6;
  const int tk = tile / ntn, tn = tile - tk * ntn;
  const int tid = threadIdx.x;
  const int c = tid & 63, r0 = tid >> 6;
#pragma unroll
  for (int i = 0; i < 16; ++i) {
    int r = r0 + i * 4;
    sm[r * 65 + c] = W[(size_t)(tk * 64 + r) * N + tn * 64 + c];
  }
  __syncthreads();
  const int n = tid >> 2, ks = (tid & 3) * 16;
  unsigned o[8];
#pragma unroll
  for (int i = 0; i < 8; ++i) o[i] = pack2(sm[(ks + 2 * i) * 65 + n], sm[(ks + 2 * i + 1) * 65 + n]);
  uint4* dst = (uint4*)(Wt + (size_t)(tn * 64 + n) * K + tk * 64 + ks);
  dst[0] = make_uint4(o[0], o[1], o[2], o[3]);
  dst[1] = make_uint4(o[4], o[5], o[6], o[7]);
  __syncthreads();
}

DI void p0_convert(const float* __restrict__ src, u16* __restrict__ dst, int job) {
  size_t i = (size_t)job * 2048 + threadIdx.x * 8;
  float4 a = *(const float4*)(src + i), b = *(const float4*)(src + i + 4);
  *(uint4*)(dst + i) = make_uint4(pack2(a.x, a.y), pack2(a.z, a.w), pack2(b.x, b.y), pack2(b.z, b.w));
}

DI void p0_lb(const P& p) {
  float* LB = (float*)(p.ws + OFF_LB);
  for (int c = threadIdx.x; c < 1024; c += 256) {
    float a = p.lower_bounds[c], b = p.lower_bounds[1024 + c];
    LB[c] = 1.f / (1.f + expf(b - a));
  }
}

DI void p0_s5const(const P& p, int job) {
  int idx = job * 256 + threadIdx.x;
  int g = idx >> 6;
  float re = fminf(p.a_re[idx], -1e-4f), im = p.a_im[idx];
  float dl = expf(p.log_step[g]);
  float mag = expf(re * dl);
  float sn, cs;
  sincosf(im * dl, &sn, &cs);
  float ax = mag * cs, ay = mag * sn;
  float nx = ax - 1.f, ny = ay;
  float d2 = re * re + im * im;
  float cr = (nx * re + ny * im) / d2, ci = (ny * re - nx * im) / d2;
  float2* ABAR = (float2*)(p.ws + OFF_ABAR);
  float2* APOW = (float2*)(p.ws + OFF_APOW);
  float2* BBAR = (float2*)(p.ws + OFF_BBAR);
  ABAR[idx] = make_float2(ax, ay);
  float x = ax, y = ay, x16 = 0.f, y16 = 0.f;
#pragma unroll
  for (int i = 0; i < 5; ++i) {
    float nx2 = x * x - y * y, ny2 = 2.f * x * y;
    x = nx2; y = ny2;
    if (i == 3) { x16 = x; y16 = y; }
  }
  APOW[idx] = make_float2(x * x16 - y * y16, x * y16 + y * x16);
#pragma unroll
  for (int c = 0; c < 16; ++c) {
    float br = p.b_re[idx * 16 + c], bi = p.b_im[idx * 16 + c];
    BBAR[idx * 16 + c] = make_float2(cr * br - ci * bi, cr * bi + ci * br);
  }
}

DI void rms_row_to_bf16(const float* __restrict__ src, const float* __restrict__ w, u16* __restrict__ dst, int lane) {
  float4 v[4];
  float ss = 0.f;
#pragma unroll
  for (int i = 0; i < 4; ++i) {
    v[i] = *(const float4*)(src + i * 256 + lane * 4);
    ss += v[i].x * v[i].x + v[i].y * v[i].y + v[i].z * v[i].z + v[i].w * v[i].w;
  }
  ss = wave_sum(ss);
  float rs = rsqrtf(ss * (1.f / 1024.f) + EPS);
#pragma unroll
  for (int i = 0; i < 4; ++i) {
    float4 ww = *(const float4*)(w + i * 256 + lane * 4);
    uint2 o = make_uint2(pack2(v[i].x * rs * ww.x, v[i].y * rs * ww.y), pack2(v[i].z * rs * ww.z, v[i].w * rs * ww.w));
    *(uint2*)(dst + i * 256 + lane * 4) = o;
  }
}

DI void phase0(const P& p, int job, char* smem) {
  if (job < 1792) p0_transpose(p.w_in, 1024, 7168, (u16*)(p.ws + OFF_WTIN), job, smem);
  else if (job < 2048) p0_transpose(p.w_glu, 1024, 1024, (u16*)(p.ws + OFF_WTGLU), job - 1792, smem);
  else if (job < 2304) p0_transpose(p.w_a, 1024, 1024, (u16*)(p.ws + OFF_WTA), job - 2048, smem);
  else if (job < 2560) p0_transpose(p.w_b, 1024, 1024, (u16*)(p.ws + OFF_WTB), job - 2304, smem);
  else if (job < 2816) p0_transpose(p.w_out, 1024, 1024, (u16*)(p.ws + OFF_WTOUT), job - 2560, smem);
  else if (job < 3328) p0_transpose(p.peer_wq, 1024, 2048, (u16*)(p.ws + OFF_WTQ), job - 2816, smem);
  else if (job < 3392) p0_convert(p.k1, (u16*)(p.ws + OFF_K1), job - 3328);
  else if (job < 3456) p0_convert(p.k2, (u16*)(p.ws + OFF_K2), job - 3392);
  else if (job == 3456) p0_lb(p);
  else if (job < 3473) p0_s5const(p, job - 3457);
  else {
    int tk = (job - 3473) * 4 + (threadIdx.x >> 6);
    rms_row_to_bf16(xrow(p, tk), p.norm1_w, unitp(p, 0) + (size_t)tk * 1024, threadIdx.x & 63);
  }
}
constexpr int NJ0 = 3473 + T / 4;

DI void phase1(const P& p, int job, char* smem) {
  const int pm = job / 56, pn = job - pm * 56;
  const int brow = pm * 128, bcol = pn * 128;
  f32x4 acc[4][4];
  ZERO_ACC(acc);
  gemm_core(unitp(p, 0), 1024, (const u16*)(p.ws + OFF_WTIN), 1024, 1024, brow, bcol, smem, acc);
  EPI_VARS;
  const int region = pn >> 3;
  const int cbase = bcol - region * 1024;
  if (region == 2) {
    u16* VT = unitp(p, 3);
    int vb = ((brow >> 4) + wr * 4) * 16384 + (cbase + wc * 64 + fr) * 16 + fq * 4;
    asm volatile("" : "+v"(vb));
    EPI_LOOP { *(s16x4*)(VT + vb + m * 16384 + n * 256) = pack4(acc[m][n]); }
  } else {
    u16* dst = unitp(p, region == 0 ? 1 : region == 1 ? 2 : region + 1);
    EPI_BASE(1024, brow, cbase);
    EPI_LOOP {
#pragma unroll
      for (int j = 0; j < 4; ++j) {
        float v = acc[m][n][j];
        if (region == 0 || region == 3) v = siluf_(v);
        else if (region >= 5) v = sigmoidf_(v);
        dst[idx0 + (m * 16 + j) * 1024 + n * 16] = f2bf(v);
      }
    }
  }
}
constexpr int NJ1 = 133 * 56;

DI void p2_hgrn_pre(const P& p, int job, char* smem) {
  const int tid = threadIdx.x, wave = tid >> 6, lane = tid & 63, fr = lane & 15, fq = lane >> 4;
  const int chunk = job >> 1, h = (job & 1) * 4 + wave;
  const int tok0 = chunk * 16;
  u16* R1 = unitp(p, 1);
  const u16* R2 = unitp(p, 2);
  const u16* VT = unitp(p, 3);
  u16* OIN = unitp(p, 0);
  u16* KTT = (u16*)((char*)p.out + OOFF_KTT);
  float* DEC = (float*)((char*)p.out + OOFF_DEC);
  const float* LB = (const float*)(p.ws + OFF_LB);
  char* sq = smem + wave * 8704;
  char* sk = sq + 4352;
  const int c0 = h * 128 + lane * 2;
  const float lb0 = LB[c0], lb1 = LB[c0 + 1];
  float b0 = 0.f, b1 = 0.f;
  float kn0[16], kn1[16];
#pragma unroll
  for (int t = 0; t < 16; ++t) {
    size_t gi = (size_t)(tok0 + t) * 1024 + c0;
    unsigned q2 = *(const unsigned*)(R1 + gi), f2 = *(const unsigned*)(R2 + gi);
    float f0 = bflo(f2), f1 = bfhi(f2);
    float e0 = __expf(-f0), e1 = __expf(-f1);
    float fg0 = lb0 + (1.f - lb0) / (1.f + e0), fg1 = lb1 + (1.f - lb1) / (1.f + e1);
    float k0 = (1.f - lb0) * e0 / (1.f + e0), k1 = (1.f - lb1) * e1 / (1.f + e1);
    b0 += __logf(fg0);
    b1 += __logf(fg1);
    float qt0 = bflo(q2) * __expf(b0), qt1 = bfhi(q2) * __expf(b1);
    kn0[t] = k0 * __expf(-b0);
    kn1[t] = k1 * __expf(-b1);
    unsigned qp = pack2(qt0, qt1);
    *(unsigned*)(R1 + gi) = qp;
    *(unsigned*)(sq + t * 272 + lane * 4) = qp;
    *(unsigned*)(sk + t * 272 + lane * 4) = pack2(kn0[t], kn1[t]);
  }
  const float eb0 = __expf(b0), eb1 = __expf(b1);
  *(float2*)(DEC + (size_t)chunk * 1024 + c0) = make_float2(eb0, eb1);
  {
    unsigned w0[8], w1[8];
#pragma unroll
    for (int i = 0; i < 8; ++i) {
      w0[i] = pack2(kn0[2 * i] * eb0, kn0[2 * i + 1] * eb0);
      w1[i] = pack2(kn1[2 * i] * eb1, kn1[2 * i + 1] * eb1);
    }
    uint4* kd = (uint4*)(KTT + ((size_t)chunk * 1024 + c0) * 16);
    kd[0] = make_uint4(w0[0], w0[1], w0[2], w0[3]);
    kd[1] = make_uint4(w0[4], w0[5], w0[6], w0[7]);
    kd[2] = make_uint4(w1[0], w1[1], w1[2], w1[3]);
    kd[3] = make_uint4(w1[4], w1[5], w1[6], w1[7]);
  }
  __syncthreads();
  f32x4 at = {0.f, 0.f, 0.f, 0.f};
#pragma unroll
  for (int ks = 0; ks < 4; ++ks) {
    s16x8 a = *(const s16x8*)(sk + fr * 272 + ks * 64 + fq * 16);
    s16x8 b = *(const s16x8*)(sq + fr * 272 + ks * 64 + fq * 16);
    at = mfma32(a, b, at);
  }
  asm volatile("s_nop 15\n\ts_nop 15" : "+v"(at));
#pragma unroll
  for (int j = 0; j < 4; ++j)
    if (4 * fq + j > fr) at[j] = 0.f;
  s16x4 af = pack4(at);
  asm volatile("s_nop 7" : "+v"(af));
#pragma unroll
  for (int nt = 0; nt < 8; ++nt) {
    size_t vi = ((size_t)chunk * 1024 + h * 128 + nt * 16 + fr) * 16 + 4 * fq;
    s16x4 vb = *(const s16x4*)(VT + vi);
    f32x4 o = mfma16(af, vb, f32x4{0.f, 0.f, 0.f, 0.f});
    asm volatile("s_nop 15\n\ts_nop 15" : "+v"(o));
    *(s16x4*)(OIN + vi) = pack4(o);
  }
  __syncthreads();
}

DI void s5_load_bbar(const P& p, int g, int pp, float (&br)[16], float (&bi)[16]) {
  const float4* B = (const float4*)((const float2*)(p.ws + OFF_BBAR) + ((size_t)g * 64 + pp) * 16);
#pragma unroll
  for (int i = 0; i < 8; ++i) {
    float4 v = B[i];
    br[2 * i] = v.x; bi[2 * i] = v.y; br[2 * i + 1] = v.z; bi[2 * i + 1] = v.w;
  }
}
DI void s5_step(const uint4& ua, const uint4& ub, int t, const float (&br)[16], const float (&bi)[16], float ax, float ay,
                float& xr, float& xi) {
  unsigned uu[8] = {(unsigned)__builtin_amdgcn_readlane((int)ua.x, t), (unsigned)__builtin_amdgcn_readlane((int)ua.y, t),
                    (unsigned)__builtin_amdgcn_readlane((int)ua.z, t), (unsigned)__builtin_amdgcn_readlane((int)ua.w, t),
                    (unsigned)__builtin_amdgcn_readlane((int)ub.x, t), (unsigned)__builtin_amdgcn_readlane((int)ub.y, t),
                    (unsigned)__builtin_amdgcn_readlane((int)ub.z, t), (unsigned)__builtin_amdgcn_readlane((int)ub.w, t)};
  float sr = 0.f, si = 0.f;
#pragma unroll
  for (int i = 0; i < 8; ++i) {
    float a = bflo(uu[i]), b = bfhi(uu[i]);
    sr += br[2 * i] * a + br[2 * i + 1] * b;
    si += bi[2 * i] * a + bi[2 * i + 1] * b;
  }
  float nr = ax * xr - ay * xi + sr, ni = ax * xi + ay * xr + si;
  xr = nr; xi = ni;
}

DI void p2_s5a(const P& p, int job) {
  const int gq = job & 15, nc = job >> 4;
  const int n = nc / 43, c = nc - n * 43;
  const int tid = threadIdx.x, g = gq * 4 + (tid >> 6), pp = tid & 63;
  float br[16], bi[16];
  s5_load_bbar(p, g, pp, br, bi);
  const float2 ab = ((const float2*)(p.ws + OFF_ABAR))[g * 64 + pp];
  const u16* U = unitp(p, 5) + (size_t)(n * LP + c * 48) * 1024 + g * 16;
  float xr = 0.f, xi = 0.f;
  uint4 ua, ub;
  {
    const u16* r = U + (size_t)min(pp, 47) * 1024;
    ua = *(const uint4*)r;
    ub = *(const uint4*)(r + 8);
  }
#pragma unroll 4
  for (int t = 0; t < 48; ++t) s5_step(ua, ub, t, br, bi, ab.x, ab.y, xr, xi);
  float2* E = (float2*)((char*)p.out + OOFF_E);
  E[((size_t)(n * 43 + c) * 64 + g) * 64 + pp] = make_float2(xr, xi);
}
constexpr int NJ2_H = 2064, NJ2_S = 8 * 43 * 16;
constexpr int NJ2 = NJ2_H + NJ2_S;

#define SEQ_GLOAD(cg_, P)                                                                              \
  {                                                                                                    \
    const int cgv = (cg_);                                                                             \
    P##rq = *(const uint4*)(QT + (size_t)(cgv * 16 + (tid >> 4)) * 1024 + h * 128 + (tid & 15) * 8);  \
    P##rk = *(const uint4*)(KTT + ((size_t)cgv * 1024 + h * 128) * 16 + tid * 8);                      \
    if (tid < 32) P##rd = *(const float4*)(DEC + (size_t)cgv * 1024 + h * 128 + tid * 4);              \
    size_t vi0 = ((size_t)cgv * 1024 + h * 128 + wave * 32 + fr) * 16 + 4 * fq;                        \
    P##rv0 = *(const s16x4*)(VT + vi0);                                                                \
    P##rv1 = *(const s16x4*)(VT + vi0 + 256);                                                          \
    P##ro0 = *(const s16x4*)(OIN + vi0);                                                               \
    P##ro1 = *(const s16x4*)(OIN + vi0 + 256);                                                         \
  }
#define SEQ_LSTORE(b_, P)                                                  \
  {                                                                        \
    char* lb_ = smem + (b_) * 8960;                                        \
    *(uint4*)(lb_ + (tid >> 4) * 272 + (tid & 15) * 16) = P##rq;           \
    *(uint4*)(lb_ + 4352 + tid * 16) = P##rk;                              \
    if (tid < 32) *(float4*)(lb_ + 8448 + tid * 16) = P##rd;               \
  }
#define SEQ_BODY(c_, X, Y)                                                                                   \
  {                                                                                                          \
    const int c = (c_);                                                                                      \
    const int b = c & 1;                                                                                     \
    const int tok0 = (cg0 + c) * 16;                                                                         \
    if (c + 2 < NCHK) SEQ_GLOAD(cg0 + c + 2, X)                                                              \
    const char* base = smem + b * 8960;                                                                      \
    f32x4 o0 = f32x4{0.f, 0.f, 0.f, 0.f}, o1 = f32x4{0.f, 0.f, 0.f, 0.f};                                    \
    _Pragma("unroll") for (int ks = 0; ks < 4; ++ks) {                                                       \
      s16x4 qa = *(const s16x4*)(base + fr * 272 + (ks * 32 + 4 * fq) * 2);                                  \
      s16x4 qb = *(const s16x4*)(base + fr * 272 + (ks * 32 + 16 + 4 * fq) * 2);                             \
      s16x8 Af = __builtin_shufflevector(qa, qb, 0, 1, 2, 3, 4, 5, 6, 7);                                    \
      s16x8 B0 = pack8(S[2 * ks][0], S[2 * ks + 1][0]), B1 = pack8(S[2 * ks][1], S[2 * ks + 1][1]);          \
      asm volatile("s_nop 7" : "+v"(B0), "+v"(B1), "+v"(Af));                                                \
      o0 = mfma32(Af, B0, o0);                                                                               \
      o1 = mfma32(Af, B1, o1);                                                                               \
    }                                                                                                        \
    asm volatile("s_nop 15\n\ts_nop 15" : "+v"(o0), "+v"(o1));                                               \
    _Pragma("unroll") for (int j = 0; j < 4; ++j) {                                                          \
      u16* orow = ORAW + (size_t)(tok0 + 4 * fq + j) * 1024 + h * 128 + wave * 32 + fr;                      \
      orow[0] = f2bf(o0[j] + bf2f((u16)co0[j]));                                                             \
      orow[16] = f2bf(o1[j] + bf2f((u16)co1[j]));                                                            \
    }                                                                                                        \
    _Pragma("unroll") for (int mt = 0; mt < 8; ++mt) {                                                       \
      f32x4 d = *(const f32x4*)(base + 8448 + (mt * 16 + 4 * fq) * 4);                                       \
      s16x4 ka = *(const s16x4*)(base + 4352 + (mt * 16 + fr) * 32 + fq * 8);                                \
      f32x4 s0 = S[mt][0] * d, s1 = S[mt][1] * d;                                                            \
      asm volatile("s_nop 7" : "+v"(s0), "+v"(s1), "+v"(ka));                                                \
      S[mt][0] = mfma16(ka, cv0, s0);                                                                        \
      S[mt][1] = mfma16(ka, cv1, s1);                                                                        \
    }                                                                                                        \
    asm volatile("s_nop 15\n\ts_nop 15" : "+v"(S[0][0]), "+v"(S[0][1]), "+v"(S[1][0]), "+v"(S[1][1]), "+v"(S[2][0]), "+v"(S[2][1]), "+v"(S[3][0]), "+v"(S[3][1]), "+v"(S[4][0]), "+v"(S[4][1]), "+v"(S[5][0]), "+v"(S[5][1]), "+v"(S[6][0]), "+v"(S[6][1]), "+v"(S[7][0]), "+v"(S[7][1])); \
    if (c + 1 < NCHK) SEQ_LSTORE(b ^ 1, Y)                                                                   \
    asm volatile("s_waitcnt lgkmcnt(0)\n\ts_barrier" ::: "memory");                                         \
    if (c + 1 < NCHK) { cv0 = Y##rv0; cv1 = Y##rv1; co0 = Y##ro0; co1 = Y##ro1; }                            \
  }
DI void p3_hgrn_seq(const P& p, int job, char* smem) {
  const int tid = threadIdx.x, wave = tid >> 6, lane = tid & 63, fr = lane & 15, fq = lane >> 4;
  const int n = job >> 3, h = job & 7;
  const u16* QT = unitp(p, 1);
  const u16* KTT = (const u16*)((const char*)p.out + OOFF_KTT);
  const float* DEC = (const float*)((const char*)p.out + OOFF_DEC);
  const u16* VT = unitp(p, 3);
  const u16* OIN = unitp(p, 0);
  u16* ORAW = unitp(p, 2);
  f32x4 S[8][2];
#pragma unroll
  for (int mt = 0; mt < 8; ++mt) { S[mt][0] = f32x4{0.f, 0.f, 0.f, 0.f}; S[mt][1] = f32x4{0.f, 0.f, 0.f, 0.f}; }
  const int cg0 = n * NCHK;
  uint4 Arq, Ark, Brq, Brk;
  float4 Ard = make_float4(0.f, 0.f, 0.f, 0.f), Brd = make_float4(0.f, 0.f, 0.f, 0.f);
  s16x4 Arv0, Arv1, Aro0, Aro1, Brv0, Brv1, Bro0, Bro1, cv0, cv1, co0, co1;
  SEQ_GLOAD(cg0, A)
  SEQ_LSTORE(0, A)
  cv0 = Arv0; cv1 = Arv1; co0 = Aro0; co1 = Aro1;
  SEQ_GLOAD(cg0 + 1, B)
  __syncthreads();
  for (int cc = 0; cc < NCHK - 1; cc += 2) {
    SEQ_BODY(cc, A, B)
    SEQ_BODY(cc + 1, B, A)
  }
  SEQ_BODY(NCHK - 1, A, B)
  float* HG = p.out + O_HGP + ((size_t)(n * 8 + h) * 128) * 128;
#pragma unroll
  for (int mt = 0; mt < 8; ++mt)
#pragma unroll
    for (int nt = 0; nt < 2; ++nt)
#pragma unroll
      for (int j = 0; j < 4; ++j) HG[(size_t)(mt * 16 + 4 * fq + j) * 128 + wave * 32 + nt * 16 + fr] = S[mt][nt][j];
}

DI void p3_hgrn_sample(const P& p, int job, char* smem) {
  const int tid = threadIdx.x;
  const int ns = job >> 3, h = job & 7;
  const int v = tid & 127, kh = tid >> 7;
  const u16* R1 = unitp(p, 1);
  const u16* R2 = unitp(p, 2 + 0);
  const u16* VT = unitp(p, 3);
  u16* ORAW = unitp(p, 2);
  const float* LB = (const float*)(p.ws + OFF_LB);
  float* sg = (float*)smem;
  float* skk = sg + 512;
  float* sq = skk + 512;
  float* so = sq + 512;
  const int tokb = TP + ns * 4;
  float fraw[4];
  if (tid < 128) {
    const float lb = LB[h * 128 + tid];
#pragma unroll
    for (int t = 0; t < 4; ++t) {
      size_t gi = (size_t)(tokb + t) * 1024 + h * 128 + tid;
      float f = bf2f(R2[gi]);
      fraw[t] = f;
      float e = __expf(-f);
      sg[t * 128 + tid] = lb + (1.f - lb) / (1.f + e);
      skk[t * 128 + tid] = (1.f - lb) * e / (1.f + e);
      sq[t * 128 + tid] = bf2f(R1[gi]);
    }
  }
  (void)fraw;
  float S[64];
  const float* st = p.state_hgrn + ((size_t)(ns * 8 + h) * 128 + kh * 64) * 128 + v;
#pragma unroll
  for (int i = 0; i < 64; ++i) S[i] = st[(size_t)i * 128];
  float vt[4];
#pragma unroll
  for (int t = 0; t < 4; ++t) {
    int tok = tokb + t;
    vt[t] = bf2f(VT[((size_t)(tok >> 4) * 1024 + h * 128 + v) * 16 + (tok & 15)]);
  }
  __syncthreads();
#pragma unroll
  for (int t = 0; t < 4; ++t) {
    float op = 0.f;
#pragma unroll
    for (int i = 0; i < 64; ++i) {
      int k = t * 128 + kh * 64 + i;
      S[i] = sg[k] * S[i] + skk[k] * vt[t];
      op += sq[k] * S[i];
    }
    so[(t * 2 + kh) * 128 + v] = op;
  }
  float* HG = p.out + O_HGS + ((size_t)(ns * 8 + h) * 128 + kh * 64) * 128 + v;
#pragma unroll
  for (int i = 0; i < 64; ++i) HG[(size_t)i * 128] = S[i];
  __syncthreads();
  if (tid < 128) {
#pragma unroll
    for (int t = 0; t < 4; ++t)
      ORAW[(size_t)(tokb + t) * 1024 + h * 128 + tid] = f2bf(so[(t * 2) * 128 + tid] + so[(t * 2 + 1) * 128 + tid]);
  }
  __syncthreads();
}

DI void p3_s5c(const P& p, int mode, int seq, int c, int gq, char* smem) {
  const int tid = threadIdx.x, wave = tid >> 6, lane = tid & 63, fr = lane & 15, fq = lane >> 4;
  const int g = gq * 4 + wave, pp = lane;
  float br[16], bi[16];
  s5_load_bbar(p, g, pp, br, bi);
  const float2 ab = ((const float2*)(p.ws + OFF_ABAR))[g * 64 + pp];
  float xr, xi;
  int tok0, ntok;
  if (mode == 0) {
    const float2 ap = ((const float2*)(p.ws + OFF_APOW))[g * 64 + pp];
    const float2* E = (const float2*)((const char*)p.out + OOFF_E) + ((size_t)(seq * 43) * 64 + g) * 64 + pp;
    xr = 0.f; xi = 0.f;
    for (int j0 = 0; j0 < c; j0 += 8) {
      float2 e[8];
#pragma unroll
      for (int i = 0; i < 8; ++i) e[i] = E[(size_t)min(j0 + i, c - 1) * 4096];
#pragma unroll
      for (int i = 0; i < 8; ++i)
        if (j0 + i < c) {
          float nr = ap.x * xr - ap.y * xi + e[i].x, ni = ap.x * xi + ap.y * xr + e[i].y;
          xr = nr; xi = ni;
        }
    }
    tok0 = seq * LP + c * 48;
    ntok = 48;
  } else {
    xr = p.ssm_re[((size_t)seq * 64 + g) * 64 + pp];
    xi = p.ssm_im[((size_t)seq * 64 + g) * 64 + pp];
    tok0 = TP + seq * 4;
    ntok = 4;
  }
  s16x8 cf[4];
#pragma unroll
  for (int ks = 0; ks < 4; ++ks) {
    int p0 = ks * 32 + fq * 8;
    const float* src = (p0 < 64 ? p.c_re : p.c_im) + ((size_t)g * 16 + fr) * 64 + (p0 & 63);
    float sgn = p0 < 64 ? 1.f : -1.f;
    float4 a = *(const float4*)src, b = *(const float4*)(src + 4);
    uint4 u = make_uint4(pack2(sgn * a.x, sgn * a.y), pack2(sgn * a.z, sgn * a.w), pack2(sgn * b.x, sgn * b.y),
                         pack2(sgn * b.z, sgn * b.w));
    cf[ks] = __builtin_bit_cast(s16x8, u);
  }
  const float dsk = p.ssm_d[g * 16 + fr];
  u16* U = unitp(p, 5);
  char* xs = smem + wave * 4352;
  const int nsub = (ntok + 15) >> 4;
  uint4 ua, ub;
  {
    const u16* r = U + (size_t)(tok0 + min(pp, ntok - 1)) * 1024 + g * 16;
    ua = *(const uint4*)r;
    ub = *(const uint4*)(r + 8);
  }
  for (int sc = 0; sc < nsub; ++sc) {
    const int tb = tok0 + sc * 16;
    const int nt = min(16, ntok - sc * 16);
#pragma unroll 4
    for (int t = 0; t < 16; ++t) {
      if (t < nt) {
        s5_step(ua, ub, sc * 16 + t, br, bi, ab.x, ab.y, xr, xi);
        *(u16*)(xs + t * 272 + pp * 2) = f2bf(xr);
        *(u16*)(xs + t * 272 + 128 + pp * 2) = f2bf(xi);
      } else {
        *(u16*)(xs + t * 272 + pp * 2) = 0;
        *(u16*)(xs + t * 272 + 128 + pp * 2) = 0;
      }
    }
    __syncthreads();
    f32x4 y = {0.f, 0.f, 0.f, 0.f};
#pragma unroll
    for (int ks = 0; ks < 4; ++ks) {
      s16x8 a = *(const s16x8*)(xs + fr * 272 + ks * 64 + fq * 16);
      y = mfma32(a, cf[ks], y);
    }
    asm volatile("s_nop 15\n\ts_nop 15" : "+v"(y));
#pragma unroll
    for (int j = 0; j < 4; ++j) {
      int t = 4 * fq + j;
      if (t < nt) {
        size_t gi = (size_t)(tb + t) * 1024 + g * 16 + fr;
        float uu = bf2f(U[gi]);
        U[gi] = f2bf(geluf_(y[j] + dsk * uu));
      }
    }
    __syncthreads();
  }
  if (mode == 0) {
    if (c == 42) {
      p.out[O_SRP + ((size_t)seq * 64 + g) * 64 + pp] = xr;
      p.out[O_SIP + ((size_t)seq * 64 + g) * 64 + pp] = xi;
    }
  } else {
    p.out[O_SRS + ((size_t)seq * 64 + g) * 64 + pp] = xr;
    p.out[O_SIS + ((size_t)seq * 64 + g) * 64 + pp] = xi;
  }
}
DI void p3_s5chain(const P& p, int job, char* smem) {
  const int tid = threadIdx.x, wave = tid >> 6, lane = tid & 63, fr = lane & 15, fq = lane >> 4;
  const int n = job >> 4, gq = job & 15;
  const int g = gq * 4 + wave, pp = lane;
  const float2 ab = ((const float2*)(p.ws + OFF_ABAR))[g * 64 + pp];
  s16x4 bb[8];
#pragma unroll
  for (int nt = 0; nt < 8; ++nt) {
    const float4* src = (const float4*)((const float2*)(p.ws + OFF_BBAR) + ((size_t)g * 64 + (nt & 3) * 16 + fr) * 16 + 4 * fq);
    float4 v0 = src[0], v1 = src[1];
    f32x4 sel = (nt < 4) ? f32x4{v0.x, v0.z, v1.x, v1.z} : f32x4{v0.y, v0.w, v1.y, v1.w};
    bb[nt] = pack4(sel);
  }
  s16x8 cf[4];
#pragma unroll
  for (int ks = 0; ks < 4; ++ks) {
    int p0 = ks * 32 + fq * 8;
    const float* src = (p0 < 64 ? p.c_re : p.c_im) + ((size_t)g * 16 + fr) * 64 + (p0 & 63);
    float sgn = p0 < 64 ? 1.f : -1.f;
    float4 a = *(const float4*)src, b = *(const float4*)(src + 4);
    uint4 u = make_uint4(pack2(sgn * a.x, sgn * a.y), pack2(sgn * a.z, sgn * a.w), pack2(sgn * b.x, sgn * b.y),
                         pack2(sgn * b.z, sgn * b.w));
    cf[ks] = __builtin_bit_cast(s16x8, u);
  }
  const float dsk = p.ssm_d[g * 16 + fr];
  u16* U = unitp(p, 5);
  char* xs = smem + wave * 12800;
  float* bu = (float*)(xs + 4352);
  float xr = 0.f, xi = 0.f;
  const int tokb = n * LP;
  s16x4 ua[3], na[3];
  u16 us[3][4], ns[3][4];
#pragma unroll
  for (int sc = 0; sc < 3; ++sc) {
    ua[sc] = *(const s16x4*)(U + (size_t)(tokb + sc * 16 + fr) * 1024 + g * 16 + 4 * fq);
#pragma unroll
    for (int j = 0; j < 4; ++j) us[sc][j] = U[(size_t)(tokb + sc * 16 + 4 * fq + j) * 1024 + g * 16 + fr];
  }
  for (int c = 0; c < 43; ++c) {
#pragma unroll
    for (int sc = 0; sc < 3; ++sc) {
      na[sc] = ua[sc];
#pragma unroll
      for (int j = 0; j < 4; ++j) ns[sc][j] = us[sc][j];
      if (c + 1 < 43) {
        na[sc] = *(const s16x4*)(U + (size_t)(tokb + (c + 1) * 48 + sc * 16 + fr) * 1024 + g * 16 + 4 * fq);
#pragma unroll
        for (int j = 0; j < 4; ++j) ns[sc][j] = U[(size_t)(tokb + (c + 1) * 48 + sc * 16 + 4 * fq + j) * 1024 + g * 16 + fr];
      }
    }
#pragma unroll
    for (int sc = 0; sc < 3; ++sc) {
      const int tb = tokb + c * 48 + sc * 16;
      s16x4 au = ua[sc];
      asm volatile("s_nop 3" : "+v"(au));
      f32x4 r[8];
#pragma unroll
      for (int nt = 0; nt < 8; ++nt) r[nt] = mfma16(au, bb[nt], f32x4{0.f, 0.f, 0.f, 0.f});
      asm volatile("s_nop 15" : "+v"(r[0]), "+v"(r[1]), "+v"(r[2]), "+v"(r[3]), "+v"(r[4]), "+v"(r[5]), "+v"(r[6]), "+v"(r[7]));
#pragma unroll
      for (int nt = 0; nt < 8; ++nt)
#pragma unroll
        for (int j = 0; j < 4; ++j) bu[(4 * fq + j) * 132 + nt * 16 + fr] = r[nt][j];
      __builtin_amdgcn_wave_barrier();
      float bre[16], bim[16];
#pragma unroll
      for (int t = 0; t < 16; ++t) { bre[t] = bu[t * 132 + pp]; bim[t] = bu[t * 132 + 64 + pp]; }
#pragma unroll
      for (int t = 0; t < 16; ++t) {
        float nr = ab.x * xr - ab.y * xi + bre[t], ni = ab.x * xi + ab.y * xr + bim[t];
        xr = nr; xi = ni;
        *(u16*)(xs + t * 272 + pp * 2) = f2bf(xr);
        *(u16*)(xs + t * 272 + 128 + pp * 2) = f2bf(xi);
      }
      __builtin_amdgcn_wave_barrier();
      f32x4 y = {0.f, 0.f, 0.f, 0.f};
#pragma unroll
      for (int ks = 0; ks < 4; ++ks) {
        s16x8 a = *(const s16x8*)(xs + fr * 272 + ks * 64 + fq * 16);
        y = mfma32(a, cf[ks], y);
      }
      asm volatile("s_nop 15\n\ts_nop 15" : "+v"(y));
#pragma unroll
      for (int j = 0; j < 4; ++j) {
        size_t gi = (size_t)(tb + 4 * fq + j) * 1024 + g * 16 + fr;
        U[gi] = f2bf(geluf_(y[j] + dsk * bf2f(us[sc][j])));
      }
    }
#pragma unroll
    for (int sc = 0; sc < 3; ++sc) {
      ua[sc] = na[sc];
#pragma unroll
      for (int j = 0; j < 4; ++j) us[sc][j] = ns[sc][j];
    }
  }
  p.out[O_SRP + ((size_t)n * 64 + g) * 64 + pp] = xr;
  p.out[O_SIP + ((size_t)n * 64 + g) * 64 + pp] = xi;
}
constexpr int NJ3_A = 64, NJ3_CH = 128, NJ3_B = 1024, NJ3_D = 128 * 16;
constexpr int NJ3_REST = NJ3_B + NJ3_D;
DI void phase3rest(const P& p, int job, char* smem) {
  if (job < NJ3_B) p3_hgrn_sample(p, job, smem);
  else { int j = job - NJ3_B; p3_s5c(p, 1, j >> 4, 0, j & 15, smem); }
}

DI void p4_onorm(const P& p, int job) {
  const int lane = threadIdx.x & 63;
  const int tk = job * 4 + (threadIdx.x >> 6);
  u16* O = unitp(p, 2) + (size_t)tk * 1024 + lane * 16;
  const u16* SG = unitp(p, 4) + (size_t)tk * 1024 + lane * 16;
  uint4 a0 = *(const uint4*)O, a1 = *(const uint4*)(O + 8);
  uint4 g0 = *(const uint4*)SG, g1 = *(const uint4*)(SG + 8);
  unsigned ov[8] = {a0.x, a0.y, a0.z, a0.w, a1.x, a1.y, a1.z, a1.w};
  unsigned gv[8] = {g0.x, g0.y, g0.z, g0.w, g1.x, g1.y, g1.z, g1.w};
  float ss = 0.f;
#pragma unroll
  for (int i = 0; i < 8; ++i) { float a = bflo(ov[i]), b = bfhi(ov[i]); ss += a * a + b * b; }
  ss += __shfl_xor(ss, 1);
  ss += __shfl_xor(ss, 2);
  ss += __shfl_xor(ss, 4);
  const float rs = rsqrtf(ss * (1.f / 128.f) + EPS);
  const float* gw = p.g_norm_w + (lane & 7) * 16;
  unsigned r[8];
#pragma unroll
  for (int i = 0; i < 8; ++i) {
    float a = bflo(ov[i]) * rs * gw[2 * i] * bflo(gv[i]);
    float b = bfhi(ov[i]) * rs * gw[2 * i + 1] * bfhi(gv[i]);
    r[i] = pack2(a, b);
  }
  *(uint4*)O = make_uint4(r[0], r[1], r[2], r[3]);
  *(uint4*)(O + 8) = make_uint4(r[4], r[5], r[6], r[7]);
}
DI void p4_glu(const P& p, int job, char* smem) {
  const int pm = job >> 3, pn = job & 7;
  const int brow = pm * 128, bcol = pn * 128;
  f32x4 acc[4][4];
  ZERO_ACC(acc);
  const u16* Y = unitp(p, 5);
  gemm_core(Y, 1024, (const u16*)(p.ws + OFF_WTGLU), 1024, 1024, brow, bcol, smem, acc);
  EPI_VARS;
  u16* Z = unitp(p, 1);
  EPI_BASE(1024, brow, bcol);
  EPI_LOOP {
    float bb = p.b_glu[bcol + wc * 64 + n * 16 + fr];
#pragma unroll
    for (int j = 0; j < 4; ++j) {
      int gi = idx0 + (m * 16 + j) * 1024 + n * 16;
      Z[gi] = f2bf(bf2f(Y[gi]) * sigmoidf_(acc[m][n][j] + bb));
    }
  }
}
constexpr int NJ4_A = T / 4, NJ4 = NJ4_A + 133 * 8;

DI void phase5(const P& p, int job, char* smem) {
  const int pm = job >> 3, pn = job & 7;
  const int brow = pm * 128, bcol = pn * 128;
  EPI_VARS;
  u16* MX = unitp(p, 3);
#pragma unroll 1
  for (int pass = 0; pass < 2; ++pass) {
    f32x4 acc[4][4];
    ZERO_ACC(acc);
    gemm_core(unitp(p, pass ? 1 : 2), 1024, (const u16*)(p.ws + (pass ? OFF_WTB : OFF_WTA)), 1024, 1024, brow, bcol,
              smem, acc);
    const u16* GT = unitp(p, 6 + pass);
    EPI_BASE(1024, brow, bcol);
    EPI_LOOP {
#pragma unroll
      for (int j = 0; j < 4; ++j) {
        int gi = idx0 + (m * 16 + j) * 1024 + n * 16;
        float prev = pass ? bf2f(MX[gi]) : 0.f;
        MX[gi] = f2bf(prev + acc[m][n][j] * bf2f(GT[gi]));
      }
    }
  }
}
constexpr int NJ5 = 133 * 8;

DI void phase6(const P& p, int job, char* smem) {
  const int pm = job >> 3, pn = job & 7;
  const int brow = pm * 128, bcol = pn * 128;
  EPI_VARS;
  f32x4 acc[4][4];
  ZERO_ACC(acc);
  gemm_core(unitp(p, 3), 1024, (const u16*)(p.ws + OFF_WTOUT), 1024, 1024, brow, bcol, smem, acc);
  float* X1 = (float*)unitp(p, 0);
  int rb = brow + wr * 64 + fq * 4, cbv = bcol + wc * 64 + fr;
  asm volatile("" : "+v"(rb), "+v"(cbv));
#pragma unroll
  for (int m = 0; m < 4; ++m) {
#pragma unroll
    for (int j = 0; j < 4; ++j) {
      const int row = rb + m * 16 + j;
      const float* xr = xrow(p, row) + cbv;
      float* xo = X1 + (size_t)row * 1024 + cbv;
#pragma unroll
      for (int n = 0; n < 4; ++n) xo[n * 16] = xr[n * 16] + acc[m][n][j];
    }
  }
}
constexpr int NJ6 = 133 * 8;

DI void phase7(const P& p, int job) {
  int tk = job * 4 + (threadIdx.x >> 6);
  rms_row_to_bf16((const float*)unitp(p, 0) + (size_t)tk * 1024, p.norm2_w, unitp(p, 2) + (size_t)tk * 1024,
                  threadIdx.x & 63);
}
constexpr int NJ7 = T / 4;
DI void convert_tables(const P& p, int j) {
  const float* src = (j < 4096 ? p.peer_u : p.peer_v) + (size_t)(j & 4095) * 4096 + threadIdx.x * 16;
  const float sc = j < 4096 ? 64.f : 16.f;
  unsigned char* dst = (unsigned char*)unitp(p, 6) + (size_t)j * 4096 + threadIdx.x * 16;
  unsigned w[4];
#pragma unroll
  for (int i = 0; i < 4; ++i) {
    float4 a = *(const float4*)(src + 4 * i);
    int d = __builtin_amdgcn_cvt_pk_fp8_f32(a.x * sc, a.y * sc, 0, false);
    d = __builtin_amdgcn_cvt_pk_fp8_f32(a.z * sc, a.w * sc, d, true);
    w[i] = (unsigned)d;
  }
  *(uint4*)dst = make_uint4(w[0], w[1], w[2], w[3]);
}

DI void phase8(const P& p, int job, char* smem) {
  const int pm = job >> 4, pn = job & 15;
  const int brow = pm * 128, bcol = pn * 128;
  EPI_VARS;
  f32x4 acc[4][4];
  ZERO_ACC(acc);
  gemm_core(unitp(p, 2), 1024, (const u16*)(p.ws + OFF_WTQ), 1024, 1024, brow, bcol, smem, acc);
  u16* Q = unitp(p, 3);
  EPI_BASE(2048, brow, bcol);
  EPI_LOOP {
#pragma unroll
    for (int j = 0; j < 4; ++j) Q[idx0 + (m * 16 + j) * 2048 + n * 16] = f2bf(acc[m][n][j]);
  }
}
constexpr int NJ8 = 133 * 16;

DI int f2key(float f) { int s = __float_as_int(f); return s ^ ((s >> 31) & 0x7fffffff); }
DI float key2f(int k) { return __int_as_float(k ^ ((k >> 31) & 0x7fffffff)); }
DI int rowmax16(int x) {
  x = max(x, __builtin_amdgcn_update_dpp(0, x, 0x128, 0xf, 0xf, false));
  x = max(x, __builtin_amdgcn_update_dpp(0, x, 0x124, 0xf, 0xf, false));
  x = max(x, __builtin_amdgcn_update_dpp(0, x, 0x122, 0xf, 0xf, false));
  x = max(x, __builtin_amdgcn_update_dpp(0, x, 0x121, 0xf, 0xf, false));
  return x;
}
DI void phase9(const P& p, int job) {
  const int tid = threadIdx.x, wave = tid >> 6, lane = tid & 63, fr = lane & 15, fq = lane >> 4;
  const int tile = job >> 1, h = (job & 1) * 4 + wave;
  const int tok0 = tile * 16;
  const u16* QRY = unitp(p, 3);
  int* EXPI = (int*)unitp(p, 5);
  float* GATE = (float*)((char*)unitp(p, 5) + (size_t)T * 128 * 4);
  float v12[2][4];
  int i12[2][4];
#pragma unroll
  for (int half = 0; half < 2; ++half) {
    f32x4 acc[8];
#pragma unroll
    for (int nt = 0; nt < 8; ++nt) acc[nt] = f32x4{0.f, 0.f, 0.f, 0.f};
    const u16* Kb = (const u16*)(p.ws + (half ? OFF_K2 : OFF_K1)) + (size_t)h * 128 * 128;
#pragma unroll
    for (int ks = 0; ks < 4; ++ks) {
      s16x8 a = *(const s16x8*)(QRY + (size_t)(tok0 + fr) * 2048 + h * 256 + half * 128 + ks * 32 + fq * 8);
#pragma unroll
      for (int nt = 0; nt < 8; ++nt) {
        s16x8 b = *(const s16x8*)(Kb + (size_t)(nt * 16 + fr) * 128 + ks * 32 + fq * 8);
        acc[nt] = mfma32(a, b, acc[nt]);
      }
    }
    asm volatile("s_nop 15\n\ts_nop 15" : "+v"(acc[0]), "+v"(acc[1]), "+v"(acc[2]), "+v"(acc[3]), "+v"(acc[4]), "+v"(acc[5]), "+v"(acc[6]), "+v"(acc[7]));
#pragma unroll
    for (int j = 0; j < 4; ++j) {
      int keys[8];
#pragma unroll
      for (int nt = 0; nt < 8; ++nt) keys[nt] = (f2key(acc[nt][j]) & ~127) | (127 - (nt * 16 + fr));
#define CX(a, b) { int hi_ = max(keys[a], keys[b]), lo_ = min(keys[a], keys[b]); keys[a] = hi_; keys[b] = lo_; }
      CX(0, 1) CX(2, 3) CX(4, 5) CX(6, 7)
      CX(0, 2) CX(1, 3) CX(4, 6) CX(5, 7)
      CX(1, 2) CX(5, 6)
      CX(0, 4) CX(1, 5) CX(2, 6) CX(3, 7)
      CX(2, 4) CX(3, 5)
      CX(1, 2) CX(3, 4) CX(5, 6)
#undef CX
      int mine = 0;
      for (int r = 0; r < 16; ++r) {
        int wk = rowmax16(keys[0]);
        if (fr == r) mine = wk;
        if (keys[0] == wk) {
#pragma unroll
          for (int nt = 0; nt < 7; ++nt) keys[nt] = keys[nt + 1];
          keys[7] = (int)0x80000000;
        }
      }
      v12[half][j] = key2f(mine & ~127);
      i12[half][j] = 127 - (mine & 127);
    }
  }
#pragma unroll
  for (int j = 0; j < 4; ++j) {
    const float v1 = v12[0][j], v2 = v12[1][j];
    const int e1 = i12[0][j], e2 = i12[1][j];
    int ptr = 0;
    float sc = 0.f;
    int ex = 0;
    const int gbase = lane & ~15;
    for (int r = 0; r < 16; ++r) {
      int pc = min(ptr, 15);
      float v2p = __shfl(v2, gbase + pc);
      int e2p = __shfl(e2, gbase + pc);
      int key = ptr < 16 ? ((f2key(v1 + v2p) & ~255) | (255 - (fr * 16 + ptr))) : (int)0x80000000;
      int wk = rowmax16(key);
      int pos = 255 - (wk & 255);
      int wi = pos >> 4;
      int myexp = e1 * 128 + e2p;
      int wexp = __shfl(myexp, gbase + wi);
      if (fr == r) { sc = key2f(wk & ~255); ex = wexp; }
      if (fr == wi) ptr++;
    }
    float mx = sc;
    mx = fmaxf(mx, __shfl_xor(mx, 1));
    mx = fmaxf(mx, __shfl_xor(mx, 2));
    mx = fmaxf(mx, __shfl_xor(mx, 4));
    mx = fmaxf(mx, __shfl_xor(mx, 8));
    float e = __expf(sc - mx);
    float sm = e;
    sm += __shfl_xor(sm, 1);
    sm += __shfl_xor(sm, 2);
    sm += __shfl_xor(sm, 4);
    sm += __shfl_xor(sm, 8);
    size_t oi = (size_t)(tok0 + 4 * fq + j) * 128 + h * 16 + fr;
    EXPI[oi] = ex;
    GATE[oi] = e / sm;
  }
}
constexpr int NJ9 = 1064 * 2;

typedef float f32x2v __attribute__((ext_vector_type(2)));
DI void unpack16(const uint4& a, float (&x)[16]) {
  const unsigned w[4] = {a.x, a.y, a.z, a.w};
#pragma unroll
  for (int i = 0; i < 4; ++i) {
    f32x2v lo = __builtin_amdgcn_cvt_pk_f32_fp8((int)w[i], false);
    f32x2v hi = __builtin_amdgcn_cvt_pk_f32_fp8((int)w[i], true);
    x[4 * i] = lo[0]; x[4 * i + 1] = lo[1]; x[4 * i + 2] = hi[0]; x[4 * i + 3] = hi[1];
  }
}
#define LANE_OF(k) ((((k) >> 3) & 1) * 32 + (((k) >> 2) & 1) * 16 + (((k) >> 1) & 1) * 8 + ((k)&1) * 4)
DI void phase10(const P& p, int job) {
  const int lane = threadIdx.x & 63;
  const int tk = job * 4 + (threadIdx.x >> 6);
  float* dst;
  if (tk < TP) {
    int n = tk / LP, l = tk - n * LP;
    if (l < 16) return;
    dst = p.out + O_YP + ((size_t)n * 2048 + (l - 16)) * 1024;
  } else {
    dst = p.out + O_YS + (size_t)(tk - TP) * 1024;
  }
  const float* X1 = (const float*)unitp(p, 0) + (size_t)tk * 1024;
  const u16* H2 = unitp(p, 2) + (size_t)tk * 1024;
  const int* EXPI = (const int*)unitp(p, 5) + (size_t)tk * 128;
  const float* GATE = (const float*)((const char*)unitp(p, 5) + (size_t)T * 128 * 4) + (size_t)tk * 128;
  const unsigned char* UT = (const unsigned char*)unitp(p, 6);
  const unsigned char* VTB = UT + (size_t)16384 * 1024;
  float hv[16];
  {
    uint4 a = *(const uint4*)(H2 + lane * 16), b = *(const uint4*)(H2 + lane * 16 + 8);
    hv[0] = bflo(a.x); hv[1] = bfhi(a.x); hv[2] = bflo(a.y); hv[3] = bfhi(a.y);
    hv[4] = bflo(a.z); hv[5] = bfhi(a.z); hv[6] = bflo(a.w); hv[7] = bfhi(a.w);
    hv[8] = bflo(b.x); hv[9] = bfhi(b.x); hv[10] = bflo(b.y); hv[11] = bfhi(b.y);
    hv[12] = bflo(b.z); hv[13] = bfhi(b.z); hv[14] = bflo(b.w); hv[15] = bfhi(b.w);
  }
  float ov[16];
#pragma unroll
  for (int i = 0; i < 16; ++i) ov[i] = 0.f;
  const int kmine = ((lane >> 5) & 1) * 8 + ((lane >> 4) & 1) * 4 + ((lane >> 3) & 1) * 2 + ((lane >> 2) & 1);
  const bool b5 = lane & 32, b4 = lane & 16, b3 = lane & 8, b2 = lane & 4;
  for (int h = 0; h < 8; ++h) {
    const int e_l = EXPI[h * 16 + kmine];
    const float g_l = GATE[h * 16 + kmine];
    float part[16];
#pragma unroll
    for (int k = 0; k < 16; ++k) {
      int e = __builtin_amdgcn_readlane(e_l, LANE_OF(k));
      uint4 a = *(const uint4*)(UT + (size_t)e * 1024 + lane * 16);
      float x[16];
      unpack16(a, x);
      float d = 0.f;
#pragma unroll
      for (int i = 0; i < 16; ++i) d += x[i] * hv[i];
      part[k] = d;
    }
    float r8[8], r4[4], r2[2];
#pragma unroll
    for (int i = 0; i < 8; ++i) {
      float send = b5 ? part[i] : part[i + 8], keep = b5 ? part[i + 8] : part[i];
      r8[i] = keep + __shfl_xor(send, 32);
    }
#pragma unroll
    for (int i = 0; i < 4; ++i) {
      float send = b4 ? r8[i] : r8[i + 4], keep = b4 ? r8[i + 4] : r8[i];
      r4[i] = keep + __shfl_xor(send, 16);
    }
#pragma unroll
    for (int i = 0; i < 2; ++i) {
      float send = b3 ? r4[i] : r4[i + 2], keep = b3 ? r4[i + 2] : r4[i];
      r2[i] = keep + __shfl_xor(send, 8);
    }
    float d;
    {
      float send = b2 ? r2[0] : r2[1], keep = b2 ? r2[1] : r2[0];
      d = keep + __shfl_xor(send, 4);
    }
    d += __shfl_xor(d, 2);
    d += __shfl_xor(d, 1);
    const float w_l = g_l * geluf_(d * (1.f / 64.f)) * (1.f / 16.f);
#pragma unroll
    for (int k = 0; k < 16; ++k) {
      int e = __builtin_amdgcn_readlane(e_l, LANE_OF(k));
      float w = __builtin_bit_cast(float, __builtin_amdgcn_readlane(__builtin_bit_cast(int, w_l), LANE_OF(k)));
      uint4 a = *(const uint4*)(VTB + (size_t)e * 1024 + lane * 16);
      float x[16];
      unpack16(a, x);
#pragma unroll
      for (int i = 0; i < 16; ++i) ov[i] += w * x[i];
    }
  }
  float ss = 0.f;
#pragma unroll
  for (int i = 0; i < 4; ++i) {
    float4 x = *(const float4*)(X1 + lane * 16 + i * 4);
    ov[4 * i] += x.x; ov[4 * i + 1] += x.y; ov[4 * i + 2] += x.z; ov[4 * i + 3] += x.w;
    ss += ov[4 * i] * ov[4 * i] + ov[4 * i + 1] * ov[4 * i + 1] + ov[4 * i + 2] * ov[4 * i + 2] + ov[4 * i + 3] * ov[4 * i + 3];
  }
  ss = wave_sum(ss);
  const float rs = rsqrtf(ss * (1.f / 1024.f) + EPS);
#pragma unroll
  for (int i = 0; i < 4; ++i) {
    int eo = lane * 16 + i * 4;
    float4 w = *(const float4*)(p.final_w + eo);
    *(float4*)(dst + eo) =
        make_float4(ov[4 * i] * rs * w.x, ov[4 * i + 1] * rs * w.y, ov[4 * i + 2] * rs * w.z, ov[4 * i + 3] * rs * w.w);
  }
}
constexpr int NJ10 = T / 4;


#define XB_TMO      128
#define XB_XCNT(j)  (256  + 64 * (j))
#define XB_XSUB(j)  (1280 + 64 * (j))
#define XB_XGEN(j)  (2304 + 64 * (j))
#define XB_TOP      3328
#define XB_TOPGEN   3392
#define XCD_BAR_WORDS 3456
#define XB_SPIN_CAP (1u << 18)
#define LAS __attribute__((address_space(3)))

__device__ __forceinline__ unsigned xb_ld(unsigned* p)              { return __hip_atomic_load(p, __ATOMIC_RELAXED, __HIP_MEMORY_SCOPE_AGENT); }
__device__ __forceinline__ unsigned xb_add(unsigned* p, unsigned v) { return __hip_atomic_fetch_add(p, v, __ATOMIC_RELAXED, __HIP_MEMORY_SCOPE_AGENT); }
__device__ __forceinline__ unsigned xb_xcc_id() { return (unsigned)__builtin_amdgcn_s_getreg((3 << 11) | 20) & 0xFu; }
#define XB_SPIN(cond, bar) do { unsigned _sp = 0; while (cond) { __builtin_amdgcn_s_sleep(1); \
    if ((++_sp & 255u) == 0u) { if (xb_ld(&(bar)[XB_TMO])) break; if (_sp > XB_SPIN_CAP) { atomicAdd(&(bar)[XB_TMO], 1u); break; } } } } while (0)

struct XcdBarrier {
    unsigned* bar; unsigned x;
    volatile LAS unsigned* st;
};

__device__ __forceinline__ XcdBarrier xcd_barrier_post(unsigned* bar, volatile LAS unsigned* st) {
    XcdBarrier b; b.bar = bar; b.x = xb_xcc_id(); b.st = st;
    if (threadIdx.x == 0) (void)xb_add(&bar[XB_XCNT(b.x)], 1u);
    return b;
}
__device__ __forceinline__ void xcd_barrier_complete(unsigned* bar, unsigned x, unsigned& nloc, unsigned& nx) {
    const unsigned G = gridDim.x * gridDim.y * gridDim.z;
    unsigned sum, cnt, mine, sp = 0u;
    for (;;) {
        sum = 0u; cnt = 0u; mine = 0u;
#pragma unroll
        for (unsigned j = 0; j < 16; ++j) { const unsigned c = xb_ld(&bar[XB_XCNT(j)]); sum += c; cnt += (c > 0u) ? 1u : 0u; mine = (j == x) ? c : mine; }
        if (sum == G) break;
        __builtin_amdgcn_s_sleep(1);
        if ((++sp & 255u) == 0u) { if (xb_ld(&bar[XB_TMO])) break; if (sp > XB_SPIN_CAP) { atomicAdd(&bar[XB_TMO], 1u); break; } }
    }
    nloc = mine > 0u ? mine : 1u; nx = cnt > 0u ? cnt : 1u;
}

__device__ __forceinline__ void xcd_barrier(const XcdBarrier& b) {
    asm volatile("s_waitcnt vmcnt(0)" ::: "memory");
    __syncthreads();
    if (threadIdx.x == 0) {
        unsigned* bar = b.bar;
        __builtin_amdgcn_s_waitcnt(0);
        unsigned nloc = b.st[0], nx = b.st[1];
        if (nloc == 0u) { xcd_barrier_complete(bar, b.x, nloc, nx); b.st[0] = nloc; b.st[1] = nx; }
        const unsigned old = xb_add(&bar[XB_XSUB(b.x)], 1u);
        const unsigned gen = old / nloc;
        if (old + 1u == (gen + 1u) * nloc) {
            __builtin_amdgcn_fence(__ATOMIC_RELEASE, "agent");
            asm volatile("s_waitcnt vmcnt(0)" ::: "memory");
            const unsigned og = xb_add(&bar[XB_TOP], 1u);
            const unsigned tg = og / nx;
            if (og + 1u == (tg + 1u) * nx) xb_add(&bar[XB_TOPGEN], 1u);
            else XB_SPIN(xb_ld(&bar[XB_TOPGEN]) == tg, bar);
            __builtin_amdgcn_fence(__ATOMIC_ACQUIRE, "agent");
            xb_add(&bar[XB_XGEN(b.x)], 1u);
            asm volatile("s_waitcnt vmcnt(0)" ::: "memory");
        } else {
            XB_SPIN(xb_ld(&bar[XB_XGEN(b.x)]) == gen, bar);
            __builtin_amdgcn_fence(__ATOMIC_ACQUIRE, "agent");
            asm volatile("s_waitcnt vmcnt(0)" ::: "memory");
        }
    }
    __syncthreads();
}


DI void my_sync(unsigned* bar, unsigned target) {
  asm volatile("s_waitcnt vmcnt(0)" ::: "memory");
  __syncthreads();
  if (threadIdx.x == 0) {
    __builtin_amdgcn_fence(__ATOMIC_RELEASE, "agent");
    asm volatile("s_waitcnt vmcnt(0)" ::: "memory");
    __hip_atomic_fetch_add(bar, 1u, __ATOMIC_RELAXED, __HIP_MEMORY_SCOPE_AGENT);
    while (__hip_atomic_load(bar, __ATOMIC_RELAXED, __HIP_MEMORY_SCOPE_AGENT) < target) __builtin_amdgcn_s_sleep(2);
    __builtin_amdgcn_fence(__ATOMIC_ACQUIRE, "agent");
    asm volatile("s_waitcnt vmcnt(0)" ::: "memory");
  }
  __syncthreads();
}
__global__ void __launch_bounds__(256, 2) mega(P p, int ph_lo, int ph_hi) {
  __shared__ __attribute__((aligned(16))) char smem[SMEM_BYTES];
  cg::grid_group grid = cg::this_grid();
  const int G = gridDim.x, B = blockIdx.x;
#define RUN_PHASE(n) if ((ONLY < 0 || ONLY == n) && ph_lo <= n && n < ph_hi)
  __shared__ uint4 xb_words;
  if (threadIdx.x == 0) xb_words = make_uint4(0u, 0u, 0u, 0u);
  __syncthreads();
  XcdBarrier xb = xcd_barrier_post((unsigned*)(p.ws + OFF_BAR), (volatile LAS unsigned*)&xb_words);
  if (ph_hi > 1000) grid.sync();
#define SYNC_IF(n) if (n > ph_lo) { xcd_barrier(xb); }
  RUN_PHASE(0) { for (int j = B; j < NJ0; j += G) phase0(p, j, smem); }
  RUN_PHASE(1) { SYNC_IF(1) for (int j = B; j < NJ1; j += G) phase1(p, j, smem); }
  RUN_PHASE(2) { SYNC_IF(2)
    for (int j = B; j < NJ2_H; j += G) p2_hgrn_pre(p, j, smem); }
  RUN_PHASE(3) { SYNC_IF(3)
    if (B < NJ3_A) p3_hgrn_seq(p, B, smem);
    else if (B < NJ3_A + NJ3_CH) p3_s5chain(p, B - NJ3_A, smem);
    else for (int j = B - (NJ3_A + NJ3_CH); j < NJ3_REST; j += G - (NJ3_A + NJ3_CH)) phase3rest(p, j, smem); }
  RUN_PHASE(4) { SYNC_IF(4)
    for (int j = B; j < NJ4; j += G) { if (j < NJ4_A) p4_onorm(p, j); else p4_glu(p, j - NJ4_A, smem); } }
  RUN_PHASE(5) { SYNC_IF(5) for (int j = B; j < NJ5; j += G) phase5(p, j, smem); }
  RUN_PHASE(6) { SYNC_IF(6) for (int j = B; j < NJ6; j += G) phase6(p, j, smem);
    { const int extra = NJ6 % G;
      if (B >= extra) for (int j = B - extra; j < 8192; j += G - extra) convert_tables(p, j); } }
  RUN_PHASE(7) { SYNC_IF(7) for (int j = B; j < NJ7; j += G) phase7(p, j); }
  RUN_PHASE(8) { SYNC_IF(8) for (int j = B; j < NJ8; j += G) phase8(p, j, smem); }
  RUN_PHASE(9) { SYNC_IF(9) for (int j = B; j < NJ9; j += G) phase9(p, j); }
  RUN_PHASE(10) { SYNC_IF(10) for (int j = B; j < NJ10; j += G) phase10(p, j); }
}

extern "C" void kernel_launch(void* const* d_in, const int* in_sizes, int n_in, void* d_out, int out_size, void* d_ws,
                              size_t ws_size, hipStream_t stream) {
  static int grid_blocks = 0;
  if (!grid_blocks) {
    int dev = 0, cus = 0, per_cu = 0;
    hipGetDevice(&dev);
    hipDeviceGetAttribute(&cus, hipDeviceAttributeMultiprocessorCount, dev);
    hipOccupancyMaxActiveBlocksPerMultiprocessor(&per_cu, mega, 256, 0);
    if (per_cu < 1) per_cu = 1;
    grid_blocks = cus * per_cu;
  }
  P p{};
  const float** pf = (const float**)&p;
  for (int i = 0; i < 30; ++i) pf[i] = (const float*)d_in[i];
  p.out = (float*)d_out;
  p.ws = (char*)d_ws;
#if SINGLE_LAUNCH
  hipMemsetAsync((char*)d_ws + OFF_BAR, 0, XCD_BAR_WORDS * sizeof(unsigned), stream);
  int lo = 0, hi = 11;
  void* args[] = {&p, &lo, &hi};
  hipError_t e = hipLaunchCooperativeKernel((void*)mega, dim3(grid_blocks), dim3(256), args, 0, stream);
  if (e != hipSuccess) fprintf(stderr, "cooperative launch failed: %s (grid %d)\n", hipGetErrorString(e), grid_blocks);
#else
  for (int ph = 0; ph < 11; ++ph) hipLaunchKernelGGL(mega, dim3(grid_blocks), dim3(256), 0, stream, p, ph, ph + 1);
#endif
}
```

```cpp
#include <hip/hip_runtime.h>
#include <hip/hip_cooperative_groups.h>
#include <cstdio>
namespace cg = cooperative_groups;

#define DI __device__ __forceinline__
typedef unsigned short u16;
typedef short s16x4 __attribute__((ext_vector_type(4)));
typedef short s16x8 __attribute__((ext_vector_type(8)));
typedef float f32x4 __attribute__((ext_vector_type(4)));
typedef __bf16 bf16x2_t __attribute__((ext_vector_type(2)));
typedef float f32x2_t __attribute__((ext_vector_type(2)));

#ifndef SINGLE_LAUNCH
#define SINGLE_LAUNCH 1
#endif

constexpr int T = 17024, TP = 16512, LP = 2064, NCHK = 129;
constexpr float EPS = 1e-6f;
#ifndef ONLY
#define ONLY -1
#endif
constexpr size_t UNIT = (size_t)T * 1024 * 2;
constexpr size_t OFF_WTIN = 0;
constexpr size_t OFF_WTGLU = OFF_WTIN + (size_t)7168 * 1024 * 2;
constexpr size_t OFF_WTA = OFF_WTGLU + 2097152;
constexpr size_t OFF_WTB = OFF_WTA + 2097152;
constexpr size_t OFF_WTOUT = OFF_WTB + 2097152;
constexpr size_t OFF_WTQ = OFF_WTOUT + 2097152;
constexpr size_t OFF_K1 = OFF_WTQ + 4194304;
constexpr size_t OFF_K2 = OFF_K1 + 262144;
constexpr size_t OFF_LB = OFF_K2 + 262144;
constexpr size_t OFF_ABAR = OFF_LB + 4096;
constexpr size_t OFF_APOW = OFF_ABAR + 32768;
constexpr size_t OFF_BBAR = OFF_APOW + 32768;
constexpr size_t OFF_UNITS = OFF_BBAR + 524288;
constexpr size_t OFF_BAR = OFF_UNITS + 8 * ((size_t)17024 * 1024 * 2);
constexpr size_t OFF_UT8 = OFF_BAR + 65536;
constexpr size_t OOFF_KTT = 0;
constexpr size_t OOFF_DEC = UNIT;
constexpr size_t OOFF_E = OOFF_DEC + (size_t)1032 * 1024 * 4;
constexpr size_t O_YP = 0, O_YS = 16777216, O_HGP = 17301504, O_SRP = 18350080, O_SIP = 18382848,
                 O_HGS = 18415616, O_SRS = 35192832, O_SIS = 35717120;
constexpr int SMEM_BYTES = 65536;

struct P {
  const float *x_prompt, *x_sample, *state_hgrn, *ssm_re, *ssm_im, *meta, *lower_bounds, *norm1_w, *w_in, *g_norm_w,
      *a_re, *a_im, *log_step, *b_re, *b_im, *c_re, *c_im, *ssm_d, *w_glu, *b_glu, *w_a, *w_b, *w_out, *norm2_w,
      *peer_wq, *k1, *k2, *peer_u, *peer_v, *final_w;
  float* out;
  char* ws;
};

DI unsigned pack2(float a, float b) {
  f32x2_t v = {a, b};
  bf16x2_t r = __builtin_convertvector(v, bf16x2_t);
  return __builtin_bit_cast(unsigned, r);
}
DI u16 f2bf(float a) { return (u16)(pack2(a, 0.f) & 0xffffu); }
DI float bf2f(u16 v) { return __uint_as_float(((unsigned)v) << 16); }
DI float bflo(unsigned v) { return __uint_as_float(v << 16); }
DI float bfhi(unsigned v) { return __uint_as_float(v & 0xffff0000u); }
DI f32x4 mfma32(s16x8 a, s16x8 b, f32x4 c) { return __builtin_amdgcn_mfma_f32_16x16x32_bf16(a, b, c, 0, 0, 0); }
DI f32x4 mfma16(s16x4 a, s16x4 b, f32x4 c) { return __builtin_amdgcn_mfma_f32_16x16x16bf16_1k(a, b, c, 0, 0, 0); }
DI float wave_sum(float v) {
#pragma unroll
  for (int o = 32; o >= 1; o >>= 1) v += __shfl_xor(v, o);
  return v;
}
DI float sigmoidf_(float x) { return 1.f / (1.f + __expf(-x)); }
DI float siluf_(float x) { return x / (1.f + __expf(-x)); }
DI float geluf_(float x) { return 0.5f * x * (1.f + erff(x * 0.70710678118654752f)); }
DI s16x4 pack4(f32x4 v) {
  unsigned a = pack2(v[0], v[1]), b = pack2(v[2], v[3]);
  uint2 u = make_uint2(a, b);
  return __builtin_bit_cast(s16x4, u);
}
DI s16x8 pack8(f32x4 x, f32x4 y) {
  uint4 u = make_uint4(pack2(x[0], x[1]), pack2(x[2], x[3]), pack2(y[0], y[1]), pack2(y[2], y[3]));
  return __builtin_bit_cast(s16x8, u);
}
DI u16* unitp(const P& p, int i) { return (u16*)(p.ws + OFF_UNITS + (size_t)i * UNIT); }
DI const float* xrow(const P& p, int tk) {
  if (tk < TP) {
    int n = tk / LP, l = tk - n * LP;
    return l < 16 ? p.meta + (size_t)l * 1024 : p.x_prompt + ((size_t)n * 2048 + (l - 16)) * 1024;
  }
  return p.x_sample + (size_t)(tk - TP) * 1024;
}

DI void gemm_core(const u16* __restrict__ A, int lda, const u16* __restrict__ Bt, int ldb, int K, int brow, int bcol,
                  char* smem, f32x4 (&acc)[4][4]) {
  const int tid = threadIdx.x, wave = tid >> 6, lane = tid & 63, wr = wave >> 1, wc = wave & 1, fr = lane & 15,
            fq = lane >> 4;
  const int r0 = tid >> 3, cj = tid & 7;
  const u16* ga = A + (size_t)(brow + r0) * lda + cj * 8;
  const u16* gb = Bt + (size_t)(bcol + r0) * ldb + cj * 8;
  const size_t sa = (size_t)32 * lda, sb = (size_t)32 * ldb;
  const int woff = r0 * 128 + ((cj ^ ((r0 >> 1) & 7)) << 4);
  uint4 xa0, xa1, xa2, xa3, xb0, xb1, xb2, xb3, ya0, ya1, ya2, ya3, yb0, yb1, yb2, yb3;
#define G_LOAD(S, kk)                                                                          \
  {                                                                                            \
    S##a0 = *(const uint4*)(ga + (kk) * 64);          S##b0 = *(const uint4*)(gb + (kk) * 64);            \
    S##a1 = *(const uint4*)(ga + sa + (kk) * 64);     S##b1 = *(const uint4*)(gb + sb + (kk) * 64);       \
    S##a2 = *(const uint4*)(ga + 2 * sa + (kk) * 64); S##b2 = *(const uint4*)(gb + 2 * sb + (kk) * 64);   \
    S##a3 = *(const uint4*)(ga + 3 * sa + (kk) * 64); S##b3 = *(const uint4*)(gb + 3 * sb + (kk) * 64);   \
  }
#define G_STORE(S, st)                                                                         \
  {                                                                                            \
    char* sp_ = smem + (st) * 32768 + woff;                                                    \
    *(uint4*)(sp_) = S##a0;         *(uint4*)(sp_ + 16384) = S##b0;                            \
    *(uint4*)(sp_ + 4096) = S##a1;  *(uint4*)(sp_ + 16384 + 4096) = S##b1;                     \
    *(uint4*)(sp_ + 8192) = S##a2;  *(uint4*)(sp_ + 16384 + 8192) = S##b2;                     \
    *(uint4*)(sp_ + 12288) = S##a3; *(uint4*)(sp_ + 16384 + 12288) = S##b3;                    \
  }
  const int arow = wr * 64 + fr, brow_l = wc * 64 + fr;
  const int sw = (fr >> 1) & 7;
  const int nk = K >> 6;
#define G_COMPUTE(st)                                                                          \
  {                                                                                            \
    const char* a = smem + (st) * 32768;                                                       \
    const char* b = a + 16384;                                                                 \
    _Pragma("unroll") for (int ks = 0; ks < 2; ++ks) {                                         \
      s16x8 af[4], bfr[4];                                                                     \
      const int co = (((ks * 4 + fq) ^ sw) << 4);                                              \
      _Pragma("unroll") for (int m = 0; m < 4; ++m) af[m] = *(const s16x8*)(a + (arow + m * 16) * 128 + co);     \
      _Pragma("unroll") for (int n = 0; n < 4; ++n) bfr[n] = *(const s16x8*)(b + (brow_l + n * 16) * 128 + co);  \
      _Pragma("unroll") for (int m = 0; m < 4; ++m)                                            \
      _Pragma("unroll") for (int n = 0; n < 4; ++n) acc[m][n] = mfma32(af[m], bfr[n], acc[m][n]);                \
    }                                                                                          \
  }
  G_LOAD(x, 0)
  G_STORE(x, 0)
  G_LOAD(y, 1)
  __syncthreads();
  for (int kt = 0; kt < nk; kt += 2) {
    if (kt + 2 < nk) G_LOAD(x, kt + 2)
    G_COMPUTE(0)
    G_STORE(y, 1)
    __syncthreads();
    if (kt + 3 < nk) G_LOAD(y, kt + 3)
    G_COMPUTE(1)
    if (kt + 2 < nk) G_STORE(x, 0)
    __syncthreads();
  }
#undef G_LOAD
#undef G_STORE
#undef G_COMPUTE
  asm volatile("s_nop 15\n\ts_nop 15" : "+v"(acc[0][0]), "+v"(acc[0][1]), "+v"(acc[0][2]), "+v"(acc[0][3]), "+v"(acc[1][0]), "+v"(acc[1][1]), "+v"(acc[1][2]), "+v"(acc[1][3]), "+v"(acc[2][0]), "+v"(acc[2][1]), "+v"(acc[2][2]), "+v"(acc[2][3]), "+v"(acc[3][0]), "+v"(acc[3][1]), "+v"(acc[3][2]), "+v"(acc[3][3]));
}
#define ZERO_ACC(acc)                              \
  _Pragma("unroll") for (int m = 0; m < 4; ++m)    \
  _Pragma("unroll") for (int n = 0; n < 4; ++n) acc[m][n] = f32x4{0.f, 0.f, 0.f, 0.f};
#define EPI_VARS                                                                                             \
  const int tid = threadIdx.x, wave = tid >> 6, lane = tid & 63, wr = wave >> 1, wc = wave & 1, fr = lane & 15, \
            fq = lane >> 4;
#define EPI_BASE(ld, rb, cbv)                                    \
  int tb_ = (wr * 64 + fq * 4) * (ld) + wc * 64 + fr;           \
  asm volatile("" : "+v"(tb_));                                 \
  const int idx0 = (rb) * (ld) + (cbv) + tb_;
#define EPI_LOOP                                 \
  _Pragma("unroll") for (int m = 0; m < 4; ++m)  \
  _Pragma("unroll") for (int n = 0; n < 4; ++n)

DI void p0_transpose(const float* __restrict__ W, int K, int N, u16* __restrict__ Wt, int tile, char* smem) {
  float* sm = (float*)smem;
  const int ntn = N >> 6;
  const int tk = tile / ntn, tn = tile - tk * ntn;
  const int tid = threadIdx.x;
  const int c = tid & 63, r0 = tid >> 6;
#pragma unroll
  for (int i = 0; i < 16; ++i) {
    int r = r0 + i * 4;
    sm[r * 65 + c] = W[(size_t)(tk * 64 + r) * N + tn * 64 + c];
  }
  __syncthreads();
  const int n = tid >> 2, ks = (tid & 3) * 16;
  unsigned o[8];
#pragma unroll
  for (int i = 0; i < 8; ++i) o[i] = pack2(sm[(ks + 2 * i) * 65 + n], sm[(ks + 2 * i + 1) * 65 + n]);
  uint4* dst = (uint4*)(Wt + (size_t)(tn * 64 + n) * K + tk * 64 + ks);
  dst[0] = make_uint4(o[0], o[1], o[2], o[3]);
  dst[1] = make_uint4(o[4], o[5], o[6], o[7]);
  __syncthreads();
}

DI void p0_convert(const float* __restrict__ src, u16* __restrict__ dst, int job) {
  size_t i = (size_t)job * 2048 + threadIdx.x * 8;
  float4 a = *(const float4*)(src + i), b = *(const float4*)(src + i + 4);
  *(uint4*)(dst + i) = make_uint4(pack2(a.x, a.y), pack2(a.z, a.w), pack2(b.x, b.y), pack2(b.z, b.w));
}

DI void p0_lb(const P& p) {
  float* LB = (float*)(p.ws + OFF_LB);
  for (int c = threadIdx.x; c < 1024; c += 256) {
    float a = p.lower_bounds[c], b = p.lower_bounds[1024 + c];
    LB[c] = 1.f / (1.f + expf(b - a));
  }
}

DI void p0_s5const(const P& p, int job) {
  int idx = job * 256 + threadIdx.x;
  int g = idx >> 6;
  float re = fminf(p.a_re[idx], -1e-4f), im = p.a_im[idx];
  float dl = expf(p.log_step[g]);
  float mag = expf(re * dl);
  float sn, cs;
  sincosf(im * dl, &sn, &cs);
  float ax = mag * cs, ay = mag * sn;
  float nx = ax - 1.f, ny = ay;
  float d2 = re * re + im * im;
  float cr = (nx * re + ny * im) / d2, ci = (ny * re - nx * im) / d2;
  float2* ABAR = (float2*)(p.ws + OFF_ABAR);
  float2* APOW = (float2*)(p.ws + OFF_APOW);
  float2* BBAR = (float2*)(p.ws + OFF_BBAR);
  ABAR[idx] = make_float2(ax, ay);
  float x = ax, y = ay, x16 = 0.f, y16 = 0.f;
#pragma unroll
  for (int i = 0; i < 5; ++i) {
    float nx2 = x * x - y * y, ny2 = 2.f * x * y;
    x = nx2; y = ny2;
    if (i == 3) { x16 = x; y16 = y; }
  }
  APOW[idx] = make_float2(x * x16 - y * y16, x * y16 + y * x16);
#pragma unroll
  for (int c = 0; c < 16; ++c) {
    float br = p.b_re[idx * 16 + c], bi = p.b_im[idx * 16 + c];
    BBAR[idx * 16 + c] = make_float2(cr * br - ci * bi, cr * bi + ci * br);
  }
}

DI void rms_row_to_bf16(const float* __restrict__ src, const float* __restrict__ w, u16* __restrict__ dst, int lane) {
  float4 v[4];
  float ss = 0.f;
#pragma unroll
  for (int i = 0; i < 4; ++i) {
    v[i] = *(const float4*)(src + i * 256 + lane * 4);
    ss += v[i].x * v[i].x + v[i].y * v[i].y + v[i].z * v[i].z + v[i].w * v[i].w;
  }
  ss = wave_sum(ss);
  float rs = rsqrtf(ss * (1.f / 1024.f) + EPS);
#pragma unroll
  for (int i = 0; i < 4; ++i) {
    float4 ww = *(const float4*)(w + i * 256 + lane * 4);
    uint2 o = make_uint2(pack2(v[i].x * rs * ww.x, v[i].y * rs * ww.y), pack2(v[i].z * rs * ww.z, v[i].w * rs * ww.w));
    *(uint2*)(dst + i * 256 + lane * 4) = o;
  }
}

DI void phase0(const P& p, int job, char* smem) {
  if (job < 1792) p0_transpose(p.w_in, 1024, 7168, (u16*)(p.ws + OFF_WTIN), job, smem);
  else if (job < 2048) p0_transpose(p.w_glu, 1024, 1024, (u16*)(p.ws + OFF_WTGLU), job - 1792, smem);
  else if (job < 2304) p0_transpose(p.w_a, 1024, 1024, (u16*)(p.ws + OFF_WTA), job - 2048, smem);
  else if (job < 2560) p0_transpose(p.w_b, 1024, 1024, (u16*)(p.ws + OFF_WTB), job - 2304, smem);
  else if (job < 2816) p0_transpose(p.w_out, 1024, 1024, (u16*)(p.ws + OFF_WTOUT), job - 2560, smem);
  else if (job < 3328) p0_transpose(p.peer_wq, 1024, 2048, (u16*)(p.ws + OFF_WTQ), job - 2816, smem);
  else if (job < 3392) p0_convert(p.k1, (u16*)(p.ws + OFF_K1), job - 3328);
  else if (job < 3456) p0_convert(p.k2, (u16*)(p.ws + OFF_K2), job - 3392);
  else if (job == 3456) p0_lb(p);
  else if (job < 3473) p0_s5const(p, job - 3457);
  else {
    int tk = (job - 3473) * 4 + (threadIdx.x >> 6);
    rms_row_to_bf16(xrow(p, tk), p.norm1_w, unitp(p, 0) + (size_t)tk * 1024, threadIdx.x & 63);
  }
}
constexpr int NJ0 = 3473 + T / 4;

DI void phase1(const P& p, int job, char* smem) {
  const int pm = job / 56, pn = job - pm * 56;
  const int brow = pm * 128, bcol = pn * 128;
  f32x4 acc[4][4];
  ZERO_ACC(acc);
  gemm_core(unitp(p, 0), 1024, (const u16*)(p.ws + OFF_WTIN), 1024, 1024, brow, bcol, smem, acc);
  EPI_VARS;
  const int region = pn >> 3;
  const int cbase = bcol - region * 1024;
  if (region == 2) {
    u16* VT = unitp(p, 3);
    int vb = ((brow >> 4) + wr * 4) * 16384 + (cbase + wc * 64 + fr) * 16 + fq * 4;
    asm volatile("" : "+v"(vb));
    EPI_LOOP { *(s16x4*)(VT + vb + m * 16384 + n * 256) = pack4(acc[m][n]); }
  } else {
    u16* dst = unitp(p, region == 0 ? 1 : region == 1 ? 2 : region + 1);
    EPI_BASE(1024, brow, cbase);
    EPI_LOOP {
#pragma unroll
      for (int j = 0; j < 4; ++j) {
        float v = acc[m][n][j];
        if (region == 0 || region == 3) v = siluf_(v);
        else if (region >= 5) v = sigmoidf_(v);
        dst[idx0 + (m * 16 + j) * 1024 + n * 16] = f2bf(v);
      }
    }
  }
}
constexpr int NJ1 = 133 * 56;

DI void p2_hgrn_pre(const P& p, int job, char* smem) {
  const int tid = threadIdx.x, wave = tid >> 6, lane = tid & 63, fr = lane & 15, fq = lane >> 4;
  const int chunk = job >> 1, h = (job & 1) * 4 + wave;
  const int tok0 = chunk * 16;
  u16* R1 = unitp(p, 1);
  const u16* R2 = unitp(p, 2);
  const u16* VT = unitp(p, 3);
  u16* OIN = unitp(p, 0);
  u16* KTT = (u16*)((char*)p.out + OOFF_KTT);
  float* DEC = (float*)((char*)p.out + OOFF_DEC);
  const float* LB = (const float*)(p.ws + OFF_LB);
  char* sq = smem + wave * 8704;
  char* sk = sq + 4352;
  const int c0 = h * 128 + lane * 2;
  const float lb0 = LB[c0], lb1 = LB[c0 + 1];
  float b0 = 0.f, b1 = 0.f;
  float kn0[16], kn1[16];
#pragma unroll
  for (int t = 0; t < 16; ++t) {
    size_t gi = (size_t)(tok0 + t) * 1024 + c0;
    unsigned q2 = *(const unsigned*)(R1 + gi), f2 = *(const unsigned*)(R2 + gi);
    float f0 = bflo(f2), f1 = bfhi(f2);
    float e0 = __expf(-f0), e1 = __expf(-f1);
    float fg0 = lb0 + (1.f - lb0) / (1.f + e0), fg1 = lb1 + (1.f - lb1) / (1.f + e1);
    float k0 = (1.f - lb0) * e0 / (1.f + e0), k1 = (1.f - lb1) * e1 / (1.f + e1);
    b0 += __logf(fg0);
    b1 += __logf(fg1);
    float qt0 = bflo(q2) * __expf(b0), qt1 = bfhi(q2) * __expf(b1);
    kn0[t] = k0 * __expf(-b0);
    kn1[t] = k1 * __expf(-b1);
    unsigned qp = pack2(qt0, qt1);
    *(unsigned*)(R1 + gi) = qp;
    *(unsigned*)(sq + t * 272 + lane * 4) = qp;
    *(unsigned*)(sk + t * 272 + lane * 4) = pack2(kn0[t], kn1[t]);
  }
  const float eb0 = __expf(b0), eb1 = __expf(b1);
  *(float2*)(DEC + (size_t)chunk * 1024 + c0) = make_float2(eb0, eb1);
  {
    unsigned w0[8], w1[8];
#pragma unroll
    for (int i = 0; i < 8; ++i) {
      w0[i] = pack2(kn0[2 * i] * eb0, kn0[2 * i + 1] * eb0);
      w1[i] = pack2(kn1[2 * i] * eb1, kn1[2 * i + 1] * eb1);
    }
    uint4* kd = (uint4*)(KTT + ((size_t)chunk * 1024 + c0) * 16);
    kd[0] = make_uint4(w0[0], w0[1], w0[2], w0[3]);
    kd[1] = make_uint4(w0[4], w0[5], w0[6], w0[7]);
    kd[2] = make_uint4(w1[0], w1[1], w1[2], w1[3]);
    kd[3] = make_uint4(w1[4], w1[5], w1[6], w1[7]);
  }
  __syncthreads();
  f32x4 at = {0.f, 0.f, 0.f, 0.f};
#pragma unroll
  for (int ks = 0; ks < 4; ++ks) {
    s16x8 a = *(const s16x8*)(sk + fr * 272 + ks * 64 + fq * 16);
    s16x8 b = *(const s16x8*)(sq + fr * 272 + ks * 64 + fq * 16);
    at = mfma32(a, b, at);
  }
  asm volatile("s_nop 15\n\ts_nop 15" : "+v"(at));
#pragma unroll
  for (int j = 0; j < 4; ++j)
    if (4 * fq + j > fr) at[j] = 0.f;
  s16x4 af = pack4(at);
  asm volatile("s_nop 7" : "+v"(af));
#pragma unroll
  for (int nt = 0; nt < 8; ++nt) {
    size_t vi = ((size_t)chunk * 1024 + h * 128 + nt * 16 + fr) * 16 + 4 * fq;
    s16x4 vb = *(const s16x4*)(VT + vi);
    f32x4 o = mfma16(af, vb, f32x4{0.f, 0.f, 0.f, 0.f});
    asm volatile("s_nop 15\n\ts_nop 15" : "+v"(o));
    *(s16x4*)(OIN + vi) = pack4(o);
  }
  __syncthreads();
}

DI void s5_load_bbar(const P& p, int g, int pp, float (&br)[16], float (&bi)[16]) {
  const float4* B = (const float4*)((const float2*)(p.ws + OFF_BBAR) + ((size_t)g * 64 + pp) * 16);
#pragma unroll
  for (int i = 0; i < 8; ++i) {
    float4 v = B[i];
    br[2 * i] = v.x; bi[2 * i] = v.y; br[2 * i + 1] = v.z; bi[2 * i + 1] = v.w;
  }
}
DI void s5_step(const uint4& ua, const uint4& ub, int t, const float (&br)[16], const float (&bi)[16], float ax, float ay,
                float& xr, float& xi) {
  unsigned uu[8] = {(unsigned)__builtin_amdgcn_readlane((int)ua.x, t), (unsigned)__builtin_amdgcn_readlane((int)ua.y, t),
                    (unsigned)__builtin_amdgcn_readlane((int)ua.z, t), (unsigned)__builtin_amdgcn_readlane((int)ua.w, t),
                    (unsigned)__builtin_amdgcn_readlane((int)ub.x, t), (unsigned)__builtin_amdgcn_readlane((int)ub.y, t),
                    (unsigned)__builtin_amdgcn_readlane((int)ub.z, t), (unsigned)__builtin_amdgcn_readlane((int)ub.w, t)};
  float sr = 0.f, si = 0.f;
#pragma unroll
  for (int i = 0; i < 8; ++i) {
    float a = bflo(uu[i]), b = bfhi(uu[i]);
    sr += br[2 * i] * a + br[2 * i + 1] * b;
    si += bi[2 * i] * a + bi[2 * i + 1] * b;
  }
  float nr = ax * xr - ay * xi + sr, ni = ax * xi + ay * xr + si;
  xr = nr; xi = ni;
}

DI void p2_s5a(const P& p, int job) {
  const int gq = job & 15, nc = job >> 4;
  const int n = nc / 43, c = nc - n * 43;
  const int tid = threadIdx.x, g = gq * 4 + (tid >> 6), pp = tid & 63;
  float br[16], bi[16];
  s5_load_bbar(p, g, pp, br, bi);
  const float2 ab = ((const float2*)(p.ws + OFF_ABAR))[g * 64 + pp];
  const u16* U = unitp(p, 5) + (size_t)(n * LP + c * 48) * 1024 + g * 16;
  float xr = 0.f, xi = 0.f;
  uint4 ua, ub;
  {
    const u16* r = U + (size_t)min(pp, 47) * 1024;
    ua = *(const uint4*)r;
    ub = *(const uint4*)(r + 8);
  }
#pragma unroll 4
  for (int t = 0; t < 48; ++t) s5_step(ua, ub, t, br, bi, ab.x, ab.y, xr, xi);
  float2* E = (float2*)((char*)p.out + OOFF_E);
  E[((size_t)(n * 43 + c) * 64 + g) * 64 + pp] = make_float2(xr, xi);
}
constexpr int NJ2_H = 2064, NJ2_S = 8 * 43 * 16;
constexpr int NJ2 = NJ2_H + NJ2_S;

#define SEQ_GLOAD(cg_, P)                                                                              \
  {                                                                                                    \
    const int cgv = (cg_);                                                                             \
    P##rq = *(const uint4*)(QT + (size_t)(cgv * 16 + (tid >> 4)) * 1024 + h * 128 + (tid & 15) * 8);  \
    P##rk = *(const uint4*)(KTT + ((size_t)cgv * 1024 + h * 128) * 16 + tid * 8);                      \
    if (tid < 32) P##rd = *(const float4*)(DEC + (size_t)cgv * 1024 + h * 128 + tid * 4);              \
    size_t vi0 = ((size_t)cgv * 1024 + h * 128 + wave * 32 + fr) * 16 + 4 * fq;                        \
    P##rv0 = *(const s16x4*)(VT + vi0);                                                                \
    P##rv1 = *(const s16x4*)(VT + vi0 + 256);                                                          \
    P##ro0 = *(const s16x4*)(OIN + vi0);                                                               \
    P##ro1 = *(const s16x4*)(OIN + vi0 + 256);                                                         \
  }
#define SEQ_LSTORE(b_, P)                                                  \
  {                                                                        \
    char* lb_ = smem + (b_) * 8960;                                        \
    *(uint4*)(lb_ + (tid >> 4) * 272 + (tid & 15) * 16) = P##rq;           \
    *(uint4*)(lb_ + 4352 + tid * 16) = P##rk;                              \
    if (tid < 32) *(float4*)(lb_ + 8448 + tid * 16) = P##rd;               \
  }
#define SEQ_BODY(c_, X, Y)                                                                                   \
  {                                                                                                          \
    const int c = (c_);                                                                                      \
    const int b = c & 1;                                                                                     \
    const int tok0 = (cg0 + c) * 16;                                                                         \
    if (c + 2 < NCHK) SEQ_GLOAD(cg0 + c + 2, X)                                                              \
    const char* base = smem + b * 8960;                                                                      \
    f32x4 o0 = f32x4{0.f, 0.f, 0.f, 0.f}, o1 = f32x4{0.f, 0.f, 0.f, 0.f};                                    \
    _Pragma("unroll") for (int ks = 0; ks < 4; ++ks) {                                                       \
      s16x4 qa = *(const s16x4*)(base + fr * 272 + (ks * 32 + 4 * fq) * 2);                                  \
      s16x4 qb = *(const s16x4*)(base + fr * 272 + (ks * 32 + 16 + 4 * fq) * 2);                             \
      s16x8 Af = __builtin_shufflevector(qa, qb, 0, 1, 2, 3, 4, 5, 6, 7);                                    \
      s16x8 B0 = pack8(S[2 * ks][0], S[2 * ks + 1][0]), B1 = pack8(S[2 * ks][1], S[2 * ks + 1][1]);          \
      asm volatile("s_nop 7" : "+v"(B0), "+v"(B1), "+v"(Af));                                                \
      o0 = mfma32(Af, B0, o0);                                                                               \
      o1 = mfma32(Af, B1, o1);                                                                               \
    }                                                                                                        \
    asm volatile("s_nop 15\n\ts_nop 15" : "+v"(o0), "+v"(o1));                                               \
    _Pragma("unroll") for (int j = 0; j < 4; ++j) {                                                          \
      u16* orow = ORAW + (size_t)(tok0 + 4 * fq + j) * 1024 + h * 128 + wave * 32 + fr;                      \
      orow[0] = f2bf(o0[j] + bf2f((u16)co0[j]));                                                             \
      orow[16] = f2bf(o1[j] + bf2f((u16)co1[j]));                                                            \
    }                                                                                                        \
    _Pragma("unroll") for (int mt = 0; mt < 8; ++mt) {                                                       \
      f32x4 d = *(const f32x4*)(base + 8448 + (mt * 16 + 4 * fq) * 4);                                       \
      s16x4 ka = *(const s16x4*)(base + 4352 + (mt * 16 + fr) * 32 + fq * 8);                                \
      f32x4 s0 = S[mt][0] * d, s1 = S[mt][1] * d;                                                            \
      asm volatile("s_nop 7" : "+v"(s0), "+v"(s1), "+v"(ka));                                                \
      S[mt][0] = mfma16(ka, cv0, s0);                                                                        \
      S[mt][1] = mfma16(ka, cv1, s1);                                                                        \
    }                                                                                                        \
    asm volatile("s_nop 15\n\ts_nop 15" : "+v"(S[0][0]), "+v"(S[0][1]), "+v"(S[1][0]), "+v"(S[1][1]), "+v"(S[2][0]), "+v"(S[2][1]), "+v"(S[3][0]), "+v"(S[3][1]), "+v"(S[4][0]), "+v"(S[4][1]), "+v"(S[5][0]), "+v"(S[5][1]), "+v"(S[6][0]), "+v"(S[6][1]), "+v"(S[7][0]), "+v"(S[7][1])); \
    if (c + 1 < NCHK) SEQ_LSTORE(b ^ 1, Y)                                                                   \
    asm volatile("s_waitcnt lgkmcnt(0)\n\ts_barrier" ::: "memory");                                         \
    if (c + 1 < NCHK) { cv0 = Y##rv0; cv1 = Y##rv1; co0 = Y##ro0; co1 = Y##ro1; }                            \
  }
DI void p3_hgrn_seq(const P& p, int job, char* smem) {
  const int tid = threadIdx.x, wave = tid >> 6, lane = tid & 63, fr = lane & 15, fq = lane >> 4;
  const int n = job >> 3, h = job & 7;
  const u16* QT = unitp(p, 1);
  const u16* KTT = (const u16*)((const char*)p.out + OOFF_KTT);
  const float* DEC = (const float*)((const char*)p.out + OOFF_DEC);
  const u16* VT = unitp(p, 3);
  const u16* OIN = unitp(p, 0);
  u16* ORAW = unitp(p, 2);
  f32x4 S[8][2];
#pragma unroll
  for (int mt = 0; mt < 8; ++mt) { S[mt][0] = f32x4{0.f, 0.f, 0.f, 0.f}; S[mt][1] = f32x4{0.f, 0.f, 0.f, 0.f}; }
  const int cg0 = n * NCHK;
  uint4 Arq, Ark, Brq, Brk;
  float4 Ard = make_float4(0.f, 0.f, 0.f, 0.f), Brd = make_float4(0.f, 0.f, 0.f, 0.f);
  s16x4 Arv0, Arv1, Aro0, Aro1, Brv0, Brv1, Bro0, Bro1, cv0, cv1, co0, co1;
  SEQ_GLOAD(cg0, A)
  SEQ_LSTORE(0, A)
  cv0 = Arv0; cv1 = Arv1; co0 = Aro0; co1 = Aro1;
  SEQ_GLOAD(cg0 + 1, B)
  __syncthreads();
  for (int cc = 0; cc < NCHK - 1; cc += 2) {
    SEQ_BODY(cc, A, B)
    SEQ_BODY(cc + 1, B, A)
  }
  SEQ_BODY(NCHK - 1, A, B)
  float* HG = p.out + O_HGP + ((size_t)(n * 8 + h) * 128) * 128;
#pragma unroll
  for (int mt = 0; mt < 8; ++mt)
#pragma unroll
    for (int nt = 0; nt < 2; ++nt)
#pragma unroll
      for (int j = 0; j < 4; ++j) HG[(size_t)(mt * 16 + 4 * fq + j) * 128 + wave * 32 + nt * 16 + fr] = S[mt][nt][j];
}

DI void p3_hgrn_sample(const P& p, int job, char* smem) {
  const int tid = threadIdx.x;
  const int ns = job >> 3, h = job & 7;
  const int v = tid & 127, kh = tid >> 7;
  const u16* R1 = unitp(p, 1);
  const u16* R2 = unitp(p, 2 + 0);
  const u16* VT = unitp(p, 3);
  u16* ORAW = unitp(p, 2);
  const float* LB = (const float*)(p.ws + OFF_LB);
  float* sg = (float*)smem;
  float* skk = sg + 512;
  float* sq = skk + 512;
  float* so = sq + 512;
  const int tokb = TP + ns * 4;
  float fraw[4];
  if (tid < 128) {
    const float lb = LB[h * 128 + tid];
#pragma unroll
    for (int t = 0; t < 4; ++t) {
      size_t gi = (size_t)(tokb + t) * 1024 + h * 128 + tid;
      float f = bf2f(R2[gi]);
      fraw[t] = f;
      float e = __expf(-f);
      sg[t * 128 + tid] = lb + (1.f - lb) / (1.f + e);
      skk[t * 128 + tid] = (1.f - lb) * e / (1.f + e);
      sq[t * 128 + tid] = bf2f(R1[gi]);
    }
  }
  (void)fraw;
  float S[64];
  const float* st = p.state_hgrn + ((size_t)(ns * 8 + h) * 128 + kh * 64) * 128 + v;
#pragma unroll
  for (int i = 0; i < 64; ++i) S[i] = st[(size_t)i * 128];
  float vt[4];
#pragma unroll
  for (int t = 0; t < 4; ++t) {
    int tok = tokb + t;
    vt[t] = bf2f(VT[((size_t)(tok >> 4) * 1024 + h * 128 + v) * 16 + (tok & 15)]);
  }
  __syncthreads();
#pragma unroll
  for (int t = 0; t < 4; ++t) {
    float op = 0.f;
#pragma unroll
    for (int i = 0; i < 64; ++i) {
      int k = t * 128 + kh * 64 + i;
      S[i] = sg[k] * S[i] + skk[k] * vt[t];
      op += sq[k] * S[i];
    }
    so[(t * 2 + kh) * 128 + v] = op;
  }
  float* HG = p.out + O_HGS + ((size_t)(ns * 8 + h) * 128 + kh * 64) * 128 + v;
#pragma unroll
  for (int i = 0; i < 64; ++i) HG[(size_t)i * 128] = S[i];
  __syncthreads();
  if (tid < 128) {
#pragma unroll
    for (int t = 0; t < 4; ++t)
      ORAW[(size_t)(tokb + t) * 1024 + h * 128 + tid] = f2bf(so[(t * 2) * 128 + tid] + so[(t * 2 + 1) * 128 + tid]);
  }
  __syncthreads();
}

DI void p3_s5c(const P& p, int mode, int seq, int c, int gq, char* smem) {
  const int tid = threadIdx.x, wave = tid >> 6, lane = tid & 63, fr = lane & 15, fq = lane >> 4;
  const int g = gq * 4 + wave, pp = lane;
  float br[16], bi[16];
  s5_load_bbar(p, g, pp, br, bi);
  const float2 ab = ((const float2*)(p.ws + OFF_ABAR))[g * 64 + pp];
  float xr, xi;
  int tok0, ntok;
  if (mode == 0) {
    const float2 ap = ((const float2*)(p.ws + OFF_APOW))[g * 64 + pp];
    const float2* E = (const float2*)((const char*)p.out + OOFF_E) + ((size_t)(seq * 43) * 64 + g) * 64 + pp;
    xr = 0.f; xi = 0.f;
    for (int j0 = 0; j0 < c; j0 += 8) {
      float2 e[8];
#pragma unroll
      for (int i = 0; i < 8; ++i) e[i] = E[(size_t)min(j0 + i, c - 1) * 4096];
#pragma unroll
      for (int i = 0; i < 8; ++i)
        if (j0 + i < c) {
          float nr = ap.x * xr - ap.y * xi + e[i].x, ni = ap.x * xi + ap.y * xr + e[i].y;
          xr = nr; xi = ni;
        }
    }
    tok0 = seq * LP + c * 48;
    ntok = 48;
  } else {
    xr = p.ssm_re[((size_t)seq * 64 + g) * 64 + pp];
    xi = p.ssm_im[((size_t)seq * 64 + g) * 64 + pp];
    tok0 = TP + seq * 4;
    ntok = 4;
  }
  s16x8 cf[4];
#pragma unroll
  for (int ks = 0; ks < 4; ++ks) {
    int p0 = ks * 32 + fq * 8;
    const float* src = (p0 < 64 ? p.c_re : p.c_im) + ((size_t)g * 16 + fr) * 64 + (p0 & 63);
    float sgn = p0 < 64 ? 1.f : -1.f;
    float4 a = *(const float4*)src, b = *(const float4*)(src + 4);
    uint4 u = make_uint4(pack2(sgn * a.x, sgn * a.y), pack2(sgn * a.z, sgn * a.w), pack2(sgn * b.x, sgn * b.y),
                         pack2(sgn * b.z, sgn * b.w));
    cf[ks] = __builtin_bit_cast(s16x8, u);
  }
  const float dsk = p.ssm_d[g * 16 + fr];
  u16* U = unitp(p, 5);
  char* xs = smem + wave * 4352;
  const int nsub = (ntok + 15) >> 4;
  uint4 ua, ub;
  {
    const u16* r = U + (size_t)(tok0 + min(pp, ntok - 1)) * 1024 + g * 16;
    ua = *(const uint4*)r;
    ub = *(const uint4*)(r + 8);
  }
  for (int sc = 0; sc < nsub; ++sc) {
    const int tb = tok0 + sc * 16;
    const int nt = min(16, ntok - sc * 16);
#pragma unroll 4
    for (int t = 0; t < 16; ++t) {
      if (t < nt) {
        s5_step(ua, ub, sc * 16 + t, br, bi, ab.x, ab.y, xr, xi);
        *(u16*)(xs + t * 272 + pp * 2) = f2bf(xr);
        *(u16*)(xs + t * 272 + 128 + pp * 2) = f2bf(xi);
      } else {
        *(u16*)(xs + t * 272 + pp * 2) = 0;
        *(u16*)(xs + t * 272 + 128 + pp * 2) = 0;
      }
    }
    __syncthreads();
    f32x4 y = {0.f, 0.f, 0.f, 0.f};
#pragma unroll
    for (int ks = 0; ks < 4; ++ks) {
      s16x8 a = *(const s16x8*)(xs + fr * 272 + ks * 64 + fq * 16);
      y = mfma32(a, cf[ks], y);
    }
    asm volatile("s_nop 15\n\ts_nop 15" : "+v"(y));
#pragma unroll
    for (int j = 0; j < 4; ++j) {
      int t = 4 * fq + j;
      if (t < nt) {
        size_t gi = (size_t)(tb + t) * 1024 + g * 16 + fr;
        float uu = bf2f(U[gi]);
        U[gi] = f2bf(geluf_(y[j] + dsk * uu));
      }
    }
    __syncthreads();
  }
  if (mode == 0) {
    if (c == 42) {
      p.out[O_SRP + ((size_t)seq * 64 + g) * 64 + pp] = xr;
      p.out[O_SIP + ((size_t)seq * 64 + g) * 64 + pp] = xi;
    }
  } else {
    p.out[O_SRS + ((size_t)seq * 64 + g) * 64 + pp] = xr;
    p.out[O_SIS + ((size_t)seq * 64 + g) * 64 + pp] = xi;
  }
}
DI void p3_s5chain(const P& p, int job, char* smem) {
  const int tid = threadIdx.x, wave = tid >> 6, lane = tid & 63, fr = lane & 15, fq = lane >> 4;
  const int n = job >> 4, gq = job & 15;
  const int g = gq * 4 + wave, pp = lane;
  const float2 ab = ((const float2*)(p.ws + OFF_ABAR))[g * 64 + pp];
  s16x4 bb[8];
#pragma unroll
  for (int nt = 0; nt < 8; ++nt) {
    const float4* src = (const float4*)((const float2*)(p.ws + OFF_BBAR) + ((size_t)g * 64 + (nt & 3) * 16 + fr) * 16 + 4 * fq);
    float4 v0 = src[0], v1 = src[1];
    f32x4 sel = (nt < 4) ? f32x4{v0.x, v0.z, v1.x, v1.z} : f32x4{v0.y, v0.w, v1.y, v1.w};
    bb[nt] = pack4(sel);
  }
  s16x8 cf[4];
#pragma unroll
  for (int ks = 0; ks < 4; ++ks) {
    int p0 = ks * 32 + fq * 8;
    const float* src = (p0 < 64 ? p.c_re : p.c_im) + ((size_t)g * 16 + fr) * 64 + (p0 & 63);
    float sgn = p0 < 64 ? 1.f : -1.f;
    float4 a = *(const float4*)src, b = *(const float4*)(src + 4);
    uint4 u = make_uint4(pack2(sgn * a.x, sgn * a.y), pack2(sgn * a.z, sgn * a.w), pack2(sgn * b.x, sgn * b.y),
                         pack2(sgn * b.z, sgn * b.w));
    cf[ks] = __builtin_bit_cast(s16x8, u);
  }
  const float dsk = p.ssm_d[g * 16 + fr];
  u16* U = unitp(p, 5);
  char* xs = smem + wave * 12800;
  float* bu = (float*)(xs + 4352);
  float xr = 0.f, xi = 0.f;
  const int tokb = n * LP;
  s16x4 ua[3], na[3];
  u16 us[3][4], ns[3][4];
#pragma unroll
  for (int sc = 0; sc < 3; ++sc) {
    ua[sc] = *(const s16x4*)(U + (size_t)(tokb + sc * 16 + fr) * 1024 + g * 16 + 4 * fq);
#pragma unroll
    for (int j = 0; j < 4; ++j) us[sc][j] = U[(size_t)(tokb + sc * 16 + 4 * fq + j) * 1024 + g * 16 + fr];
  }
  for (int c = 0; c < 43; ++c) {
#pragma unroll
    for (int sc = 0; sc < 3; ++sc) {
      na[sc] = ua[sc];
#pragma unroll
      for (int j = 0; j < 4; ++j) ns[sc][j] = us[sc][j];
      if (c + 1 < 43) {
        na[sc] = *(const s16x4*)(U + (size_t)(tokb + (c + 1) * 48 + sc * 16 + fr) * 1024 + g * 16 + 4 * fq);
#pragma unroll
        for (int j = 0; j < 4; ++j) ns[sc][j] = U[(size_t)(tokb + (c + 1) * 48 + sc * 16 + 4 * fq + j) * 1024 + g * 16 + fr];
      }
    }
#pragma unroll
    for (int sc = 0; sc < 3; ++sc) {
      const int tb = tokb + c * 48 + sc * 16;
      s16x4 au = ua[sc];
      asm volatile("s_nop 3" : "+v"(au));
      f32x4 r[8];
#pragma unroll
      for (int nt = 0; nt < 8; ++nt) r[nt] = mfma16(au, bb[nt], f32x4{0.f, 0.f, 0.f, 0.f});
      asm volatile("s_nop 15" : "+v"(r[0]), "+v"(r[1]), "+v"(r[2]), "+v"(r[3]), "+v"(r[4]), "+v"(r[5]), "+v"(r[6]), "+v"(r[7]));
#pragma unroll
      for (int nt = 0; nt < 8; ++nt)
#pragma unroll
        for (int j = 0; j < 4; ++j) bu[(4 * fq + j) * 132 + nt * 16 + fr] = r[nt][j];
      __builtin_amdgcn_wave_barrier();
      float bre[16], bim[16];
#pragma unroll
      for (int t = 0; t < 16; ++t) { bre[t] = bu[t * 132 + pp]; bim[t] = bu[t * 132 + 64 + pp]; }
#pragma unroll
      for (int t = 0; t < 16; ++t) {
        float nr = ab.x * xr - ab.y * xi + bre[t], ni = ab.x * xi + ab.y * xr + bim[t];
        xr = nr; xi = ni;
        *(u16*)(xs + t * 272 + pp * 2) = f2bf(xr);
        *(u16*)(xs + t * 272 + 128 + pp * 2) = f2bf(xi);
      }
      __builtin_amdgcn_wave_barrier();
      f32x4 y = {0.f, 0.f, 0.f, 0.f};
#pragma unroll
      for (int ks = 0; ks < 4; ++ks) {
        s16x8 a = *(const s16x8*)(xs + fr * 272 + ks * 64 + fq * 16);
        y = mfma32(a, cf[ks], y);
      }
      asm volatile("s_nop 15\n\ts_nop 15" : "+v"(y));
#pragma unroll
      for (int j = 0; j < 4; ++j) {
        size_t gi = (size_t)(tb + 4 * fq + j) * 1024 + g * 16 + fr;
        U[gi] = f2bf(geluf_(y[j] + dsk * bf2f(us[sc][j])));
      }
    }
#pragma unroll
    for (int sc = 0; sc < 3; ++sc) {
      ua[sc] = na[sc];
#pragma unroll
      for (int j = 0; j < 4; ++j) us[sc][j] = ns[sc][j];
    }
  }
  p.out[O_SRP + ((size_t)n * 64 + g) * 64 + pp] = xr;
  p.out[O_SIP + ((size_t)n * 64 + g) * 64 + pp] = xi;
}
constexpr int NJ3_A = 64, NJ3_CH = 128, NJ3_B = 1024, NJ3_D = 128 * 16;
constexpr int NJ3_REST = NJ3_B + NJ3_D;
DI void phase3rest(const P& p, int job, char* smem) {
  if (job < NJ3_B) p3_hgrn_sample(p, job, smem);
  else { int j = job - NJ3_B; p3_s5c(p, 1, j >> 4, 0, j & 15, smem); }
}

DI void p4_onorm(const P& p, int job) {
  const int lane = threadIdx.x & 63;
  const int tk = job * 4 + (threadIdx.x >> 6);
  u16* O = unitp(p, 2) + (size_t)tk * 1024 + lane * 16;
  const u16* SG = unitp(p, 4) + (size_t)tk * 1024 + lane * 16;
  uint4 a0 = *(const uint4*)O, a1 = *(const uint4*)(O + 8);
  uint4 g0 = *(const uint4*)SG, g1 = *(const uint4*)(SG + 8);
  unsigned ov[8] = {a0.x, a0.y, a0.z, a0.w, a1.x, a1.y, a1.z, a1.w};
  unsigned gv[8] = {g0.x, g0.y, g0.z, g0.w, g1.x, g1.y, g1.z, g1.w};
  float ss = 0.f;
#pragma unroll
  for (int i = 0; i < 8; ++i) { float a = bflo(ov[i]), b = bfhi(ov[i]); ss += a * a + b * b; }
  ss += __shfl_xor(ss, 1);
  ss += __shfl_xor(ss, 2);
  ss += __shfl_xor(ss, 4);
  const float rs = rsqrtf(ss * (1.f / 128.f) + EPS);
  const float* gw = p.g_norm_w + (lane & 7) * 16;
  unsigned r[8];
#pragma unroll
  for (int i = 0; i < 8; ++i) {
    float a = bflo(ov[i]) * rs * gw[2 * i] * bflo(gv[i]);
    float b = bfhi(ov[i]) * rs * gw[2 * i + 1] * bfhi(gv[i]);
    r[i] = pack2(a, b);
  }
  *(uint4*)O = make_uint4(r[0], r[1], r[2], r[3]);
  *(uint4*)(O + 8) = make_uint4(r[4], r[5], r[6], r[7]);
}
DI void p4_glu(const P& p, int job, char* smem) {
  const int pm = job >> 3, pn = job & 7;
  const int brow = pm * 128, bcol = pn * 128;
  f32x4 acc[4][4];
  ZERO_ACC(acc);
  const u16* Y = unitp(p, 5);
  gemm_core(Y, 1024, (const u16*)(p.ws + OFF_WTGLU), 1024, 1024, brow, bcol, smem, acc);
  EPI_VARS;
  u16* Z = unitp(p, 1);
  EPI_BASE(1024, brow, bcol);
  EPI_LOOP {
    float bb = p.b_glu[bcol + wc * 64 + n * 16 + fr];
#pragma unroll
    for (int j = 0; j < 4; ++j) {
      int gi = idx0 + (m * 16 + j) * 1024 + n * 16;
      Z[gi] = f2bf(bf2f(Y[gi]) * sigmoidf_(acc[m][n][j] + bb));
    }
  }
}
constexpr int NJ4_A = T / 4, NJ4 = NJ4_A + 133 * 8;

DI void phase5(const P& p, int job, char* smem) {
  const int pm = job >> 3, pn = job & 7;
  const int brow = pm * 128, bcol = pn * 128;
  EPI_VARS;
  u16* MX = unitp(p, 3);
#pragma unroll 1
  for (int pass = 0; pass < 2; ++pass) {
    f32x4 acc[4][4];
    ZERO_ACC(acc);
    gemm_core(unitp(p, pass ? 1 : 2), 1024, (const u16*)(p.ws + (pass ? OFF_WTB : OFF_WTA)), 1024, 1024, brow, bcol,
              smem, acc);
    const u16* GT = unitp(p, 6 + pass);
    EPI_BASE(1024, brow, bcol);
    EPI_LOOP {
#pragma unroll
      for (int j = 0; j < 4; ++j) {
        int gi = idx0 + (m * 16 + j) * 1024 + n * 16;
        float prev = pass ? bf2f(MX[gi]) : 0.f;
        MX[gi] = f2bf(prev + acc[m][n][j] * bf2f(GT[gi]));
      }
    }
  }
}
constexpr int NJ5 = 133 * 8;

DI void phase6(const P& p, int job, char* smem) {
  const int pm = job >> 3, pn = job & 7;
  const int brow = pm * 128, bcol = pn * 128;
  EPI_VARS;
  f32x4 acc[4][4];
  ZERO_ACC(acc);
  gemm_core(unitp(p, 3), 1024, (const u16*)(p.ws + OFF_WTOUT), 1024, 1024, brow, bcol, smem, acc);
  float* X1 = (float*)unitp(p, 0);
  int rb = brow + wr * 64 + fq * 4, cbv = bcol + wc * 64 + fr;
  asm volatile("" : "+v"(rb), "+v"(cbv));
#pragma unroll
  for (int m = 0; m < 4; ++m) {
#pragma unroll
    for (int j = 0; j < 4; ++j) {
      const int row = rb + m * 16 + j;
      const float* xr = xrow(p, row) + cbv;
      float* xo = X1 + (size_t)row * 1024 + cbv;
#pragma unroll
      for (int n = 0; n < 4; ++n) xo[n * 16] = xr[n * 16] + acc[m][n][j];
    }
  }
}
constexpr int NJ6 = 133 * 8;

DI void phase7(const P& p, int job) {
  int tk = job * 4 + (threadIdx.x >> 6);
  rms_row_to_bf16((const float*)unitp(p, 0) + (size_t)tk * 1024, p.norm2_w, unitp(p, 2) + (size_t)tk * 1024,
                  threadIdx.x & 63);
}
constexpr int NJ7 = T / 4;
DI void convert_tables(const P& p, int j) {
  const float* src = (j < 4096 ? p.peer_u : p.peer_v) + (size_t)(j & 4095) * 4096 + threadIdx.x * 16;
  const float sc = j < 4096 ? 64.f : 16.f;
  unsigned char* dst = (j < 4096 ? (unsigned char*)(p.ws + OFF_UT8) + (size_t)j * 4096
                                 : (unsigned char*)unitp(p, 6) + (size_t)(j - 4096) * 4096) + threadIdx.x * 16;
  unsigned w[4];
#pragma unroll
  for (int i = 0; i < 4; ++i) {
    float4 a = *(const float4*)(src + 4 * i);
    int d = __builtin_amdgcn_cvt_pk_fp8_f32(a.x * sc, a.y * sc, 0, false);
    d = __builtin_amdgcn_cvt_pk_fp8_f32(a.z * sc, a.w * sc, d, true);
    w[i] = (unsigned)d;
  }
  *(uint4*)dst = make_uint4(w[0], w[1], w[2], w[3]);
}

DI void phase8(const P& p, int job, char* smem) {
  const int pm = job >> 4, pn = job & 15;
  const int brow = pm * 128, bcol = pn * 128;
  EPI_VARS;
  f32x4 acc[4][4];
  ZERO_ACC(acc);
  gemm_core(unitp(p, 2), 1024, (const u16*)(p.ws + OFF_WTQ), 1024, 1024, brow, bcol, smem, acc);
  u16* Q = unitp(p, 3);
  EPI_BASE(2048, brow, bcol);
  EPI_LOOP {
#pragma unroll
    for (int j = 0; j < 4; ++j) Q[idx0 + (m * 16 + j) * 2048 + n * 16] = f2bf(acc[m][n][j]);
  }
}
constexpr int NJ8 = 133 * 16;

DI int f2key(float f) { int s = __float_as_int(f); return s ^ ((s >> 31) & 0x7fffffff); }
DI float key2f(int k) { return __int_as_float(k ^ ((k >> 31) & 0x7fffffff)); }
DI int rowmax16(int x) {
  x = max(x, __builtin_amdgcn_update_dpp(0, x, 0x128, 0xf, 0xf, false));
  x = max(x, __builtin_amdgcn_update_dpp(0, x, 0x124, 0xf, 0xf, false));
  x = max(x, __builtin_amdgcn_update_dpp(0, x, 0x122, 0xf, 0xf, false));
  x = max(x, __builtin_amdgcn_update_dpp(0, x, 0x121, 0xf, 0xf, false));
  return x;
}
DI void phase9(const P& p, int job) {
  const int tid = threadIdx.x, wave = tid >> 6, lane = tid & 63, fr = lane & 15, fq = lane >> 4;
  const int tile = job >> 1, h = (job & 1) * 4 + wave;
  const int tok0 = tile * 16;
  const u16* QRY = unitp(p, 3);
  int* EXPI = (int*)unitp(p, 5);
  float* GATE = (float*)((char*)unitp(p, 5) + (size_t)T * 128 * 4);
  float v12[2][4];
  int i12[2][4];
#pragma unroll
  for (int half = 0; half < 2; ++half) {
    f32x4 acc[8];
#pragma unroll
    for (int nt = 0; nt < 8; ++nt) acc[nt] = f32x4{0.f, 0.f, 0.f, 0.f};
    const u16* Kb = (const u16*)(p.ws + (half ? OFF_K2 : OFF_K1)) + (size_t)h * 128 * 128;
#pragma unroll
    for (int ks = 0; ks < 4; ++ks) {
      s16x8 a = *(const s16x8*)(QRY + (size_t)(tok0 + fr) * 2048 + h * 256 + half * 128 + ks * 32 + fq * 8);
#pragma unroll
      for (int nt = 0; nt < 8; ++nt) {
        s16x8 b = *(const s16x8*)(Kb + (size_t)(nt * 16 + fr) * 128 + ks * 32 + fq * 8);
        acc[nt] = mfma32(a, b, acc[nt]);
      }
    }
    asm volatile("s_nop 15\n\ts_nop 15" : "+v"(acc[0]), "+v"(acc[1]), "+v"(acc[2]), "+v"(acc[3]), "+v"(acc[4]), "+v"(acc[5]), "+v"(acc[6]), "+v"(acc[7]));
#pragma unroll
    for (int j = 0; j < 4; ++j) {
      int keys[8];
#pragma unroll
      for (int nt = 0; nt < 8; ++nt) keys[nt] = (f2key(acc[nt][j]) & ~127) | (127 - (nt * 16 + fr));
#define CX(a, b) { int hi_ = max(keys[a], keys[b]), lo_ = min(keys[a], keys[b]); keys[a] = hi_; keys[b] = lo_; }
      CX(0, 1) CX(2, 3) CX(4, 5) CX(6, 7)
      CX(0, 2) CX(1, 3) CX(4, 6) CX(5, 7)
      CX(1, 2) CX(5, 6)
      CX(0, 4) CX(1, 5) CX(2, 6) CX(3, 7)
      CX(2, 4) CX(3, 5)
      CX(1, 2) CX(3, 4) CX(5, 6)
#undef CX
      int mine = 0;
      for (int r = 0; r < 16; ++r) {
        int wk = rowmax16(keys[0]);
        if (fr == r) mine = wk;
        if (keys[0] == wk) {
#pragma unroll
          for (int nt = 0; nt < 7; ++nt) keys[nt] = keys[nt + 1];
          keys[7] = (int)0x80000000;
        }
      }
      v12[half][j] = key2f(mine & ~127);
      i12[half][j] = 127 - (mine & 127);
    }
  }
#pragma unroll
  for (int j = 0; j < 4; ++j) {
    const float v1 = v12[0][j], v2 = v12[1][j];
    const int e1 = i12[0][j], e2 = i12[1][j];
    int ptr = 0;
    float sc = 0.f;
    int ex = 0;
    const int gbase = lane & ~15;
    for (int r = 0; r < 16; ++r) {
      int pc = min(ptr, 15);
      float v2p = __shfl(v2, gbase + pc);
      int e2p = __shfl(e2, gbase + pc);
      int key = ptr < 16 ? ((f2key(v1 + v2p) & ~255) | (255 - (fr * 16 + ptr))) : (int)0x80000000;
      int wk = rowmax16(key);
      int pos = 255 - (wk & 255);
      int wi = pos >> 4;
      int myexp = e1 * 128 + e2p;
      int wexp = __shfl(myexp, gbase + wi);
      if (fr == r) { sc = key2f(wk & ~255); ex = wexp; }
      if (fr == wi) ptr++;
    }
    float mx = sc;
    mx = fmaxf(mx, __shfl_xor(mx, 1));
    mx = fmaxf(mx, __shfl_xor(mx, 2));
    mx = fmaxf(mx, __shfl_xor(mx, 4));
    mx = fmaxf(mx, __shfl_xor(mx, 8));
    float e = __expf(sc - mx);
    float sm = e;
    sm += __shfl_xor(sm, 1);
    sm += __shfl_xor(sm, 2);
    sm += __shfl_xor(sm, 4);
    sm += __shfl_xor(sm, 8);
    size_t oi = (size_t)(tok0 + 4 * fq + j) * 128 + h * 16 + fr;
    EXPI[oi] = ex;
    GATE[oi] = e / sm;
  }
}
constexpr int NJ9 = 1064 * 2;

typedef float f32x2v __attribute__((ext_vector_type(2)));
DI void unpack16(const uint4& a, float (&x)[16]) {
  const unsigned w[4] = {a.x, a.y, a.z, a.w};
#pragma unroll
  for (int i = 0; i < 4; ++i) {
    f32x2v lo = __builtin_amdgcn_cvt_pk_f32_fp8((int)w[i], false);
    f32x2v hi = __builtin_amdgcn_cvt_pk_f32_fp8((int)w[i], true);
    x[4 * i] = lo[0]; x[4 * i + 1] = lo[1]; x[4 * i + 2] = hi[0]; x[4 * i + 3] = hi[1];
  }
}
#define LANE_OF(k) ((((k) >> 3) & 1) * 32 + (((k) >> 2) & 1) * 16 + (((k) >> 1) & 1) * 8 + ((k)&1) * 4)
DI void phase10(const P& p, int job) {
  const int lane = threadIdx.x & 63;
  const int tk = job * 4 + (threadIdx.x >> 6);
  float* dst;
  if (tk < TP) {
    int n = tk / LP, l = tk - n * LP;
    if (l < 16) return;
    dst = p.out + O_YP + ((size_t)n * 2048 + (l - 16)) * 1024;
  } else {
    dst = p.out + O_YS + (size_t)(tk - TP) * 1024;
  }
  const float* X1 = (const float*)unitp(p, 0) + (size_t)tk * 1024;
  const u16* H2 = unitp(p, 2) + (size_t)tk * 1024;
  const int* EXPI = (const int*)unitp(p, 5) + (size_t)tk * 128;
  const float* GATE = (const float*)((const char*)unitp(p, 5) + (size_t)T * 128 * 4) + (size_t)tk * 128;
  const unsigned char* UT = (const unsigned char*)(p.ws + OFF_UT8);
  const unsigned char* VTB = (const unsigned char*)unitp(p, 6);
  float hv[16];
  {
    uint4 a = *(const uint4*)(H2 + lane * 16), b = *(const uint4*)(H2 + lane * 16 + 8);
    hv[0] = bflo(a.x); hv[1] = bfhi(a.x); hv[2] = bflo(a.y); hv[3] = bfhi(a.y);
    hv[4] = bflo(a.z); hv[5] = bfhi(a.z); hv[6] = bflo(a.w); hv[7] = bfhi(a.w);
    hv[8] = bflo(b.x); hv[9] = bfhi(b.x); hv[10] = bflo(b.y); hv[11] = bfhi(b.y);
    hv[12] = bflo(b.z); hv[13] = bfhi(b.z); hv[14] = bflo(b.w); hv[15] = bfhi(b.w);
  }
  float ov[16];
#pragma unroll
  for (int i = 0; i < 16; ++i) ov[i] = 0.f;
  const int kmine = ((lane >> 5) & 1) * 8 + ((lane >> 4) & 1) * 4 + ((lane >> 3) & 1) * 2 + ((lane >> 2) & 1);
  const bool b5 = lane & 32, b4 = lane & 16, b3 = lane & 8, b2 = lane & 4;
  for (int h = 0; h < 8; ++h) {
    const int e_l = EXPI[h * 16 + kmine];
    const float g_l = GATE[h * 16 + kmine];
    float part[16];
#pragma unroll
    for (int k = 0; k < 16; ++k) {
      int e = __builtin_amdgcn_readlane(e_l, LANE_OF(k));
      uint4 a = *(const uint4*)(UT + (size_t)e * 1024 + lane * 16);
      float x[16];
      unpack16(a, x);
      float d = 0.f;
#pragma unroll
      for (int i = 0; i < 16; ++i) d += x[i] * hv[i];
      part[k] = d;
    }
    float r8[8], r4[4], r2[2];
#pragma unroll
    for (int i = 0; i < 8; ++i) {
      float send = b5 ? part[i] : part[i + 8], keep = b5 ? part[i + 8] : part[i];
      r8[i] = keep + __shfl_xor(send, 32);
    }
#pragma unroll
    for (int i = 0; i < 4; ++i) {
      float send = b4 ? r8[i] : r8[i + 4], keep = b4 ? r8[i + 4] : r8[i];
      r4[i] = keep + __shfl_xor(send, 16);
    }
#pragma unroll
    for (int i = 0; i < 2; ++i) {
      float send = b3 ? r4[i] : r4[i + 2], keep = b3 ? r4[i + 2] : r4[i];
      r2[i] = keep + __shfl_xor(send, 8);
    }
    float d;
    {
      float send = b2 ? r2[0] : r2[1], keep = b2 ? r2[1] : r2[0];
      d = keep + __shfl_xor(send, 4);
    }
    d += __shfl_xor(d, 2);
    d += __shfl_xor(d, 1);
    const float w_l = g_l * geluf_(d * (1.f / 64.f)) * (1.f / 16.f);
#pragma unroll
    for (int k = 0; k < 16; ++k) {
      int e = __builtin_amdgcn_readlane(e_l, LANE_OF(k));
      float w = __builtin_bit_cast(float, __builtin_amdgcn_readlane(__builtin_bit_cast(int, w_l), LANE_OF(k)));
      uint4 a = *(const uint4*)(VTB + (size_t)e * 1024 + lane * 16);
      float x[16];
      unpack16(a, x);
#pragma unroll
      for (int i = 0; i < 16; ++i) ov[i] += w * x[i];
    }
  }
  float ss = 0.f;
#pragma unroll
  for (int i = 0; i < 4; ++i) {
    float4 x = *(const float4*)(X1 + lane * 16 + i * 4);
    ov[4 * i] += x.x; ov[4 * i + 1] += x.y; ov[4 * i + 2] += x.z; ov[4 * i + 3] += x.w;
    ss += ov[4 * i] * ov[4 * i] + ov[4 * i + 1] * ov[4 * i + 1] + ov[4 * i + 2] * ov[4 * i + 2] + ov[4 * i + 3] * ov[4 * i + 3];
  }
  ss = wave_sum(ss);
  const float rs = rsqrtf(ss * (1.f / 1024.f) + EPS);
#pragma unroll
  for (int i = 0; i < 4; ++i) {
    int eo = lane * 16 + i * 4;
    float4 w = *(const float4*)(p.final_w + eo);
    *(float4*)(dst + eo) =
        make_float4(ov[4 * i] * rs * w.x, ov[4 * i + 1] * rs * w.y, ov[4 * i + 2] * rs * w.z, ov[4 * i + 3] * rs * w.w);
  }
}
constexpr int NJ10 = T / 4;


#define XB_TMO      128
#define XB_XCNT(j)  (256  + 64 * (j))
#define XB_XSUB(j)  (1280 + 64 * (j))
#define XB_XGEN(j)  (2304 + 64 * (j))
#define XB_TOP      3328
#define XB_TOPGEN   3392
#define XCD_BAR_WORDS 3456
#define XB_SPIN_CAP (1u << 18)
#define LAS __attribute__((address_space(3)))

__device__ __forceinline__ unsigned xb_ld(unsigned* p)              { return __hip_atomic_load(p, __ATOMIC_RELAXED, __HIP_MEMORY_SCOPE_AGENT); }
__device__ __forceinline__ unsigned xb_add(unsigned* p, unsigned v) { return __hip_atomic_fetch_add(p, v, __ATOMIC_RELAXED, __HIP_MEMORY_SCOPE_AGENT); }
__device__ __forceinline__ unsigned xb_xcc_id() { return (unsigned)__builtin_amdgcn_s_getreg((3 << 11) | 20) & 0xFu; }
#define XB_SPIN(cond, bar) do { unsigned _sp = 0; while (cond) { __builtin_amdgcn_s_sleep(1); \
    if ((++_sp & 255u) == 0u) { if (xb_ld(&(bar)[XB_TMO])) break; if (_sp > XB_SPIN_CAP) { atomicAdd(&(bar)[XB_TMO], 1u); break; } } } } while (0)

struct XcdBarrier {
    unsigned* bar; unsigned x;
    volatile LAS unsigned* st;
};

__device__ __forceinline__ XcdBarrier xcd_barrier_post(unsigned* bar, volatile LAS unsigned* st) {
    XcdBarrier b; b.bar = bar; b.x = xb_xcc_id(); b.st = st;
    if (threadIdx.x == 0) (void)xb_add(&bar[XB_XCNT(b.x)], 1u);
    return b;
}
__device__ __forceinline__ void xcd_barrier_complete(unsigned* bar, unsigned x, unsigned& nloc, unsigned& nx) {
    const unsigned G = gridDim.x * gridDim.y * gridDim.z;
    unsigned sum, cnt, mine, sp = 0u;
    for (;;) {
        sum = 0u; cnt = 0u; mine = 0u;
#pragma unroll
        for (unsigned j = 0; j < 16; ++j) { const unsigned c = xb_ld(&bar[XB_XCNT(j)]); sum += c; cnt += (c > 0u) ? 1u : 0u; mine = (j == x) ? c : mine; }
        if (sum == G) break;
        __builtin_amdgcn_s_sleep(1);
        if ((++sp & 255u) == 0u) { if (xb_ld(&bar[XB_TMO])) break; if (sp > XB_SPIN_CAP) { atomicAdd(&bar[XB_TMO], 1u); break; } }
    }
    nloc = mine > 0u ? mine : 1u; nx = cnt > 0u ? cnt : 1u;
}

__device__ __forceinline__ void xcd_barrier(const XcdBarrier& b) {
    asm volatile("s_waitcnt vmcnt(0)" ::: "memory");
    __syncthreads();
    if (threadIdx.x == 0) {
        unsigned* bar = b.bar;
        __builtin_amdgcn_s_waitcnt(0);
        unsigned nloc = b.st[0], nx = b.st[1];
        if (nloc == 0u) { xcd_barrier_complete(bar, b.x, nloc, nx); b.st[0] = nloc; b.st[1] = nx; }
        const unsigned old = xb_add(&bar[XB_XSUB(b.x)], 1u);
        const unsigned gen = old / nloc;
        if (old + 1u == (gen + 1u) * nloc) {
            __builtin_amdgcn_fence(__ATOMIC_RELEASE, "agent");
            asm volatile("s_waitcnt vmcnt(0)" ::: "memory");
            const unsigned og = xb_add(&bar[XB_TOP], 1u);
            const unsigned tg = og / nx;
            if (og + 1u == (tg + 1u) * nx) xb_add(&bar[XB_TOPGEN], 1u);
            else XB_SPIN(xb_ld(&bar[XB_TOPGEN]) == tg, bar);
            __builtin_amdgcn_fence(__ATOMIC_ACQUIRE, "agent");
            xb_add(&bar[XB_XGEN(b.x)], 1u);
            asm volatile("s_waitcnt vmcnt(0)" ::: "memory");
        } else {
            XB_SPIN(xb_ld(&bar[XB_XGEN(b.x)]) == gen, bar);
            __builtin_amdgcn_fence(__ATOMIC_ACQUIRE, "agent");
            asm volatile("s_waitcnt vmcnt(0)" ::: "memory");
        }
    }
    __syncthreads();
}


DI void my_sync(unsigned* bar, unsigned target) {
  asm volatile("s_waitcnt vmcnt(0)" ::: "memory");
  __syncthreads();
  if (threadIdx.x == 0) {
    __builtin_amdgcn_fence(__ATOMIC_RELEASE, "agent");
    asm volatile("s_waitcnt vmcnt(0)" ::: "memory");
    __hip_atomic_fetch_add(bar, 1u, __ATOMIC_RELAXED, __HIP_MEMORY_SCOPE_AGENT);
    while (__hip_atomic_load(bar, __ATOMIC_RELAXED, __HIP_MEMORY_SCOPE_AGENT) < target) __builtin_amdgcn_s_sleep(2);
    __builtin_amdgcn_fence(__ATOMIC_ACQUIRE, "agent");
    asm volatile("s_waitcnt vmcnt(0)" ::: "memory");
  }
  __syncthreads();
}
__global__ void __launch_bounds__(256, 2) mega(P p, int ph_lo, int ph_hi) {
  __shared__ __attribute__((aligned(16))) char smem[SMEM_BYTES];
  cg::grid_group grid = cg::this_grid();
  const int G = gridDim.x, B = blockIdx.x;
#define RUN_PHASE(n) if ((ONLY < 0 || ONLY == n) && ph_lo <= n && n < ph_hi)
  __shared__ uint4 xb_words;
  if (threadIdx.x == 0) xb_words = make_uint4(0u, 0u, 0u, 0u);
  __syncthreads();
  XcdBarrier xb = xcd_barrier_post((unsigned*)(p.ws + OFF_BAR), (volatile LAS unsigned*)&xb_words);
  if (ph_hi > 1000) grid.sync();
#define SYNC_IF(n) if (n > ph_lo) { xcd_barrier(xb); }
  RUN_PHASE(0) {
    for (int j = B; j < NJ0 - 1536; j += G) phase0(p, j < 1792 ? j : j + 1536, smem); }
  RUN_PHASE(1) { SYNC_IF(1) for (int j = B; j < NJ1; j += G) phase1(p, j, smem); }
  RUN_PHASE(2) { SYNC_IF(2)
    for (int j = B; j < NJ2_H; j += G) p2_hgrn_pre(p, j, smem); }
  RUN_PHASE(3) { SYNC_IF(3)
    if (B < NJ3_A) p3_hgrn_seq(p, B, smem);
    else if (B < NJ3_A + NJ3_CH) p3_s5chain(p, B - NJ3_A, smem);
    else for (int j = B - (NJ3_A + NJ3_CH); j < NJ3_REST + 1536; j += G - (NJ3_A + NJ3_CH)) {
      if (j < NJ3_REST) phase3rest(p, j, smem); else phase0(p, 1792 + (j - NJ3_REST), smem); } }
  RUN_PHASE(4) { SYNC_IF(4)
    for (int j = B; j < NJ4; j += G) { if (j < NJ4_A) p4_onorm(p, j); else p4_glu(p, j - NJ4_A, smem); } }
  RUN_PHASE(5) { SYNC_IF(5) for (int j = B; j < NJ5; j += G) phase5(p, j, smem);
    { const int extra = NJ5 % G;
      if (B >= extra) for (int j = B - extra; j < 4096; j += G - extra) convert_tables(p, j); } }
  RUN_PHASE(6) { SYNC_IF(6) for (int j = B; j < NJ6; j += G) phase6(p, j, smem);
    { const int extra = NJ6 % G;
      if (B >= extra) for (int j = 4096 + B - extra; j < 8192; j += G - extra) convert_tables(p, j); } }
  RUN_PHASE(7) { SYNC_IF(7) for (int j = B; j < NJ7; j += G) phase7(p, j); }
  RUN_PHASE(8) { SYNC_IF(8) for (int j = B; j < NJ8; j += G) phase8(p, j, smem); }
  RUN_PHASE(9) { SYNC_IF(9) for (int j = B; j < NJ9; j += G) phase9(p, j); }
  RUN_PHASE(10) { SYNC_IF(10) for (int j = B; j < NJ10; j += G) phase10(p, j); }
}

extern "C" void kernel_launch(void* const* d_in, const int* in_sizes, int n_in, void* d_out, int out_size, void* d_ws,
                              size_t ws_size, hipStream_t stream) {
  static int grid_blocks = 0;
  if (!grid_blocks) {
    int dev = 0, cus = 0, per_cu = 0;
    hipGetDevice(&dev);
    hipDeviceGetAttribute(&cus, hipDeviceAttributeMultiprocessorCount, dev);
    hipOccupancyMaxActiveBlocksPerMultiprocessor(&per_cu, mega, 256, 0);
    if (per_cu < 1) per_cu = 1;
    grid_blocks = cus * per_cu;
  }
  P p{};
  const float** pf = (const float**)&p;
  for (int i = 0; i < 30; ++i) pf[i] = (const float*)d_in[i];
  p.out = (float*)d_out;
  p.ws = (char*)d_ws;
#if SINGLE_LAUNCH
  hipMemsetAsync((char*)d_ws + OFF_BAR, 0, XCD_BAR_WORDS * sizeof(unsigned), stream);
  int lo = 0, hi = 11;
  void* args[] = {&p, &lo, &hi};
  hipError_t e = hipLaunchCooperativeKernel((void*)mega, dim3(grid_blocks), dim3(256), args, 0, stream);
  if (e != hipSuccess) fprintf(stderr, "cooperative launch failed: %s (grid %d)\n", hipGetErrorString(e), grid_blocks);
#else
  for (int ph = 0; ph < 11; ++ph) hipLaunchKernelGGL(mega, dim3(grid_blocks), dim3(256), 0, stream, p, ph, ph + 1);
#endif
}
```

```cpp
#include <hip/hip_runtime.h>
#include <hip/hip_cooperative_groups.h>
#include <cstdio>
namespace cg = cooperative_groups;

#define DI __device__ __forceinline__
typedef unsigned short u16;
typedef short s16x4 __attribute__((ext_vector_type(4)));
typedef short s16x8 __attribute__((ext_vector_type(8)));
typedef float f32x4 __attribute__((ext_vector_type(4)));
typedef __bf16 bf16x2_t __attribute__((ext_vector_type(2)));
typedef float f32x2_t __attribute__((ext_vector_type(2)));

#ifndef SINGLE_LAUNCH
#define SINGLE_LAUNCH 1
#endif

constexpr int T = 17024, TP = 16512, LP = 2064, NCHK = 129;
constexpr float EPS = 1e-6f;
#ifndef ONLY
#define ONLY -1
#endif
constexpr size_t UNIT = (size_t)T * 1024 * 2;
constexpr size_t OFF_WTIN = 0;
constexpr size_t OFF_WTGLU = OFF_WTIN + (size_t)7168 * 1024 * 2;
constexpr size_t OFF_WTA = OFF_WTGLU + 2097152;
constexpr size_t OFF_WTB = OFF_WTA + 2097152;
constexpr size_t OFF_WTOUT = OFF_WTB + 2097152;
constexpr size_t OFF_WTQ = OFF_WTOUT + 2097152;
constexpr size_t OFF_K1 = OFF_WTQ + 4194304;
constexpr size_t OFF_K2 = OFF_K1 + 262144;
constexpr size_t OFF_LB = OFF_K2 + 262144;
constexpr size_t OFF_ABAR = OFF_LB + 4096;
constexpr size_t OFF_APOW = OFF_ABAR + 32768;
constexpr size_t OFF_BBAR = OFF_APOW + 32768;
constexpr size_t OFF_UNITS = OFF_BBAR + 524288;
constexpr size_t OFF_BAR = OFF_UNITS + 8 * ((size_t)17024 * 1024 * 2);
constexpr size_t OFF_UT8 = OFF_BAR + 65536;
constexpr size_t OOFF_KTT = 0;
constexpr size_t OOFF_DEC = UNIT;
constexpr size_t OOFF_E = OOFF_DEC + (size_t)1032 * 1024 * 4;
constexpr size_t O_YP = 0, O_YS = 16777216, O_HGP = 17301504, O_SRP = 18350080, O_SIP = 18382848,
                 O_HGS = 18415616, O_SRS = 35192832, O_SIS = 35717120;
constexpr int SMEM_BYTES = 65536;

struct P {
  const float *x_prompt, *x_sample, *state_hgrn, *ssm_re, *ssm_im, *meta, *lower_bounds, *norm1_w, *w_in, *g_norm_w,
      *a_re, *a_im, *log_step, *b_re, *b_im, *c_re, *c_im, *ssm_d, *w_glu, *b_glu, *w_a, *w_b, *w_out, *norm2_w,
      *peer_wq, *k1, *k2, *peer_u, *peer_v, *final_w;
  float* out;
  char* ws;
};

DI unsigned pack2(float a, float b) {
  f32x2_t v = {a, b};
  bf16x2_t r = __builtin_convertvector(v, bf16x2_t);
  return __builtin_bit_cast(unsigned, r);
}
DI u16 f2bf(float a) { return (u16)(pack2(a, 0.f) & 0xffffu); }
DI float bf2f(u16 v) { return __uint_as_float(((unsigned)v) << 16); }
DI float bflo(unsigned v) { return __uint_as_float(v << 16); }
DI float bfhi(unsigned v) { return __uint_as_float(v & 0xffff0000u); }
DI f32x4 mfma32(s16x8 a, s16x8 b, f32x4 c) { return __builtin_amdgcn_mfma_f32_16x16x32_bf16(a, b, c, 0, 0, 0); }
DI f32x4 mfma16(s16x4 a, s16x4 b, f32x4 c) { return __builtin_amdgcn_mfma_f32_16x16x16bf16_1k(a, b, c, 0, 0, 0); }
DI float wave_sum(float v) {
#pragma unroll
  for (int o = 32; o >= 1; o >>= 1) v += __shfl_xor(v, o);
  return v;
}
DI float sigmoidf_(float x) { return 1.f / (1.f + __expf(-x)); }
DI float siluf_(float x) { return x / (1.f + __expf(-x)); }
DI float geluf_(float x) { return 0.5f * x * (1.f + erff(x * 0.70710678118654752f)); }
DI s16x4 pack4(f32x4 v) {
  unsigned a = pack2(v[0], v[1]), b = pack2(v[2], v[3]);
  uint2 u = make_uint2(a, b);
  return __builtin_bit_cast(s16x4, u);
}
DI s16x8 pack8(f32x4 x, f32x4 y) {
  uint4 u = make_uint4(pack2(x[0], x[1]), pack2(x[2], x[3]), pack2(y[0], y[1]), pack2(y[2], y[3]));
  return __builtin_bit_cast(s16x8, u);
}
DI u16* unitp(const P& p, int i) { return (u16*)(p.ws + OFF_UNITS + (size_t)i * UNIT); }
DI const float* xrow(const P& p, int tk) {
  if (tk < TP) {
    int n = tk / LP, l = tk - n * LP;
    return l < 16 ? p.meta + (size_t)l * 1024 : p.x_prompt + ((size_t)n * 2048 + (l - 16)) * 1024;
  }
  return p.x_sample + (size_t)(tk - TP) * 1024;
}

DI void gemm_core(const u16* __restrict__ A, int lda, const u16* __restrict__ Bt, int ldb, int K, int brow, int bcol,
                  char* smem, f32x4 (&acc)[4][4]) {
  const int tid = threadIdx.x, wave = tid >> 6, lane = tid & 63, wr = wave >> 1, wc = wave & 1, fr = lane & 15,
            fq = lane >> 4;
  const int r0 = tid >> 3, cj = tid & 7;
  const u16* ga = A + (size_t)(brow + r0) * lda + cj * 8;
  const u16* gb = Bt + (size_t)(bcol + r0) * ldb + cj * 8;
  const size_t sa = (size_t)32 * lda, sb = (size_t)32 * ldb;
  const int woff = r0 * 128 + ((cj ^ ((r0 >> 1) & 7)) << 4);
  uint4 xa0, xa1, xa2, xa3, xb0, xb1, xb2, xb3, ya0, ya1, ya2, ya3, yb0, yb1, yb2, yb3;
#define G_LOAD(S, kk)                                                                          \
  {                                                                                            \
    S##a0 = *(const uint4*)(ga + (kk) * 64);          S##b0 = *(const uint4*)(gb + (kk) * 64);            \
    S##a1 = *(const uint4*)(ga + sa + (kk) * 64);     S##b1 = *(const uint4*)(gb + sb + (kk) * 64);       \
    S##a2 = *(const uint4*)(ga + 2 * sa + (kk) * 64); S##b2 = *(const uint4*)(gb + 2 * sb + (kk) * 64);   \
    S##a3 = *(const uint4*)(ga + 3 * sa + (kk) * 64); S##b3 = *(const uint4*)(gb + 3 * sb + (kk) * 64);   \
  }
#define G_STORE(S, st)                                                                         \
  {                                                                                            \
    char* sp_ = smem + (st) * 32768 + woff;                                                    \
    *(uint4*)(sp_) = S##a0;         *(uint4*)(sp_ + 16384) = S##b0;                            \
    *(uint4*)(sp_ + 4096) = S##a1;  *(uint4*)(sp_ + 16384 + 4096) = S##b1;                     \
    *(uint4*)(sp_ + 8192) = S##a2;  *(uint4*)(sp_ + 16384 + 8192) = S##b2;                     \
    *(uint4*)(sp_ + 12288) = S##a3; *(uint4*)(sp_ + 16384 + 12288) = S##b3;                    \
  }
  const int arow = wr * 64 + fr, brow_l = wc * 64 + fr;
  const int sw = (fr >> 1) & 7;
  const int nk = K >> 6;
#define G_COMPUTE(st)                                                                          \
  {                                                                                            \
    const char* a = smem + (st) * 32768;                                                       \
    const char* b = a + 16384;                                                                 \
    _Pragma("unroll") for (int ks = 0; ks < 2; ++ks) {                                         \
      s16x8 af[4], bfr[4];                                                                     \
      const int co = (((ks * 4 + fq) ^ sw) << 4);                                              \
      _Pragma("unroll") for (int m = 0; m < 4; ++m) af[m] = *(const s16x8*)(a + (arow + m * 16) * 128 + co);     \
      _Pragma("unroll") for (int n = 0; n < 4; ++n) bfr[n] = *(const s16x8*)(b + (brow_l + n * 16) * 128 + co);  \
      _Pragma("unroll") for (int m = 0; m < 4; ++m)                                            \
      _Pragma("unroll") for (int n = 0; n < 4; ++n) acc[m][n] = mfma32(af[m], bfr[n], acc[m][n]);                \
    }                                                                                          \
  }
  G_LOAD(x, 0)
  G_STORE(x, 0)
  G_LOAD(y, 1)
  __syncthreads();
  for (int kt = 0; kt < nk; kt += 2) {
    if (kt + 2 < nk) G_LOAD(x, kt + 2)
    G_COMPUTE(0)
    G_STORE(y, 1)
    __syncthreads();
    if (kt + 3 < nk) G_LOAD(y, kt + 3)
    G_COMPUTE(1)
    if (kt + 2 < nk) G_STORE(x, 0)
    __syncthreads();
  }
#undef G_LOAD
#undef G_STORE
#undef G_COMPUTE
  asm volatile("s_nop 15\n\ts_nop 15" : "+v"(acc[0][0]), "+v"(acc[0][1]), "+v"(acc[0][2]), "+v"(acc[0][3]), "+v"(acc[1][0]), "+v"(acc[1][1]), "+v"(acc[1][2]), "+v"(acc[1][3]), "+v"(acc[2][0]), "+v"(acc[2][1]), "+v"(acc[2][2]), "+v"(acc[2][3]), "+v"(acc[3][0]), "+v"(acc[3][1]), "+v"(acc[3][2]), "+v"(acc[3][3]));
}
#define ZERO_ACC(acc)                              \
  _Pragma("unroll") for (int m = 0; m < 4; ++m)    \
  _Pragma("unroll") for (int n = 0; n < 4; ++n) acc[m][n] = f32x4{0.f, 0.f, 0.f, 0.f};
#define EPI_VARS                                                                                             \
  const int tid = threadIdx.x, wave = tid >> 6, lane = tid & 63, wr = wave >> 1, wc = wave & 1, fr = lane & 15, \
            fq = lane >> 4;
#define EPI_BASE(ld, rb, cbv)                                    \
  int tb_ = (wr * 64 + fq * 4) * (ld) + wc * 64 + fr;           \
  asm volatile("" : "+v"(tb_));                                 \
  const int idx0 = (rb) * (ld) + (cbv) + tb_;
#define EPI_LOOP                                 \
  _Pragma("unroll") for (int m = 0; m < 4; ++m)  \
  _Pragma("unroll") for (int n = 0; n < 4; ++n)

DI void p0_transpose(const float* __restrict__ W, int K, int N, u16* __restrict__ Wt, int tile, char* smem) {
  float* sm = (float*)smem;
  const int ntn = N >> 6;
  const int tk = tile / ntn, tn = tile - tk * ntn;
  const int tid = threadIdx.x;
  const int c = tid & 63, r0 = tid >> 6;
#pragma unroll
  for (int i = 0; i < 16; ++i) {
    int r = r0 + i * 4;
    sm[r * 65 + c] = W[(size_t)(tk * 64 + r) * N + tn * 64 + c];
  }
  __syncthreads();
  const int n = tid >> 2, ks = (tid & 3) * 16;
  unsigned o[8];
#pragma unroll
  for (int i = 0; i < 8; ++i) o[i] = pack2(sm[(ks + 2 * i) * 65 + n], sm[(ks + 2 * i + 1) * 65 + n]);
  uint4* dst = (uint4*)(Wt + (size_t)(tn * 64 + n) * K + tk * 64 + ks);
  dst[0] = make_uint4(o[0], o[1], o[2], o[3]);
  dst[1] = make_uint4(o[4], o[5], o[6], o[7]);
  __syncthreads();
}

DI void p0_convert(const float* __restrict__ src, u16* __restrict__ dst, int job) {
  size_t i = (size_t)job * 2048 + threadIdx.x * 8;
  float4 a = *(const float4*)(src + i), b = *(const float4*)(src + i + 4);
  *(uint4*)(dst + i) = make_uint4(pack2(a.x, a.y), pack2(a.z, a.w), pack2(b.x, b.y), pack2(b.z, b.w));
}

DI void p0_lb(const P& p) {
  float* LB = (float*)(p.ws + OFF_LB);
  for (int c = threadIdx.x; c < 1024; c += 256) {
    float a = p.lower_bounds[c], b = p.lower_bounds[1024 + c];
    LB[c] = 1.f / (1.f + expf(b - a));
  }
}

DI void p0_s5const(const P& p, int job) {
  int idx = job * 256 + threadIdx.x;
  int g = idx >> 6;
  float re = fminf(p.a_re[idx], -1e-4f), im = p.a_im[idx];
  float dl = expf(p.log_step[g]);
  float mag = expf(re * dl);
  float sn, cs;
  sincosf(im * dl, &sn, &cs);
  float ax = mag * cs, ay = mag * sn;
  float nx = ax - 1.f, ny = ay;
  float d2 = re * re + im * im;
  float cr = (nx * re + ny * im) / d2, ci = (ny * re - nx * im) / d2;
  float2* ABAR = (float2*)(p.ws + OFF_ABAR);
  float2* APOW = (float2*)(p.ws + OFF_APOW);
  float2* BBAR = (float2*)(p.ws + OFF_BBAR);
  ABAR[idx] = make_float2(ax, ay);
  float x = ax, y = ay, x16 = 0.f, y16 = 0.f;
#pragma unroll
  for (int i = 0; i < 5; ++i) {
    float nx2 = x * x - y * y, ny2 = 2.f * x * y;
    x = nx2; y = ny2;
    if (i == 3) { x16 = x; y16 = y; }
  }
  APOW[idx] = make_float2(x * x16 - y * y16, x * y16 + y * x16);
#pragma unroll
  for (int c = 0; c < 16; ++c) {
    float br = p.b_re[idx * 16 + c], bi = p.b_im[idx * 16 + c];
    BBAR[idx * 16 + c] = make_float2(cr * br - ci * bi, cr * bi + ci * br);
  }
}

DI void rms_row_to_bf16(const float* __restrict__ src, const float* __restrict__ w, u16* __restrict__ dst, int lane) {
  float4 v[4];
  float ss = 0.f;
#pragma unroll
  for (int i = 0; i < 4; ++i) {
    v[i] = *(const float4*)(src + i * 256 + lane * 4);
    ss += v[i].x * v[i].x + v[i].y * v[i].y + v[i].z * v[i].z + v[i].w * v[i].w;
  }
  ss = wave_sum(ss);
  float rs = rsqrtf(ss * (1.f / 1024.f) + EPS);
#pragma unroll
  for (int i = 0; i < 4; ++i) {
    float4 ww = *(const float4*)(w + i * 256 + lane * 4);
    uint2 o = make_uint2(pack2(v[i].x * rs * ww.x, v[i].y * rs * ww.y), pack2(v[i].z * rs * ww.z, v[i].w * rs * ww.w));
    *(uint2*)(dst + i * 256 + lane * 4) = o;
  }
}

DI void phase0(const P& p, int job, char* smem) {
  if (job < 1792) p0_transpose(p.w_in, 1024, 7168, (u16*)(p.ws + OFF_WTIN), job, smem);
  else if (job < 2048) p0_transpose(p.w_glu, 1024, 1024, (u16*)(p.ws + OFF_WTGLU), job - 1792, smem);
  else if (job < 2304) p0_transpose(p.w_a, 1024, 1024, (u16*)(p.ws + OFF_WTA), job - 2048, smem);
  else if (job < 2560) p0_transpose(p.w_b, 1024, 1024, (u16*)(p.ws + OFF_WTB), job - 2304, smem);
  else if (job < 2816) p0_transpose(p.w_out, 1024, 1024, (u16*)(p.ws + OFF_WTOUT), job - 2560, smem);
  else if (job < 3328) p0_transpose(p.peer_wq, 1024, 2048, (u16*)(p.ws + OFF_WTQ), job - 2816, smem);
  else if (job < 3392) p0_convert(p.k1, (u16*)(p.ws + OFF_K1), job - 3328);
  else if (job < 3456) p0_convert(p.k2, (u16*)(p.ws + OFF_K2), job - 3392);
  else if (job == 3456) p0_lb(p);
  else if (job < 3473) p0_s5const(p, job - 3457);
  else {
    int tk = (job - 3473) * 4 + (threadIdx.x >> 6);
    rms_row_to_bf16(xrow(p, tk), p.norm1_w, unitp(p, 0) + (size_t)tk * 1024, threadIdx.x & 63);
  }
}
constexpr int NJ0 = 3473 + T / 4;

DI void phase1(const P& p, int job, char* smem) {
  const int pm = job / 56, pn = job - pm * 56;
  const int brow = pm * 128, bcol = pn * 128;
  f32x4 acc[4][4];
  ZERO_ACC(acc);
  gemm_core(unitp(p, 0), 1024, (const u16*)(p.ws + OFF_WTIN), 1024, 1024, brow, bcol, smem, acc);
  EPI_VARS;
  const int region = pn >> 3;
  const int cbase = bcol - region * 1024;
  if (region == 2) {
    u16* VT = unitp(p, 3);
    int vb = ((brow >> 4) + wr * 4) * 16384 + (cbase + wc * 64 + fr) * 16 + fq * 4;
    asm volatile("" : "+v"(vb));
    EPI_LOOP { *(s16x4*)(VT + vb + m * 16384 + n * 256) = pack4(acc[m][n]); }
  } else {
    u16* dst = unitp(p, region == 0 ? 1 : region == 1 ? 2 : region + 1);
    EPI_BASE(1024, brow, cbase);
    EPI_LOOP {
#pragma unroll
      for (int j = 0; j < 4; ++j) {
        float v = acc[m][n][j];
        if (region == 0 || region == 3) v = siluf_(v);
        else if (region >= 5) v = sigmoidf_(v);
        dst[idx0 + (m * 16 + j) * 1024 + n * 16] = f2bf(v);
      }
    }
  }
}
constexpr int NJ1 = 133 * 56;

DI void p2_hgrn_pre(const P& p, int job, char* smem) {
  const int tid = threadIdx.x, wave = tid >> 6, lane = tid & 63, fr = lane & 15, fq = lane >> 4;
  const int chunk = job >> 1, h = (job & 1) * 4 + wave;
  const int tok0 = chunk * 16;
  u16* R1 = unitp(p, 1);
  const u16* R2 = unitp(p, 2);
  const u16* VT = unitp(p, 3);
  u16* OIN = unitp(p, 0);
  u16* KTT = (u16*)((char*)p.out + OOFF_KTT);
  float* DEC = (float*)((char*)p.out + OOFF_DEC);
  const float* LB = (const float*)(p.ws + OFF_LB);
  char* sq = smem + wave * 8704;
  char* sk = sq + 4352;
  const int c0 = h * 128 + lane * 2;
  const float lb0 = LB[c0], lb1 = LB[c0 + 1];
  float b0 = 0.f, b1 = 0.f;
  float kn0[16], kn1[16];
#pragma unroll
  for (int t = 0; t < 16; ++t) {
    size_t gi = (size_t)(tok0 + t) * 1024 + c0;
    unsigned q2 = *(const unsigned*)(R1 + gi), f2 = *(const unsigned*)(R2 + gi);
    float f0 = bflo(f2), f1 = bfhi(f2);
    float e0 = __expf(-f0), e1 = __expf(-f1);
    float fg0 = lb0 + (1.f - lb0) / (1.f + e0), fg1 = lb1 + (1.f - lb1) / (1.f + e1);
    float k0 = (1.f - lb0) * e0 / (1.f + e0), k1 = (1.f - lb1) * e1 / (1.f + e1);
    b0 += __logf(fg0);
    b1 += __logf(fg1);
    float qt0 = bflo(q2) * __expf(b0), qt1 = bfhi(q2) * __expf(b1);
    kn0[t] = k0 * __expf(-b0);
    kn1[t] = k1 * __expf(-b1);
    unsigned qp = pack2(qt0, qt1);
    *(unsigned*)(R1 + gi) = qp;
    *(unsigned*)(sq + t * 272 + lane * 4) = qp;
    *(unsigned*)(sk + t * 272 + lane * 4) = pack2(kn0[t], kn1[t]);
  }
  const float eb0 = __expf(b0), eb1 = __expf(b1);
  *(float2*)(DEC + (size_t)chunk * 1024 + c0) = make_float2(eb0, eb1);
  {
    unsigned w0[8], w1[8];
#pragma unroll
    for (int i = 0; i < 8; ++i) {
      w0[i] = pack2(kn0[2 * i] * eb0, kn0[2 * i + 1] * eb0);
      w1[i] = pack2(kn1[2 * i] * eb1, kn1[2 * i + 1] * eb1);
    }
    uint4* kd = (uint4*)(KTT + ((size_t)chunk * 1024 + c0) * 16);
    kd[0] = make_uint4(w0[0], w0[1], w0[2], w0[3]);
    kd[1] = make_uint4(w0[4], w0[5], w0[6], w0[7]);
    kd[2] = make_uint4(w1[0], w1[1], w1[2], w1[3]);
    kd[3] = make_uint4(w1[4], w1[5], w1[6], w1[7]);
  }
  __syncthreads();
  f32x4 at = {0.f, 0.f, 0.f, 0.f};
#pragma unroll
  for (int ks = 0; ks < 4; ++ks) {
    s16x8 a = *(const s16x8*)(sk + fr * 272 + ks * 64 + fq * 16);
    s16x8 b = *(const s16x8*)(sq + fr * 272 + ks * 64 + fq * 16);
    at = mfma32(a, b, at);
  }
  asm volatile("s_nop 15\n\ts_nop 15" : "+v"(at));
#pragma unroll
  for (int j = 0; j < 4; ++j)
    if (4 * fq + j > fr) at[j] = 0.f;
  s16x4 af = pack4(at);
  asm volatile("s_nop 7" : "+v"(af));
#pragma unroll
  for (int nt = 0; nt < 8; ++nt) {
    size_t vi = ((size_t)chunk * 1024 + h * 128 + nt * 16 + fr) * 16 + 4 * fq;
    s16x4 vb = *(const s16x4*)(VT + vi);
    f32x4 o = mfma16(af, vb, f32x4{0.f, 0.f, 0.f, 0.f});
    asm volatile("s_nop 15\n\ts_nop 15" : "+v"(o));
    *(s16x4*)(OIN + vi) = pack4(o);
  }
  __syncthreads();
}

DI void s5_load_bbar(const P& p, int g, int pp, float (&br)[16], float (&bi)[16]) {
  const float4* B = (const float4*)((const float2*)(p.ws + OFF_BBAR) + ((size_t)g * 64 + pp) * 16);
#pragma unroll
  for (int i = 0; i < 8; ++i) {
    float4 v = B[i];
    br[2 * i] = v.x; bi[2 * i] = v.y; br[2 * i + 1] = v.z; bi[2 * i + 1] = v.w;
  }
}
DI void s5_step(const uint4& ua, const uint4& ub, int t, const float (&br)[16], const float (&bi)[16], float ax, float ay,
                float& xr, float& xi) {
  unsigned uu[8] = {(unsigned)__builtin_amdgcn_readlane((int)ua.x, t), (unsigned)__builtin_amdgcn_readlane((int)ua.y, t),
                    (unsigned)__builtin_amdgcn_readlane((int)ua.z, t), (unsigned)__builtin_amdgcn_readlane((int)ua.w, t),
                    (unsigned)__builtin_amdgcn_readlane((int)ub.x, t), (unsigned)__builtin_amdgcn_readlane((int)ub.y, t),
                    (unsigned)__builtin_amdgcn_readlane((int)ub.z, t), (unsigned)__builtin_amdgcn_readlane((int)ub.w, t)};
  float sr = 0.f, si = 0.f;
#pragma unroll
  for (int i = 0; i < 8; ++i) {
    float a = bflo(uu[i]), b = bfhi(uu[i]);
    sr += br[2 * i] * a + br[2 * i + 1] * b;
    si += bi[2 * i] * a + bi[2 * i + 1] * b;
  }
  float nr = ax * xr - ay * xi + sr, ni = ax * xi + ay * xr + si;
  xr = nr; xi = ni;
}

DI void p2_s5a(const P& p, int job) {
  const int gq = job & 15, nc = job >> 4;
  const int n = nc / 43, c = nc - n * 43;
  const int tid = threadIdx.x, g = gq * 4 + (tid >> 6), pp = tid & 63;
  float br[16], bi[16];
  s5_load_bbar(p, g, pp, br, bi);
  const float2 ab = ((const float2*)(p.ws + OFF_ABAR))[g * 64 + pp];
  const u16* U = unitp(p, 5) + (size_t)(n * LP + c * 48) * 1024 + g * 16;
  float xr = 0.f, xi = 0.f;
  uint4 ua, ub;
  {
    const u16* r = U + (size_t)min(pp, 47) * 1024;
    ua = *(const uint4*)r;
    ub = *(const uint4*)(r + 8);
  }
#pragma unroll 4
  for (int t = 0; t < 48; ++t) s5_step(ua, ub, t, br, bi, ab.x, ab.y, xr, xi);
  float2* E = (float2*)((char*)p.out + OOFF_E);
  E[((size_t)(n * 43 + c) * 64 + g) * 64 + pp] = make_float2(xr, xi);
}
constexpr int NJ2_H = 2064, NJ2_S = 8 * 43 * 16;
constexpr int NJ2 = NJ2_H + NJ2_S;

#define SEQ_GLOAD(cg_, P)                                                                              \
  {                                                                                                    \
    const int cgv = (cg_);                                                                             \
    P##rq = *(const uint4*)(QT + (size_t)(cgv * 16 + (tid >> 4)) * 1024 + h * 128 + (tid & 15) * 8);  \
    P##rk = *(const uint4*)(KTT + ((size_t)cgv * 1024 + h * 128) * 16 + tid * 8);                      \
    if (tid < 32) P##rd = *(const float4*)(DEC + (size_t)cgv * 1024 + h * 128 + tid * 4);              \
    size_t vi0 = ((size_t)cgv * 1024 + h * 128 + wave * 32 + fr) * 16 + 4 * fq;                        \
    P##rv0 = *(const s16x4*)(VT + vi0);                                                                \
    P##rv1 = *(const s16x4*)(VT + vi0 + 256);                                                          \
    P##ro0 = *(const s16x4*)(OIN + vi0);                                                               \
    P##ro1 = *(const s16x4*)(OIN + vi0 + 256);                                                         \
  }
#define SEQ_LSTORE(b_, P)                                                  \
  {                                                                        \
    char* lb_ = smem + (b_) * 8960;                                        \
    *(uint4*)(lb_ + (tid >> 4) * 272 + (tid & 15) * 16) = P##rq;           \
    *(uint4*)(lb_ + 4352 + tid * 16) = P##rk;                              \
    if (tid < 32) *(float4*)(lb_ + 8448 + tid * 16) = P##rd;               \
  }
#define SEQ_BODY(c_, X, Y)                                                                                   \
  {                                                                                                          \
    const int c = (c_);                                                                                      \
    const int b = c & 1;                                                                                     \
    const int tok0 = (cg0 + c) * 16;                                                                         \
    if (c + 2 < NCHK) SEQ_GLOAD(cg0 + c + 2, X)                                                              \
    const char* base = smem + b * 8960;                                                                      \
    f32x4 o0 = f32x4{0.f, 0.f, 0.f, 0.f}, o1 = f32x4{0.f, 0.f, 0.f, 0.f};                                    \
    _Pragma("unroll") for (int ks = 0; ks < 4; ++ks) {                                                       \
      s16x4 qa = *(const s16x4*)(base + fr * 272 + (ks * 32 + 4 * fq) * 2);                                  \
      s16x4 qb = *(const s16x4*)(base + fr * 272 + (ks * 32 + 16 + 4 * fq) * 2);                             \
      s16x8 Af = __builtin_shufflevector(qa, qb, 0, 1, 2, 3, 4, 5, 6, 7);                                    \
      s16x8 B0 = pack8(S[2 * ks][0], S[2 * ks + 1][0]), B1 = pack8(S[2 * ks][1], S[2 * ks + 1][1]);          \
      asm volatile("s_nop 7" : "+v"(B0), "+v"(B1), "+v"(Af));                                                \
      o0 = mfma32(Af, B0, o0);                                                                               \
      o1 = mfma32(Af, B1, o1);                                                                               \
    }                                                                                                        \
    asm volatile("s_nop 15\n\ts_nop 15" : "+v"(o0), "+v"(o1));                                               \
    _Pragma("unroll") for (int j = 0; j < 4; ++j) {                                                          \
      u16* orow = ORAW + (size_t)(tok0 + 4 * fq + j) * 1024 + h * 128 + wave * 32 + fr;                      \
      orow[0] = f2bf(o0[j] + bf2f((u16)co0[j]));                                                             \
      orow[16] = f2bf(o1[j] + bf2f((u16)co1[j]));                                                            \
    }                                                                                                        \
    _Pragma("unroll") for (int mt = 0; mt < 8; ++mt) {                                                       \
      f32x4 d = *(const f32x4*)(base + 8448 + (mt * 16 + 4 * fq) * 4);                                       \
      s16x4 ka = *(const s16x4*)(base + 4352 + (mt * 16 + fr) * 32 + fq * 8);                                \
      f32x4 s0 = S[mt][0] * d, s1 = S[mt][1] * d;                                                            \
      asm volatile("s_nop 7" : "+v"(s0), "+v"(s1), "+v"(ka));                                                \
      S[mt][0] = mfma16(ka, cv0, s0);                                                                        \
      S[mt][1] = mfma16(ka, cv1, s1);                                                                        \
    }                                                                                                        \
    asm volatile("s_nop 15\n\ts_nop 15" : "+v"(S[0][0]), "+v"(S[0][1]), "+v"(S[1][0]), "+v"(S[1][1]), "+v"(S[2][0]), "+v"(S[2][1]), "+v"(S[3][0]), "+v"(S[3][1]), "+v"(S[4][0]), "+v"(S[4][1]), "+v"(S[5][0]), "+v"(S[5][1]), "+v"(S[6][0]), "+v"(S[6][1]), "+v"(S[7][0]), "+v"(S[7][1])); \
    if (c + 1 < NCHK) SEQ_LSTORE(b ^ 1, Y)                                                                   \
    asm volatile("s_waitcnt lgkmcnt(0)\n\ts_barrier" ::: "memory");                                         \
    if (c + 1 < NCHK) { cv0 = Y##rv0; cv1 = Y##rv1; co0 = Y##ro0; co1 = Y##ro1; }                            \
  }
DI void p3_hgrn_seq(const P& p, int job, char* smem) {
  const int tid = threadIdx.x, wave = tid >> 6, lane = tid & 63, fr = lane & 15, fq = lane >> 4;
  const int n = job >> 3, h = job & 7;
  const u16* QT = unitp(p, 1);
  const u16* KTT = (const u16*)((const char*)p.out + OOFF_KTT);
  const float* DEC = (const float*)((const char*)p.out + OOFF_DEC);
  const u16* VT = unitp(p, 3);
  const u16* OIN = unitp(p, 0);
  u16* ORAW = unitp(p, 2);
  f32x4 S[8][2];
#pragma unroll
  for (int mt = 0; mt < 8; ++mt) { S[mt][0] = f32x4{0.f, 0.f, 0.f, 0.f}; S[mt][1] = f32x4{0.f, 0.f, 0.f, 0.f}; }
  const int cg0 = n * NCHK;
  uint4 Arq, Ark, Brq, Brk;
  float4 Ard = make_float4(0.f, 0.f, 0.f, 0.f), Brd = make_float4(0.f, 0.f, 0.f, 0.f);
  s16x4 Arv0, Arv1, Aro0, Aro1, Brv0, Brv1, Bro0, Bro1, cv0, cv1, co0, co1;
  SEQ_GLOAD(cg0, A)
  SEQ_LSTORE(0, A)
  cv0 = Arv0; cv1 = Arv1; co0 = Aro0; co1 = Aro1;
  SEQ_GLOAD(cg0 + 1, B)
  __syncthreads();
  for (int cc = 0; cc < NCHK - 1; cc += 2) {
    SEQ_BODY(cc, A, B)
    SEQ_BODY(cc + 1, B, A)
  }
  SEQ_BODY(NCHK - 1, A, B)
  float* HG = p.out + O_HGP + ((size_t)(n * 8 + h) * 128) * 128;
#pragma unroll
  for (int mt = 0; mt < 8; ++mt)
#pragma unroll
    for (int nt = 0; nt < 2; ++nt)
#pragma unroll
      for (int j = 0; j < 4; ++j) HG[(size_t)(mt * 16 + 4 * fq + j) * 128 + wave * 32 + nt * 16 + fr] = S[mt][nt][j];
}

DI void p3_hgrn_sample(const P& p, int job, char* smem) {
  const int tid = threadIdx.x;
  const int ns = job >> 3, h = job & 7;
  const int v = tid & 127, kh = tid >> 7;
  const u16* R1 = unitp(p, 1);
  const u16* R2 = unitp(p, 2 + 0);
  const u16* VT = unitp(p, 3);
  u16* ORAW = unitp(p, 2);
  const float* LB = (const float*)(p.ws + OFF_LB);
  float* sg = (float*)smem;
  float* skk = sg + 512;
  float* sq = skk + 512;
  float* so = sq + 512;
  const int tokb = TP + ns * 4;
  float fraw[4];
  if (tid < 128) {
    const float lb = LB[h * 128 + tid];
#pragma unroll
    for (int t = 0; t < 4; ++t) {
      size_t gi = (size_t)(tokb + t) * 1024 + h * 128 + tid;
      float f = bf2f(R2[gi]);
      fraw[t] = f;
      float e = __expf(-f);
      sg[t * 128 + tid] = lb + (1.f - lb) / (1.f + e);
      skk[t * 128 + tid] = (1.f - lb) * e / (1.f + e);
      sq[t * 128 + tid] = bf2f(R1[gi]);
    }
  }
  (void)fraw;
  float S[64];
  const float* st = p.state_hgrn + ((size_t)(ns * 8 + h) * 128 + kh * 64) * 128 + v;
#pragma unroll
  for (int i = 0; i < 64; ++i) S[i] = st[(size_t)i * 128];
  float vt[4];
#pragma unroll
  for (int t = 0; t < 4; ++t) {
    int tok = tokb + t;
    vt[t] = bf2f(VT[((size_t)(tok >> 4) * 1024 + h * 128 + v) * 16 + (tok & 15)]);
  }
  __syncthreads();
#pragma unroll
  for (int t = 0; t < 4; ++t) {
    float op = 0.f;
#pragma unroll
    for (int i = 0; i < 64; ++i) {
      int k = t * 128 + kh * 64 + i;
      S[i] = sg[k] * S[i] + skk[k] * vt[t];
      op += sq[k] * S[i];
    }
    so[(t * 2 + kh) * 128 + v] = op;
  }
  float* HG = p.out + O_HGS + ((size_t)(ns * 8 + h) * 128 + kh * 64) * 128 + v;
#pragma unroll
  for (int i = 0; i < 64; ++i) HG[(size_t)i * 128] = S[i];
  __syncthreads();
  if (tid < 128) {
#pragma unroll
    for (int t = 0; t < 4; ++t)
      ORAW[(size_t)(tokb + t) * 1024 + h * 128 + tid] = f2bf(so[(t * 2) * 128 + tid] + so[(t * 2 + 1) * 128 + tid]);
  }
  __syncthreads();
}

DI void p3_s5c(const P& p, int mode, int seq, int c, int gq, char* smem) {
  const int tid = threadIdx.x, wave = tid >> 6, lane = tid & 63, fr = lane & 15, fq = lane >> 4;
  const int g = gq * 4 + wave, pp = lane;
  float br[16], bi[16];
  s5_load_bbar(p, g, pp, br, bi);
  const float2 ab = ((const float2*)(p.ws + OFF_ABAR))[g * 64 + pp];
  float xr, xi;
  int tok0, ntok;
  if (mode == 0) {
    const float2 ap = ((const float2*)(p.ws + OFF_APOW))[g * 64 + pp];
    const float2* E = (const float2*)((const char*)p.out + OOFF_E) + ((size_t)(seq * 43) * 64 + g) * 64 + pp;
    xr = 0.f; xi = 0.f;
    for (int j0 = 0; j0 < c; j0 += 8) {
      float2 e[8];
#pragma unroll
      for (int i = 0; i < 8; ++i) e[i] = E[(size_t)min(j0 + i, c - 1) * 4096];
#pragma unroll
      for (int i = 0; i < 8; ++i)
        if (j0 + i < c) {
          float nr = ap.x * xr - ap.y * xi + e[i].x, ni = ap.x * xi + ap.y * xr + e[i].y;
          xr = nr; xi = ni;
        }
    }
    tok0 = seq * LP + c * 48;
    ntok = 48;
  } else {
    xr = p.ssm_re[((size_t)seq * 64 + g) * 64 + pp];
    xi = p.ssm_im[((size_t)seq * 64 + g) * 64 + pp];
    tok0 = TP + seq * 4;
    ntok = 4;
  }
  s16x8 cf[4];
#pragma unroll
  for (int ks = 0; ks < 4; ++ks) {
    int p0 = ks * 32 + fq * 8;
    const float* src = (p0 < 64 ? p.c_re : p.c_im) + ((size_t)g * 16 + fr) * 64 + (p0 & 63);
    float sgn = p0 < 64 ? 1.f : -1.f;
    float4 a = *(const float4*)src, b = *(const float4*)(src + 4);
    uint4 u = make_uint4(pack2(sgn * a.x, sgn * a.y), pack2(sgn * a.z, sgn * a.w), pack2(sgn * b.x, sgn * b.y),
                         pack2(sgn * b.z, sgn * b.w));
    cf[ks] = __builtin_bit_cast(s16x8, u);
  }
  const float dsk = p.ssm_d[g * 16 + fr];
  u16* U = unitp(p, 5);
  char* xs = smem + wave * 4352;
  const int nsub = (ntok + 15) >> 4;
  uint4 ua, ub;
  {
    const u16* r = U + (size_t)(tok0 + min(pp, ntok - 1)) * 1024 + g * 16;
    ua = *(const uint4*)r;
    ub = *(const uint4*)(r + 8);
  }
  for (int sc = 0; sc < nsub; ++sc) {
    const int tb = tok0 + sc * 16;
    const int nt = min(16, ntok - sc * 16);
#pragma unroll 4
    for (int t = 0; t < 16; ++t) {
      if (t < nt) {
        s5_step(ua, ub, sc * 16 + t, br, bi, ab.x, ab.y, xr, xi);
        *(u16*)(xs + t * 272 + pp * 2) = f2bf(xr);
        *(u16*)(xs + t * 272 + 128 + pp * 2) = f2bf(xi);
      } else {
        *(u16*)(xs + t * 272 + pp * 2) = 0;
        *(u16*)(xs + t * 272 + 128 + pp * 2) = 0;
      }
    }
    __syncthreads();
    f32x4 y = {0.f, 0.f, 0.f, 0.f};
#pragma unroll
    for (int ks = 0; ks < 4; ++ks) {
      s16x8 a = *(const s16x8*)(xs + fr * 272 + ks * 64 + fq * 16);
      y = mfma32(a, cf[ks], y);
    }
    asm volatile("s_nop 15\n\ts_nop 15" : "+v"(y));
#pragma unroll
    for (int j = 0; j < 4; ++j) {
      int t = 4 * fq + j;
      if (t < nt) {
        size_t gi = (size_t)(tb + t) * 1024 + g * 16 + fr;
        float uu = bf2f(U[gi]);
        U[gi] = f2bf(geluf_(y[j] + dsk * uu));
      }
    }
    __syncthreads();
  }
  if (mode == 0) {
    if (c == 42) {
      p.out[O_SRP + ((size_t)seq * 64 + g) * 64 + pp] = xr;
      p.out[O_SIP + ((size_t)seq * 64 + g) * 64 + pp] = xi;
    }
  } else {
    p.out[O_SRS + ((size_t)seq * 64 + g) * 64 + pp] = xr;
    p.out[O_SIS + ((size_t)seq * 64 + g) * 64 + pp] = xi;
  }
}
DI void p3_s5chain(const P& p, int job, char* smem) {
  const int tid = threadIdx.x, wave = tid >> 6, lane = tid & 63, fr = lane & 15, fq = lane >> 4;
  const int n = job >> 4, gq = job & 15;
  const int g = gq * 4 + wave, pp = lane;
  const float2 ab = ((const float2*)(p.ws + OFF_ABAR))[g * 64 + pp];
  s16x4 bb[8];
#pragma unroll
  for (int nt = 0; nt < 8; ++nt) {
    const float4* src = (const float4*)((const float2*)(p.ws + OFF_BBAR) + ((size_t)g * 64 + (nt & 3) * 16 + fr) * 16 + 4 * fq);
    float4 v0 = src[0], v1 = src[1];
    f32x4 sel = (nt < 4) ? f32x4{v0.x, v0.z, v1.x, v1.z} : f32x4{v0.y, v0.w, v1.y, v1.w};
    bb[nt] = pack4(sel);
  }
  s16x8 cf[4];
#pragma unroll
  for (int ks = 0; ks < 4; ++ks) {
    int p0 = ks * 32 + fq * 8;
    const float* src = (p0 < 64 ? p.c_re : p.c_im) + ((size_t)g * 16 + fr) * 64 + (p0 & 63);
    float sgn = p0 < 64 ? 1.f : -1.f;
    float4 a = *(const float4*)src, b = *(const float4*)(src + 4);
    uint4 u = make_uint4(pack2(sgn * a.x, sgn * a.y), pack2(sgn * a.z, sgn * a.w), pack2(sgn * b.x, sgn * b.y),
                         pack2(sgn * b.z, sgn * b.w));
    cf[ks] = __builtin_bit_cast(s16x8, u);
  }
  const float dsk = p.ssm_d[g * 16 + fr];
  u16* U = unitp(p, 5);
  char* xs = smem + wave * 12800;
  float* bu = (float*)(xs + 4352);
  float xr = 0.f, xi = 0.f;
  const int tokb = n * LP;
  s16x4 ua[3], na[3];
  u16 us[3][4], ns[3][4];
#pragma unroll
  for (int sc = 0; sc < 3; ++sc) {
    ua[sc] = *(const s16x4*)(U + (size_t)(tokb + sc * 16 + fr) * 1024 + g * 16 + 4 * fq);
#pragma unroll
    for (int j = 0; j < 4; ++j) us[sc][j] = U[(size_t)(tokb + sc * 16 + 4 * fq + j) * 1024 + g * 16 + fr];
  }
  for (int c = 0; c < 43; ++c) {
#pragma unroll
    for (int sc = 0; sc < 3; ++sc) {
      na[sc] = ua[sc];
#pragma unroll
      for (int j = 0; j < 4; ++j) ns[sc][j] = us[sc][j];
      if (c + 1 < 43) {
        na[sc] = *(const s16x4*)(U + (size_t)(tokb + (c + 1) * 48 + sc * 16 + fr) * 1024 + g * 16 + 4 * fq);
#pragma unroll
        for (int j = 0; j < 4; ++j) ns[sc][j] = U[(size_t)(tokb + (c + 1) * 48 + sc * 16 + 4 * fq + j) * 1024 + g * 16 + fr];
      }
    }
#pragma unroll
    for (int sc = 0; sc < 3; ++sc) {
      const int tb = tokb + c * 48 + sc * 16;
      s16x4 au = ua[sc];
      asm volatile("s_nop 3" : "+v"(au));
      f32x4 r[8];
#pragma unroll
      for (int nt = 0; nt < 8; ++nt) r[nt] = mfma16(au, bb[nt], f32x4{0.f, 0.f, 0.f, 0.f});
      asm volatile("s_nop 15" : "+v"(r[0]), "+v"(r[1]), "+v"(r[2]), "+v"(r[3]), "+v"(r[4]), "+v"(r[5]), "+v"(r[6]), "+v"(r[7]));
#pragma unroll
      for (int nt = 0; nt < 8; ++nt)
#pragma unroll
        for (int j = 0; j < 4; ++j) bu[(4 * fq + j) * 132 + nt * 16 + fr] = r[nt][j];
      __builtin_amdgcn_wave_barrier();
      float bre[16], bim[16];
#pragma unroll
      for (int t = 0; t < 16; ++t) { bre[t] = bu[t * 132 + pp]; bim[t] = bu[t * 132 + 64 + pp]; }
#pragma unroll
      for (int t = 0; t < 16; ++t) {
        float nr = ab.x * xr - ab.y * xi + bre[t], ni = ab.x * xi + ab.y * xr + bim[t];
        xr = nr; xi = ni;
        *(u16*)(xs + t * 272 + pp * 2) = f2bf(xr);
        *(u16*)(xs + t * 272 + 128 + pp * 2) = f2bf(xi);
      }
      __builtin_amdgcn_wave_barrier();
      f32x4 y = {0.f, 0.f, 0.f, 0.f};
#pragma unroll
      for (int ks = 0; ks < 4; ++ks) {
        s16x8 a = *(const s16x8*)(xs + fr * 272 + ks * 64 + fq * 16);
        y = mfma32(a, cf[ks], y);
      }
      asm volatile("s_nop 15\n\ts_nop 15" : "+v"(y));
#pragma unroll
      for (int j = 0; j < 4; ++j) {
        size_t gi = (size_t)(tb + 4 * fq + j) * 1024 + g * 16 + fr;
        U[gi] = f2bf(geluf_(y[j] + dsk * bf2f(us[sc][j])));
      }
    }
#pragma unroll
    for (int sc = 0; sc < 3; ++sc) {
      ua[sc] = na[sc];
#pragma unroll
      for (int j = 0; j < 4; ++j) us[sc][j] = ns[sc][j];
    }
  }
  p.out[O_SRP + ((size_t)n * 64 + g) * 64 + pp] = xr;
  p.out[O_SIP + ((size_t)n * 64 + g) * 64 + pp] = xi;
}
constexpr int NJ3_A = 64, NJ3_CH = 128, NJ3_B = 1024, NJ3_D = 128 * 16;
constexpr int NJ3_REST = NJ3_B + NJ3_D;
DI void phase3rest(const P& p, int job, char* smem) {
  if (job < NJ3_B) p3_hgrn_sample(p, job, smem);
  else { int j = job - NJ3_B; p3_s5c(p, 1, j >> 4, 0, j & 15, smem); }
}

DI void p4_onorm(const P& p, int job) {
  const int lane = threadIdx.x & 63;
  const int tk = job * 4 + (threadIdx.x >> 6);
  u16* O = unitp(p, 2) + (size_t)tk * 1024 + lane * 16;
  const u16* SG = unitp(p, 4) + (size_t)tk * 1024 + lane * 16;
  uint4 a0 = *(const uint4*)O, a1 = *(const uint4*)(O + 8);
  uint4 g0 = *(const uint4*)SG, g1 = *(const uint4*)(SG + 8);
  unsigned ov[8] = {a0.x, a0.y, a0.z, a0.w, a1.x, a1.y, a1.z, a1.w};
  unsigned gv[8] = {g0.x, g0.y, g0.z, g0.w, g1.x, g1.y, g1.z, g1.w};
  float ss = 0.f;
#pragma unroll
  for (int i = 0; i < 8; ++i) { float a = bflo(ov[i]), b = bfhi(ov[i]); ss += a * a + b * b; }
  ss += __shfl_xor(ss, 1);
  ss += __shfl_xor(ss, 2);
  ss += __shfl_xor(ss, 4);
  const float rs = rsqrtf(ss * (1.f / 128.f) + EPS);
  const float* gw = p.g_norm_w + (lane & 7) * 16;
  unsigned r[8];
#pragma unroll
  for (int i = 0; i < 8; ++i) {
    float a = bflo(ov[i]) * rs * gw[2 * i] * bflo(gv[i]);
    float b = bfhi(ov[i]) * rs * gw[2 * i + 1] * bfhi(gv[i]);
    r[i] = pack2(a, b);
  }
  *(uint4*)O = make_uint4(r[0], r[1], r[2], r[3]);
  *(uint4*)(O + 8) = make_uint4(r[4], r[5], r[6], r[7]);
}
DI void p4_glu(const P& p, int job, char* smem) {
  const int pm = job >> 3, pn = job & 7;
  const int brow = pm * 128, bcol = pn * 128;
  f32x4 acc[4][4];
  ZERO_ACC(acc);
  const u16* Y = unitp(p, 5);
  gemm_core(Y, 1024, (const u16*)(p.ws + OFF_WTGLU), 1024, 1024, brow, bcol, smem, acc);
  EPI_VARS;
  u16* Z = unitp(p, 1);
  EPI_BASE(1024, brow, bcol);
  EPI_LOOP {
    float bb = p.b_glu[bcol + wc * 64 + n * 16 + fr];
#pragma unroll
    for (int j = 0; j < 4; ++j) {
      int gi = idx0 + (m * 16 + j) * 1024 + n * 16;
      Z[gi] = f2bf(bf2f(Y[gi]) * sigmoidf_(acc[m][n][j] + bb));
    }
  }
}
constexpr int NJ4_A = T / 4, NJ4 = NJ4_A + 133 * 8;

DI void phase5(const P& p, int job, char* smem) {
  const int pm = job >> 3, pn = job & 7;
  const int brow = pm * 128, bcol = pn * 128;
  EPI_VARS;
  u16* MX = unitp(p, 3);
#pragma unroll 1
  for (int pass = 0; pass < 2; ++pass) {
    f32x4 acc[4][4];
    ZERO_ACC(acc);
    gemm_core(unitp(p, pass ? 1 : 2), 1024, (const u16*)(p.ws + (pass ? OFF_WTB : OFF_WTA)), 1024, 1024, brow, bcol,
              smem, acc);
    const u16* GT = unitp(p, 6 + pass);
    EPI_BASE(1024, brow, bcol);
    EPI_LOOP {
#pragma unroll
      for (int j = 0; j < 4; ++j) {
        int gi = idx0 + (m * 16 + j) * 1024 + n * 16;
        float prev = pass ? bf2f(MX[gi]) : 0.f;
        MX[gi] = f2bf(prev + acc[m][n][j] * bf2f(GT[gi]));
      }
    }
  }
}
constexpr int NJ5 = 133 * 8;

DI void phase6(const P& p, int job, char* smem) {
  const int pm = job >> 3, pn = job & 7;
  const int brow = pm * 128, bcol = pn * 128;
  EPI_VARS;
  f32x4 acc[4][4];
  ZERO_ACC(acc);
  gemm_core(unitp(p, 3), 1024, (const u16*)(p.ws + OFF_WTOUT), 1024, 1024, brow, bcol, smem, acc);
  float* X1 = (float*)unitp(p, 0);
  int rb = brow + wr * 64 + fq * 4, cbv = bcol + wc * 64 + fr;
  asm volatile("" : "+v"(rb), "+v"(cbv));
#pragma unroll
  for (int m = 0; m < 4; ++m) {
#pragma unroll
    for (int j = 0; j < 4; ++j) {
      const int row = rb + m * 16 + j;
      const float* xr = xrow(p, row) + cbv;
      float* xo = X1 + (size_t)row * 1024 + cbv;
#pragma unroll
      for (int n = 0; n < 4; ++n) xo[n * 16] = xr[n * 16] + acc[m][n][j];
    }
  }
}
constexpr int NJ6 = 133 * 8;

DI void phase7(const P& p, int job) {
  int tk = job * 4 + (threadIdx.x >> 6);
  rms_row_to_bf16((const float*)unitp(p, 0) + (size_t)tk * 1024, p.norm2_w, unitp(p, 2) + (size_t)tk * 1024,
                  threadIdx.x & 63);
}
constexpr int NJ7 = T / 4;
DI void convert_tables(const P& p, int j) {
  const float* src = (j < 4096 ? p.peer_u : p.peer_v) + (size_t)(j & 4095) * 4096 + threadIdx.x * 16;
  const float sc = j < 4096 ? 64.f : 16.f;
  unsigned char* dst = (j < 4096 ? (unsigned char*)(p.ws + OFF_UT8) + (size_t)j * 4096
                                 : (unsigned char*)unitp(p, 6) + (size_t)(j - 4096) * 4096) + threadIdx.x * 16;
  unsigned w[4];
#pragma unroll
  for (int i = 0; i < 4; ++i) {
    float4 a = *(const float4*)(src + 4 * i);
    int d = __builtin_amdgcn_cvt_pk_fp8_f32(a.x * sc, a.y * sc, 0, false);
    d = __builtin_amdgcn_cvt_pk_fp8_f32(a.z * sc, a.w * sc, d, true);
    w[i] = (unsigned)d;
  }
  *(uint4*)dst = make_uint4(w[0], w[1], w[2], w[3]);
}

DI void phase8(const P& p, int job, char* smem) {
  const int pm = job >> 4, pn = job & 15;
  const int brow = pm * 128, bcol = pn * 128;
  EPI_VARS;
  f32x4 acc[4][4];
  ZERO_ACC(acc);
  gemm_core(unitp(p, 2), 1024, (const u16*)(p.ws + OFF_WTQ), 1024, 1024, brow, bcol, smem, acc);
  u16* Q = unitp(p, 3);
  EPI_BASE(2048, brow, bcol);
  EPI_LOOP {
#pragma unroll
    for (int j = 0; j < 4; ++j) Q[idx0 + (m * 16 + j) * 2048 + n * 16] = f2bf(acc[m][n][j]);
  }
}
constexpr int NJ8 = 133 * 16;

DI int f2key(float f) { int s = __float_as_int(f); return s ^ ((s >> 31) & 0x7fffffff); }
DI float key2f(int k) { return __int_as_float(k ^ ((k >> 31) & 0x7fffffff)); }
DI int rowmax16(int x) {
  x = max(x, __builtin_amdgcn_update_dpp(0, x, 0x128, 0xf, 0xf, false));
  x = max(x, __builtin_amdgcn_update_dpp(0, x, 0x124, 0xf, 0xf, false));
  x = max(x, __builtin_amdgcn_update_dpp(0, x, 0x122, 0xf, 0xf, false));
  x = max(x, __builtin_amdgcn_update_dpp(0, x, 0x121, 0xf, 0xf, false));
  return x;
}
DI void phase9(const P& p, int job) {
  const int tid = threadIdx.x, wave = tid >> 6, lane = tid & 63, fr = lane & 15, fq = lane >> 4;
  const int tile = job >> 1, h = (job & 1) * 4 + wave;
  const int tok0 = tile * 16;
  const u16* QRY = unitp(p, 3);
  int* EXPI = (int*)unitp(p, 5);
  float* GATE = (float*)((char*)unitp(p, 5) + (size_t)T * 128 * 4);
  float v12[2][4];
  int i12[2][4];
#pragma unroll
  for (int half = 0; half < 2; ++half) {
    f32x4 acc[8];
#pragma unroll
    for (int nt = 0; nt < 8; ++nt) acc[nt] = f32x4{0.f, 0.f, 0.f, 0.f};
    const u16* Kb = (const u16*)(p.ws + (half ? OFF_K2 : OFF_K1)) + (size_t)h * 128 * 128;
#pragma unroll
    for (int ks = 0; ks < 4; ++ks) {
      s16x8 a = *(const s16x8*)(QRY + (size_t)(tok0 + fr) * 2048 + h * 256 + half * 128 + ks * 32 + fq * 8);
#pragma unroll
      for (int nt = 0; nt < 8; ++nt) {
        s16x8 b = *(const s16x8*)(Kb + (size_t)(nt * 16 + fr) * 128 + ks * 32 + fq * 8);
        acc[nt] = mfma32(a, b, acc[nt]);
      }
    }
    asm volatile("s_nop 15\n\ts_nop 15" : "+v"(acc[0]), "+v"(acc[1]), "+v"(acc[2]), "+v"(acc[3]), "+v"(acc[4]), "+v"(acc[5]), "+v"(acc[6]), "+v"(acc[7]));
#pragma unroll
    for (int j = 0; j < 4; ++j) {
      int keys[8];
#pragma unroll
      for (int nt = 0; nt < 8; ++nt) keys[nt] = (f2key(acc[nt][j]) & ~127) | (127 - (nt * 16 + fr));
#define CX(a, b) { int hi_ = max(keys[a], keys[b]), lo_ = min(keys[a], keys[b]); keys[a] = hi_; keys[b] = lo_; }
      CX(0, 1) CX(2, 3) CX(4, 5) CX(6, 7)
      CX(0, 2) CX(1, 3) CX(4, 6) CX(5, 7)
      CX(1, 2) CX(5, 6)
      CX(0, 4) CX(1, 5) CX(2, 6) CX(3, 7)
      CX(2, 4) CX(3, 5)
      CX(1, 2) CX(3, 4) CX(5, 6)
#undef CX
      int mine = 0;
      for (int r = 0; r < 16; ++r) {
        int wk = rowmax16(keys[0]);
        if (fr == r) mine = wk;
        if (keys[0] == wk) {
#pragma unroll
          for (int nt = 0; nt < 7; ++nt) keys[nt] = keys[nt + 1];
          keys[7] = (int)0x80000000;
        }
      }
      v12[half][j] = key2f(mine & ~127);
      i12[half][j] = 127 - (mine & 127);
    }
  }
#pragma unroll
  for (int j = 0; j < 4; ++j) {
    const float v1 = v12[0][j], v2 = v12[1][j];
    const int e1 = i12[0][j], e2 = i12[1][j];
    int ptr = 0;
    float sc = 0.f;
    int ex = 0;
    const int gbase = lane & ~15;
    for (int r = 0; r < 16; ++r) {
      int pc = min(ptr, 15);
      float v2p = __shfl(v2, gbase + pc);
      int e2p = __shfl(e2, gbase + pc);
      int key = ptr < 16 ? ((f2key(v1 + v2p) & ~255) | (255 - (fr * 16 + ptr))) : (int)0x80000000;
      int wk = rowmax16(key);
      int pos = 255 - (wk & 255);
      int wi = pos >> 4;
      int myexp = e1 * 128 + e2p;
      int wexp = __shfl(myexp, gbase + wi);
      if (fr == r) { sc = key2f(wk & ~255); ex = wexp; }
      if (fr == wi) ptr++;
    }
    float mx = sc;
    mx = fmaxf(mx, __shfl_xor(mx, 1));
    mx = fmaxf(mx, __shfl_xor(mx, 2));
    mx = fmaxf(mx, __shfl_xor(mx, 4));
    mx = fmaxf(mx, __shfl_xor(mx, 8));
    float e = __expf(sc - mx);
    float sm = e;
    sm += __shfl_xor(sm, 1);
    sm += __shfl_xor(sm, 2);
    sm += __shfl_xor(sm, 4);
    sm += __shfl_xor(sm, 8);
    size_t oi = (size_t)(tok0 + 4 * fq + j) * 128 + h * 16 + fr;
    EXPI[oi] = ex;
    GATE[oi] = e / sm;
  }
}
constexpr int NJ9 = 1064 * 2;

typedef float f32x2v __attribute__((ext_vector_type(2)));
DI void unpack16(const uint4& a, float (&x)[16]) {
  const unsigned w[4] = {a.x, a.y, a.z, a.w};
#pragma unroll
  for (int i = 0; i < 4; ++i) {
    f32x2v lo = __builtin_amdgcn_cvt_pk_f32_fp8((int)w[i], false);
    f32x2v hi = __builtin_amdgcn_cvt_pk_f32_fp8((int)w[i], true);
    x[4 * i] = lo[0]; x[4 * i + 1] = lo[1]; x[4 * i + 2] = hi[0]; x[4 * i + 3] = hi[1];
  }
}
#define LANE_OF(k) ((((k) >> 3) & 1) * 32 + (((k) >> 2) & 1) * 16 + (((k) >> 1) & 1) * 8 + ((k)&1) * 4)
DI void phase10(const P& p, int job) {
  const int lane = threadIdx.x & 63;
  const int tk = job * 4 + (threadIdx.x >> 6);
  float* dst;
  if (tk < TP) {
    int n = tk / LP, l = tk - n * LP;
    if (l < 16) return;
    dst = p.out + O_YP + ((size_t)n * 2048 + (l - 16)) * 1024;
  } else {
    dst = p.out + O_YS + (size_t)(tk - TP) * 1024;
  }
  const float* X1 = (const float*)unitp(p, 0) + (size_t)tk * 1024;
  const u16* H2 = unitp(p, 2) + (size_t)tk * 1024;
  const int* EXPI = (const int*)unitp(p, 5) + (size_t)tk * 128;
  const float* GATE = (const float*)((const char*)unitp(p, 5) + (size_t)T * 128 * 4) + (size_t)tk * 128;
  const unsigned char* UT = (const unsigned char*)(p.ws + OFF_UT8);
  const unsigned char* VTB = (const unsigned char*)unitp(p, 6);
  float hv[16];
  {
    uint4 a = *(const uint4*)(H2 + lane * 16), b = *(const uint4*)(H2 + lane * 16 + 8);
    hv[0] = bflo(a.x); hv[1] = bfhi(a.x); hv[2] = bflo(a.y); hv[3] = bfhi(a.y);
    hv[4] = bflo(a.z); hv[5] = bfhi(a.z); hv[6] = bflo(a.w); hv[7] = bfhi(a.w);
    hv[8] = bflo(b.x); hv[9] = bfhi(b.x); hv[10] = bflo(b.y); hv[11] = bfhi(b.y);
    hv[12] = bflo(b.z); hv[13] = bfhi(b.z); hv[14] = bflo(b.w); hv[15] = bfhi(b.w);
  }
  float ov[16];
#pragma unroll
  for (int i = 0; i < 16; ++i) ov[i] = 0.f;
  const int kmine = ((lane >> 5) & 1) * 8 + ((lane >> 4) & 1) * 4 + ((lane >> 3) & 1) * 2 + ((lane >> 2) & 1);
  const bool b5 = lane & 32, b4 = lane & 16, b3 = lane & 8, b2 = lane & 4;
  for (int h = 0; h < 8; ++h) {
    const int e_l = EXPI[h * 16 + kmine];
    const float g_l = GATE[h * 16 + kmine];
    float part[16];
#pragma unroll
    for (int k = 0; k < 16; ++k) {
      int e = __builtin_amdgcn_readlane(e_l, LANE_OF(k));
      uint4 a = *(const uint4*)(UT + (size_t)e * 1024 + lane * 16);
      float x[16];
      unpack16(a, x);
      float d = 0.f;
#pragma unroll
      for (int i = 0; i < 16; ++i) d += x[i] * hv[i];
      part[k] = d;
    }
    float r8[8], r4[4], r2[2];
#pragma unroll
    for (int i = 0; i < 8; ++i) {
      float send = b5 ? part[i] : part[i + 8], keep = b5 ? part[i + 8] : part[i];
      r8[i] = keep + __shfl_xor(send, 32);
    }
#pragma unroll
    for (int i = 0; i < 4; ++i) {
      float send = b4 ? r8[i] : r8[i + 4], keep = b4 ? r8[i + 4] : r8[i];
      r4[i] = keep + __shfl_xor(send, 16);
    }
#pragma unroll
    for (int i = 0; i < 2; ++i) {
      float send = b3 ? r4[i] : r4[i + 2], keep = b3 ? r4[i + 2] : r4[i];
      r2[i] = keep + __shfl_xor(send, 8);
    }
    float d;
    {
      float send = b2 ? r2[0] : r2[1], keep = b2 ? r2[1] : r2[0];
      d = keep + __shfl_xor(send, 4);
    }
    d += __shfl_xor(d, 2);
    d += __shfl_xor(d, 1);
    const float w_l = g_l * geluf_(d * (1.f / 64.f)) * (1.f / 16.f);
#pragma unroll
    for (int k = 0; k < 16; ++k) {
      int e = __builtin_amdgcn_readlane(e_l, LANE_OF(k));
      float w = __builtin_bit_cast(float, __builtin_amdgcn_readlane(__builtin_bit_cast(int, w_l), LANE_OF(k)));
      uint4 a = *(const uint4*)(VTB + (size_t)e * 1024 + lane * 16);
      float x[16];
      unpack16(a, x);
#pragma unroll
      for (int i = 0; i < 16; ++i) ov[i] += w * x[i];
    }
  }
  float ss = 0.f;
#pragma unroll
  for (int i = 0; i < 4; ++i) {
    float4 x = *(const float4*)(X1 + lane * 16 + i * 4);
    ov[4 * i] += x.x; ov[4 * i + 1] += x.y; ov[4 * i + 2] += x.z; ov[4 * i + 3] += x.w;
    ss += ov[4 * i] * ov[4 * i] + ov[4 * i + 1] * ov[4 * i + 1] + ov[4 * i + 2] * ov[4 * i + 2] + ov[4 * i + 3] * ov[4 * i + 3];
  }
  ss = wave_sum(ss);
  const float rs = rsqrtf(ss * (1.f / 1024.f) + EPS);
#pragma unroll
  for (int i = 0; i < 4; ++i) {
    int eo = lane * 16 + i * 4;
    float4 w = *(const float4*)(p.final_w + eo);
    *(float4*)(dst + eo) =
        make_float4(ov[4 * i] * rs * w.x, ov[4 * i + 1] * rs * w.y, ov[4 * i + 2] * rs * w.z, ov[4 * i + 3] * rs * w.w);
  }
}
constexpr int NJ10 = T / 4;


#define XB_TMO      128
#define XB_XCNT(j)  (256  + 64 * (j))
#define XB_XSUB(j)  (1280 + 64 * (j))
#define XB_XGEN(j)  (2304 + 64 * (j))
#define XB_TOP      3328
#define XB_TOPGEN   3392
#define XCD_BAR_WORDS 3456
#define XB_SPIN_CAP (1u << 18)
#define LAS __attribute__((address_space(3)))

__device__ __forceinline__ unsigned xb_ld(unsigned* p)              { return __hip_atomic_load(p, __ATOMIC_RELAXED, __HIP_MEMORY_SCOPE_AGENT); }
__device__ __forceinline__ unsigned xb_add(unsigned* p, unsigned v) { return __hip_atomic_fetch_add(p, v, __ATOMIC_RELAXED, __HIP_MEMORY_SCOPE_AGENT); }
__device__ __forceinline__ unsigned xb_xcc_id() { return (unsigned)__builtin_amdgcn_s_getreg((3 << 11) | 20) & 0xFu; }
#define XB_SPIN(cond, bar) do { unsigned _sp = 0; while (cond) { __builtin_amdgcn_s_sleep(1); \
    if ((++_sp & 255u) == 0u) { if (xb_ld(&(bar)[XB_TMO])) break; if (_sp > XB_SPIN_CAP) { atomicAdd(&(bar)[XB_TMO], 1u); break; } } } } while (0)

struct XcdBarrier {
    unsigned* bar; unsigned x;
    volatile LAS unsigned* st;
};

__device__ __forceinline__ XcdBarrier xcd_barrier_post(unsigned* bar, volatile LAS unsigned* st) {
    XcdBarrier b; b.bar = bar; b.x = xb_xcc_id(); b.st = st;
    if (threadIdx.x == 0) (void)xb_add(&bar[XB_XCNT(b.x)], 1u);
    return b;
}
__device__ __forceinline__ void xcd_barrier_complete(unsigned* bar, unsigned x, unsigned& nloc, unsigned& nx) {
    const unsigned G = gridDim.x * gridDim.y * gridDim.z;
    unsigned sum, cnt, mine, sp = 0u;
    for (;;) {
        sum = 0u; cnt = 0u; mine = 0u;
#pragma unroll
        for (unsigned j = 0; j < 16; ++j) { const unsigned c = xb_ld(&bar[XB_XCNT(j)]); sum += c; cnt += (c > 0u) ? 1u : 0u; mine = (j == x) ? c : mine; }
        if (sum == G) break;
        __builtin_amdgcn_s_sleep(1);
        if ((++sp & 255u) == 0u) { if (xb_ld(&bar[XB_TMO])) break; if (sp > XB_SPIN_CAP) { atomicAdd(&bar[XB_TMO], 1u); break; } }
    }
    nloc = mine > 0u ? mine : 1u; nx = cnt > 0u ? cnt : 1u;
}

__device__ __forceinline__ void xcd_barrier(const XcdBarrier& b) {
    asm volatile("s_waitcnt vmcnt(0)" ::: "memory");
    __syncthreads();
    if (threadIdx.x == 0) {
        unsigned* bar = b.bar;
        __builtin_amdgcn_s_waitcnt(0);
        unsigned nloc = b.st[0], nx = b.st[1];
        if (nloc == 0u) { xcd_barrier_complete(bar, b.x, nloc, nx); b.st[0] = nloc; b.st[1] = nx; }
        const unsigned old = xb_add(&bar[XB_XSUB(b.x)], 1u);
        const unsigned gen = old / nloc;
        if (old + 1u == (gen + 1u) * nloc) {
            __builtin_amdgcn_fence(__ATOMIC_RELEASE, "agent");
            asm volatile("s_waitcnt vmcnt(0)" ::: "memory");
            const unsigned og = xb_add(&bar[XB_TOP], 1u);
            const unsigned tg = og / nx;
            if (og + 1u == (tg + 1u) * nx) xb_add(&bar[XB_TOPGEN], 1u);
            else XB_SPIN(xb_ld(&bar[XB_TOPGEN]) == tg, bar);
            __builtin_amdgcn_fence(__ATOMIC_ACQUIRE, "agent");
            xb_add(&bar[XB_XGEN(b.x)], 1u);
            asm volatile("s_waitcnt vmcnt(0)" ::: "memory");
        } else {
            XB_SPIN(xb_ld(&bar[XB_XGEN(b.x)]) == gen, bar);
            __builtin_amdgcn_fence(__ATOMIC_ACQUIRE, "agent");
            asm volatile("s_waitcnt vmcnt(0)" ::: "memory");
        }
    }
    __syncthreads();
}


DI void my_sync(unsigned* bar, unsigned target) {
  asm volatile("s_waitcnt vmcnt(0)" ::: "memory");
  __syncthreads();
  if (threadIdx.x == 0) {
    __builtin_amdgcn_fence(__ATOMIC_RELEASE, "agent");
    asm volatile("s_waitcnt vmcnt(0)" ::: "memory");
    __hip_atomic_fetch_add(bar, 1u, __ATOMIC_RELAXED, __HIP_MEMORY_SCOPE_AGENT);
    while (__hip_atomic_load(bar, __ATOMIC_RELAXED, __HIP_MEMORY_SCOPE_AGENT) < target) __builtin_amdgcn_s_sleep(2);
    __builtin_amdgcn_fence(__ATOMIC_ACQUIRE, "agent");
    asm volatile("s_waitcnt vmcnt(0)" ::: "memory");
  }
  __syncthreads();
}
__global__ void __launch_bounds__(256, 2) mega(P p, int ph_lo, int ph_hi) {
  __shared__ __attribute__((aligned(16))) char smem[SMEM_BYTES];
  cg::grid_group grid = cg::this_grid();
  const int G = gridDim.x, B = blockIdx.x;
#define RUN_PHASE(n) if ((ONLY < 0 || ONLY == n) && ph_lo <= n && n < ph_hi)
  __shared__ uint4 xb_words;
  if (threadIdx.x == 0) xb_words = make_uint4(0u, 0u, 0u, 0u);
  __syncthreads();
  XcdBarrier xb = xcd_barrier_post((unsigned*)(p.ws + OFF_BAR), (volatile LAS unsigned*)&xb_words);
  if (ph_hi > 1000) grid.sync();
#define SYNC_IF(n) if (n > ph_lo) { xcd_barrier(xb); }
  RUN_PHASE(0) {
    for (int j = B; j < NJ0 - 1536; j += G) phase0(p, j < 1792 ? j : j + 1536, smem); }
  RUN_PHASE(1) { SYNC_IF(1) for (int j = B; j < NJ1; j += G) phase1(p, j, smem); }
  RUN_PHASE(2) { SYNC_IF(2)
    for (int j = B; j < NJ2_H; j += G) p2_hgrn_pre(p, j, smem); }
  RUN_PHASE(3) { SYNC_IF(3)
    if (B < NJ3_A) p3_hgrn_seq(p, B, smem);
    else if (B < NJ3_A + NJ3_CH) p3_s5chain(p, B - NJ3_A, smem);
    else for (int j = B - (NJ3_A + NJ3_CH); j < NJ3_REST + 1536; j += G - (NJ3_A + NJ3_CH)) {
      if (j < NJ3_REST) phase3rest(p, j, smem); else phase0(p, 1792 + (j - NJ3_REST), smem); } }
  RUN_PHASE(4) { SYNC_IF(4)
    for (int j = B; j < 1064; j += G) p4_glu(p, j, smem);
    { const int extra = 1064 % G;
      if (B >= extra) for (int j = B - extra; j < NJ4_A; j += G - extra) p4_onorm(p, j); } }
  RUN_PHASE(5) { SYNC_IF(5) for (int j = B; j < NJ5; j += G) phase5(p, j, smem);
    { const int extra = NJ5 % G;
      if (B >= extra) for (int j = B - extra; j < 4096; j += G - extra) convert_tables(p, j); } }
  RUN_PHASE(6) { SYNC_IF(6) for (int j = B; j < NJ6; j += G) phase6(p, j, smem);
    { const int extra = NJ6 % G;
      if (B >= extra) for (int j = 4096 + B - extra; j < 8192; j += G - extra) convert_tables(p, j); } }
  RUN_PHASE(7) { SYNC_IF(7) for (int j = B; j < NJ7; j += G) phase7(p, j); }
  RUN_PHASE(8) { SYNC_IF(8) for (int j = B; j < NJ8; j += G) phase8(p, j, smem); }
  RUN_PHASE(9) { SYNC_IF(9) for (int j = B; j < NJ9; j += G) phase9(p, j); }
  RUN_PHASE(10) { SYNC_IF(10) for (int j = B; j < NJ10; j += G) phase10(p, j); }
}

extern "C" void kernel_launch(void* const* d_in, const int* in_sizes, int n_in, void* d_out, int out_size, void* d_ws,
                              size_t ws_size, hipStream_t stream) {
  static int grid_blocks = 0;
  if (!grid_blocks) {
    int dev = 0, cus = 0, per_cu = 0;
    hipGetDevice(&dev);
    hipDeviceGetAttribute(&cus, hipDeviceAttributeMultiprocessorCount, dev);
    hipOccupancyMaxActiveBlocksPerMultiprocessor(&per_cu, mega, 256, 0);
    if (per_cu < 1) per_cu = 1;
    grid_blocks = cus * per_cu;
  }
  P p{};
  const float** pf = (const float**)&p;
  for (int i = 0; i < 30; ++i) pf[i] = (const float*)d_in[i];
  p.out = (float*)d_out;
  p.ws = (char*)d_ws;
#if SINGLE_LAUNCH
  hipMemsetAsync((char*)d_ws + OFF_BAR, 0, XCD_BAR_WORDS * sizeof(unsigned), stream);
  int lo = 0, hi = 11;
  void* args[] = {&p, &lo, &hi};
  hipError_t e = hipLaunchCooperativeKernel((void*)mega, dim3(grid_blocks), dim3(256), args, 0, stream);
  if (e != hipSuccess) fprintf(stderr, "cooperative launch failed: %s (grid %d)\n", hipGetErrorString(e), grid_blocks);
#else
  for (int ph = 0; ph < 11; ++ph) hipLaunchKernelGGL(mega, dim3(grid_blocks), dim3(256), 0, stream, p, ph, ph + 1);
#endif
}
```

```cpp
#include <hip/hip_runtime.h>
#include <hip/hip_cooperative_groups.h>
#include <cstdio>
namespace cg = cooperative_groups;

#define DI __device__ __forceinline__
typedef unsigned short u16;
typedef short s16x4 __attribute__((ext_vector_type(4)));
typedef short s16x8 __attribute__((ext_vector_type(8)));
typedef float f32x4 __attribute__((ext_vector_type(4)));
typedef __bf16 bf16x2_t __attribute__((ext_vector_type(2)));
typedef float f32x2_t __attribute__((ext_vector_type(2)));

#ifndef SINGLE_LAUNCH
#define SINGLE_LAUNCH 1
#endif

constexpr int T = 17024, TP = 16512, LP = 2064, NCHK = 129;
constexpr float EPS = 1e-6f;
#ifndef ONLY
#define ONLY -1
#endif
constexpr size_t UNIT = (size_t)T * 1024 * 2;
constexpr size_t OFF_WTIN = 0;
constexpr size_t OFF_WTGLU = OFF_WTIN + (size_t)7168 * 1024 * 2;
constexpr size_t OFF_WTA = OFF_WTGLU + 2097152;
constexpr size_t OFF_WTB = OFF_WTA + 2097152;
constexpr size_t OFF_WTOUT = OFF_WTB + 2097152;
constexpr size_t OFF_WTQ = OFF_WTOUT + 2097152;
constexpr size_t OFF_K1 = OFF_WTQ + 4194304;
constexpr size_t OFF_K2 = OFF_K1 + 262144;
constexpr size_t OFF_LB = OFF_K2 + 262144;
constexpr size_t OFF_ABAR = OFF_LB + 4096;
constexpr size_t OFF_APOW = OFF_ABAR + 32768;
constexpr size_t OFF_BBAR = OFF_APOW + 32768;
constexpr size_t OFF_UNITS = OFF_BBAR + 524288;
constexpr size_t OFF_BAR = OFF_UNITS + 8 * ((size_t)17024 * 1024 * 2);
constexpr size_t OFF_UT8 = OFF_BAR + 65536;
constexpr size_t OOFF_KTT = 0;
constexpr size_t OOFF_DEC = UNIT;
constexpr size_t OOFF_E = OOFF_DEC + (size_t)1032 * 1024 * 4;
constexpr size_t O_YP = 0, O_YS = 16777216, O_HGP = 17301504, O_SRP = 18350080, O_SIP = 18382848,
                 O_HGS = 18415616, O_SRS = 35192832, O_SIS = 35717120;
constexpr int SMEM_BYTES = 65536;

struct P {
  const float *x_prompt, *x_sample, *state_hgrn, *ssm_re, *ssm_im, *meta, *lower_bounds, *norm1_w, *w_in, *g_norm_w,
      *a_re, *a_im, *log_step, *b_re, *b_im, *c_re, *c_im, *ssm_d, *w_glu, *b_glu, *w_a, *w_b, *w_out, *norm2_w,
      *peer_wq, *k1, *k2, *peer_u, *peer_v, *final_w;
  float* out;
  char* ws;
};

DI unsigned pack2(float a, float b) {
  f32x2_t v = {a, b};
  bf16x2_t r = __builtin_convertvector(v, bf16x2_t);
  return __builtin_bit_cast(unsigned, r);
}
DI u16 f2bf(float a) { return (u16)(pack2(a, 0.f) & 0xffffu); }
DI float bf2f(u16 v) { return __uint_as_float(((unsigned)v) << 16); }
DI float bflo(unsigned v) { return __uint_as_float(v << 16); }
DI float bfhi(unsigned v) { return __uint_as_float(v & 0xffff0000u); }
DI f32x4 mfma32(s16x8 a, s16x8 b, f32x4 c) { return __builtin_amdgcn_mfma_f32_16x16x32_bf16(a, b, c, 0, 0, 0); }
DI f32x4 mfma16(s16x4 a, s16x4 b, f32x4 c) { return __builtin_amdgcn_mfma_f32_16x16x16bf16_1k(a, b, c, 0, 0, 0); }
DI float wave_sum(float v) {
#pragma unroll
  for (int o = 32; o >= 1; o >>= 1) v += __shfl_xor(v, o);
  return v;
}
DI float sigmoidf_(float x) { return 1.f / (1.f + __expf(-x)); }
DI float siluf_(float x) { return x / (1.f + __expf(-x)); }
DI float geluf_(float x) { return 0.5f * x * (1.f + erff(x * 0.70710678118654752f)); }
DI s16x4 pack4(f32x4 v) {
  unsigned a = pack2(v[0], v[1]), b = pack2(v[2], v[3]);
  uint2 u = make_uint2(a, b);
  return __builtin_bit_cast(s16x4, u);
}
DI s16x8 pack8(f32x4 x, f32x4 y) {
  uint4 u = make_uint4(pack2(x[0], x[1]), pack2(x[2], x[3]), pack2(y[0], y[1]), pack2(y[2], y[3]));
  return __builtin_bit_cast(s16x8, u);
}
DI u16* unitp(const P& p, int i) { return (u16*)(p.ws + OFF_UNITS + (size_t)i * UNIT); }
DI const float* xrow(const P& p, int tk) {
  if (tk < TP) {
    int n = tk / LP, l = tk - n * LP;
    return l < 16 ? p.meta + (size_t)l * 1024 : p.x_prompt + ((size_t)n * 2048 + (l - 16)) * 1024;
  }
  return p.x_sample + (size_t)(tk - TP) * 1024;
}

DI void gemm_core(const u16* __restrict__ A, int lda, const u16* __restrict__ Bt, int ldb, int K, int brow, int bcol,
                  char* smem, f32x4 (&acc)[4][4]) {
  const int tid = threadIdx.x, wave = tid >> 6, lane = tid & 63, wr = wave >> 1, wc = wave & 1, fr = lane & 15,
            fq = lane >> 4;
  const int r0 = tid >> 3, cj = tid & 7;
  const u16* ga = A + (size_t)(brow + r0) * lda + cj * 8;
  const u16* gb = Bt + (size_t)(bcol + r0) * ldb + cj * 8;
  const size_t sa = (size_t)32 * lda, sb = (size_t)32 * ldb;
  const int woff = r0 * 128 + ((cj ^ ((r0 >> 1) & 7)) << 4);
  uint4 xa0, xa1, xa2, xa3, xb0, xb1, xb2, xb3, ya0, ya1, ya2, ya3, yb0, yb1, yb2, yb3;
#define G_LOAD(S, kk)                                                                          \
  {                                                                                            \
    S##a0 = *(const uint4*)(ga + (kk) * 64);          S##b0 = *(const uint4*)(gb + (kk) * 64);            \
    S##a1 = *(const uint4*)(ga + sa + (kk) * 64);     S##b1 = *(const uint4*)(gb + sb + (kk) * 64);       \
    S##a2 = *(const uint4*)(ga + 2 * sa + (kk) * 64); S##b2 = *(const uint4*)(gb + 2 * sb + (kk) * 64);   \
    S##a3 = *(const uint4*)(ga + 3 * sa + (kk) * 64); S##b3 = *(const uint4*)(gb + 3 * sb + (kk) * 64);   \
  }
#define G_STORE(S, st)                                                                         \
  {                                                                                            \
    char* sp_ = smem + (st) * 32768 + woff;                                                    \
    *(uint4*)(sp_) = S##a0;         *(uint4*)(sp_ + 16384) = S##b0;                            \
    *(uint4*)(sp_ + 4096) = S##a1;  *(uint4*)(sp_ + 16384 + 4096) = S##b1;                     \
    *(uint4*)(sp_ + 8192) = S##a2;  *(uint4*)(sp_ + 16384 + 8192) = S##b2;                     \
    *(uint4*)(sp_ + 12288) = S##a3; *(uint4*)(sp_ + 16384 + 12288) = S##b3;                    \
  }
  const int arow = wr * 64 + fr, brow_l = wc * 64 + fr;
  const int sw = (fr >> 1) & 7;
  const int nk = K >> 6;
#define G_COMPUTE(st)                                                                          \
  {                                                                                            \
    const char* a = smem + (st) * 32768;                                                       \
    const char* b = a + 16384;                                                                 \
    _Pragma("unroll") for (int ks = 0; ks < 2; ++ks) {                                         \
      s16x8 af[4], bfr[4];                                                                     \
      const int co = (((ks * 4 + fq) ^ sw) << 4);                                              \
      _Pragma("unroll") for (int m = 0; m < 4; ++m) af[m] = *(const s16x8*)(a + (arow + m * 16) * 128 + co);     \
      _Pragma("unroll") for (int n = 0; n < 4; ++n) bfr[n] = *(const s16x8*)(b + (brow_l + n * 16) * 128 + co);  \
      _Pragma("unroll") for (int m = 0; m < 4; ++m)                                            \
      _Pragma("unroll") for (int n = 0; n < 4; ++n) acc[m][n] = mfma32(af[m], bfr[n], acc[m][n]);                \
    }                                                                                          \
  }
  G_LOAD(x, 0)
  G_STORE(x, 0)
  G_LOAD(y, 1)
  __syncthreads();
  for (int kt = 0; kt < nk; kt += 2) {
    if (kt + 2 < nk) G_LOAD(x, kt + 2)
    G_COMPUTE(0)
    G_STORE(y, 1)
    __syncthreads();
    if (kt + 3 < nk) G_LOAD(y, kt + 3)
    G_COMPUTE(1)
    if (kt + 2 < nk) G_STORE(x, 0)
    __syncthreads();
  }
#undef G_LOAD
#undef G_STORE
#undef G_COMPUTE
  asm volatile("s_nop 15\n\ts_nop 15" : "+v"(acc[0][0]), "+v"(acc[0][1]), "+v"(acc[0][2]), "+v"(acc[0][3]), "+v"(acc[1][0]), "+v"(acc[1][1]), "+v"(acc[1][2]), "+v"(acc[1][3]), "+v"(acc[2][0]), "+v"(acc[2][1]), "+v"(acc[2][2]), "+v"(acc[2][3]), "+v"(acc[3][0]), "+v"(acc[3][1]), "+v"(acc[3][2]), "+v"(acc[3][3]));
}
#define ZERO_ACC(acc)                              \
  _Pragma("unroll") for (int m = 0; m < 4; ++m)    \
  _Pragma("unroll") for (int n = 0; n < 4; ++n) acc[m][n] = f32x4{0.f, 0.f, 0.f, 0.f};
#define EPI_VARS                                                                                             \
  const int tid = threadIdx.x, wave = tid >> 6, lane = tid & 63, wr = wave >> 1, wc = wave & 1, fr = lane & 15, \
            fq = lane >> 4;
#define EPI_BASE(ld, rb, cbv)                                    \
  int tb_ = (wr * 64 + fq * 4) * (ld) + wc * 64 + fr;           \
  asm volatile("" : "+v"(tb_));                                 \
  const int idx0 = (rb) * (ld) + (cbv) + tb_;
#define EPI_LOOP                                 \
  _Pragma("unroll") for (int m = 0; m < 4; ++m)  \
  _Pragma("unroll") for (int n = 0; n < 4; ++n)

DI void p0_transpose(const float* __restrict__ W, int K, int N, u16* __restrict__ Wt, int tile, char* smem) {
  float* sm = (float*)smem;
  const int ntn = N >> 6;
  const int tk = tile / ntn, tn = tile - tk * ntn;
  const int tid = threadIdx.x;
  const int c = tid & 63, r0 = tid >> 6;
#pragma unroll
  for (int i = 0; i < 16; ++i) {
    int r = r0 + i * 4;
    sm[r * 65 + c] = W[(size_t)(tk * 64 + r) * N + tn * 64 + c];
  }
  __syncthreads();
  const int n = tid >> 2, ks = (tid & 3) * 16;
  unsigned o[8];
#pragma unroll
  for (int i = 0; i < 8; ++i) o[i] = pack2(sm[(ks + 2 * i) * 65 + n], sm[(ks + 2 * i + 1) * 65 + n]);
  uint4* dst = (uint4*)(Wt + (size_t)(tn * 64 + n) * K + tk * 64 + ks);
  dst[0] = make_uint4(o[0], o[1], o[2], o[3]);
  dst[1] = make_uint4(o[4], o[5], o[6], o[7]);
  __syncthreads();
}

DI void p0_convert(const float* __restrict__ src, u16* __restrict__ dst, int job) {
  size_t i = (size_t)job * 2048 + threadIdx.x * 8;
  float4 a = *(const float4*)(src + i), b = *(const float4*)(src + i + 4);
  *(uint4*)(dst + i) = make_uint4(pack2(a.x, a.y), pack2(a.z, a.w), pack2(b.x, b.y), pack2(b.z, b.w));
}

DI void p0_lb(const P& p) {
  float* LB = (float*)(p.ws + OFF_LB);
  for (int c = threadIdx.x; c < 1024; c += 256) {
    float a = p.lower_bounds[c], b = p.lower_bounds[1024 + c];
    LB[c] = 1.f / (1.f + expf(b - a));
  }
}

DI void p0_s5const(const P& p, int job) {
  int idx = job * 256 + threadIdx.x;
  int g = idx >> 6;
  float re = fminf(p.a_re[idx], -1e-4f), im = p.a_im[idx];
  float dl = expf(p.log_step[g]);
  float mag = expf(re * dl);
  float sn, cs;
  sincosf(im * dl, &sn, &cs);
  float ax = mag * cs, ay = mag * sn;
  float nx = ax - 1.f, ny = ay;
  float d2 = re * re + im * im;
  float cr = (nx * re + ny * im) / d2, ci = (ny * re - nx * im) / d2;
  float2* ABAR = (float2*)(p.ws + OFF_ABAR);
  float2* APOW = (float2*)(p.ws + OFF_APOW);
  float2* BBAR = (float2*)(p.ws + OFF_BBAR);
  ABAR[idx] = make_float2(ax, ay);
  float x = ax, y = ay, x16 = 0.f, y16 = 0.f;
#pragma unroll
  for (int i = 0; i < 5; ++i) {
    float nx2 = x * x - y * y, ny2 = 2.f * x * y;
    x = nx2; y = ny2;
    if (i == 3) { x16 = x; y16 = y; }
  }
  APOW[idx] = make_float2(x * x16 - y * y16, x * y16 + y * x16);
#pragma unroll
  for (int c = 0; c < 16; ++c) {
    float br = p.b_re[idx * 16 + c], bi = p.b_im[idx * 16 + c];
    BBAR[idx * 16 + c] = make_float2(cr * br - ci * bi, cr * bi + ci * br);
  }
}

DI void rms_row_to_bf16(const float* __restrict__ src, const float* __restrict__ w, u16* __restrict__ dst, int lane) {
  float4 v[4];
  float ss = 0.f;
#pragma unroll
  for (int i = 0; i < 4; ++i) {
    v[i] = *(const float4*)(src + i * 256 + lane * 4);
    ss += v[i].x * v[i].x + v[i].y * v[i].y + v[i].z * v[i].z + v[i].w * v[i].w;
  }
  ss = wave_sum(ss);
  float rs = rsqrtf(ss * (1.f / 1024.f) + EPS);
#pragma unroll
  for (int i = 0; i < 4; ++i) {
    float4 ww = *(const float4*)(w + i * 256 + lane * 4);
    uint2 o = make_uint2(pack2(v[i].x * rs * ww.x, v[i].y * rs * ww.y), pack2(v[i].z * rs * ww.z, v[i].w * rs * ww.w));
    *(uint2*)(dst + i * 256 + lane * 4) = o;
  }
}

DI void phase0(const P& p, int job, char* smem) {
  if (job < 1792) p0_transpose(p.w_in, 1024, 7168, (u16*)(p.ws + OFF_WTIN), job, smem);
  else if (job < 2048) p0_transpose(p.w_glu, 1024, 1024, (u16*)(p.ws + OFF_WTGLU), job - 1792, smem);
  else if (job < 2304) p0_transpose(p.w_a, 1024, 1024, (u16*)(p.ws + OFF_WTA), job - 2048, smem);
  else if (job < 2560) p0_transpose(p.w_b, 1024, 1024, (u16*)(p.ws + OFF_WTB), job - 2304, smem);
  else if (job < 2816) p0_transpose(p.w_out, 1024, 1024, (u16*)(p.ws + OFF_WTOUT), job - 2560, smem);
  else if (job < 3328) p0_transpose(p.peer_wq, 1024, 2048, (u16*)(p.ws + OFF_WTQ), job - 2816, smem);
  else if (job < 3392) p0_convert(p.k1, (u16*)(p.ws + OFF_K1), job - 3328);
  else if (job < 3456) p0_convert(p.k2, (u16*)(p.ws + OFF_K2), job - 3392);
  else if (job == 3456) p0_lb(p);
  else if (job < 3473) p0_s5const(p, job - 3457);
  else {
    int tk = (job - 3473) * 4 + (threadIdx.x >> 6);
    rms_row_to_bf16(xrow(p, tk), p.norm1_w, unitp(p, 0) + (size_t)tk * 1024, threadIdx.x & 63);
  }
}
constexpr int NJ0 = 3473 + T / 4;

DI void phase1(const P& p, int job, char* smem) {
  const int pm = job / 56, pn = job - pm * 56;
  const int brow = pm * 128, bcol = pn * 128;
  f32x4 acc[4][4];
  ZERO_ACC(acc);
  gemm_core(unitp(p, 0), 1024, (const u16*)(p.ws + OFF_WTIN), 1024, 1024, brow, bcol, smem, acc);
  EPI_VARS;
  const int region = pn >> 3;
  const int cbase = bcol - region * 1024;
  if (region == 2) {
    u16* VT = unitp(p, 3);
    int vb = ((brow >> 4) + wr * 4) * 16384 + (cbase + wc * 64 + fr) * 16 + fq * 4;
    asm volatile("" : "+v"(vb));
    EPI_LOOP { *(s16x4*)(VT + vb + m * 16384 + n * 256) = pack4(acc[m][n]); }
  } else {
    u16* dst = unitp(p, region == 0 ? 1 : region == 1 ? 2 : region + 1);
    EPI_BASE(1024, brow, cbase);
    EPI_LOOP {
#pragma unroll
      for (int j = 0; j < 4; ++j) {
        float v = acc[m][n][j];
        if (region == 0 || region == 3) v = siluf_(v);
        else if (region >= 5) v = sigmoidf_(v);
        dst[idx0 + (m * 16 + j) * 1024 + n * 16] = f2bf(v);
      }
    }
  }
}
constexpr int NJ1 = 133 * 56;

DI void p2_hgrn_pre(const P& p, int job, char* smem) {
  const int tid = threadIdx.x, wave = tid >> 6, lane = tid & 63, fr = lane & 15, fq = lane >> 4;
  const int chunk = job >> 1, h = (job & 1) * 4 + wave;
  const int tok0 = chunk * 16;
  u16* R1 = unitp(p, 1);
  const u16* R2 = unitp(p, 2);
  const u16* VT = unitp(p, 3);
  u16* OIN = unitp(p, 0);
  u16* KTT = (u16*)((char*)p.out + OOFF_KTT);
  float* DEC = (float*)((char*)p.out + OOFF_DEC);
  const float* LB = (const float*)(p.ws + OFF_LB);
  char* sq = smem + wave * 8704;
  char* sk = sq + 4352;
  const int c0 = h * 128 + lane * 2;
  const float lb0 = LB[c0], lb1 = LB[c0 + 1];
  float b0 = 0.f, b1 = 0.f;
  float kn0[16], kn1[16];
#pragma unroll
  for (int t = 0; t < 16; ++t) {
    size_t gi = (size_t)(tok0 + t) * 1024 + c0;
    unsigned q2 = *(const unsigned*)(R1 + gi), f2 = *(const unsigned*)(R2 + gi);
    float f0 = bflo(f2), f1 = bfhi(f2);
    float e0 = __expf(-f0), e1 = __expf(-f1);
    float fg0 = lb0 + (1.f - lb0) / (1.f + e0), fg1 = lb1 + (1.f - lb1) / (1.f + e1);
    float k0 = (1.f - lb0) * e0 / (1.f + e0), k1 = (1.f - lb1) * e1 / (1.f + e1);
    b0 += __logf(fg0);
    b1 += __logf(fg1);
    float qt0 = bflo(q2) * __expf(b0), qt1 = bfhi(q2) * __expf(b1);
    kn0[t] = k0 * __expf(-b0);
    kn1[t] = k1 * __expf(-b1);
    unsigned qp = pack2(qt0, qt1);
    *(unsigned*)(R1 + gi) = qp;
    *(unsigned*)(sq + t * 272 + lane * 4) = qp;
    *(unsigned*)(sk + t * 272 + lane * 4) = pack2(kn0[t], kn1[t]);
  }
  const float eb0 = __expf(b0), eb1 = __expf(b1);
  *(float2*)(DEC + (size_t)chunk * 1024 + c0) = make_float2(eb0, eb1);
  {
    unsigned w0[8], w1[8];
#pragma unroll
    for (int i = 0; i < 8; ++i) {
      w0[i] = pack2(kn0[2 * i] * eb0, kn0[2 * i + 1] * eb0);
      w1[i] = pack2(kn1[2 * i] * eb1, kn1[2 * i + 1] * eb1);
    }
    uint4* kd = (uint4*)(KTT + ((size_t)chunk * 1024 + c0) * 16);
    kd[0] = make_uint4(w0[0], w0[1], w0[2], w0[3]);
    kd[1] = make_uint4(w0[4], w0[5], w0[6], w0[7]);
    kd[2] = make_uint4(w1[0], w1[1], w1[2], w1[3]);
    kd[3] = make_uint4(w1[4], w1[5], w1[6], w1[7]);
  }
  __syncthreads();
  f32x4 at = {0.f, 0.f, 0.f, 0.f};
#pragma unroll
  for (int ks = 0; ks < 4; ++ks) {
    s16x8 a = *(const s16x8*)(sk + fr * 272 + ks * 64 + fq * 16);
    s16x8 b = *(const s16x8*)(sq + fr * 272 + ks * 64 + fq * 16);
    at = mfma32(a, b, at);
  }
  asm volatile("s_nop 15\n\ts_nop 15" : "+v"(at));
#pragma unroll
  for (int j = 0; j < 4; ++j)
    if (4 * fq + j > fr) at[j] = 0.f;
  s16x4 af = pack4(at);
  asm volatile("s_nop 7" : "+v"(af));
#pragma unroll
  for (int nt = 0; nt < 8; ++nt) {
    size_t vi = ((size_t)chunk * 1024 + h * 128 + nt * 16 + fr) * 16 + 4 * fq;
    s16x4 vb = *(const s16x4*)(VT + vi);
    f32x4 o = mfma16(af, vb, f32x4{0.f, 0.f, 0.f, 0.f});
    asm volatile("s_nop 15\n\ts_nop 15" : "+v"(o));
    *(s16x4*)(OIN + vi) = pack4(o);
  }
  __syncthreads();
}

DI void s5_load_bbar(const P& p, int g, int pp, float (&br)[16], float (&bi)[16]) {
  const float4* B = (const float4*)((const float2*)(p.ws + OFF_BBAR) + ((size_t)g * 64 + pp) * 16);
#pragma unroll
  for (int i = 0; i < 8; ++i) {
    float4 v = B[i];
    br[2 * i] = v.x; bi[2 * i] = v.y; br[2 * i + 1] = v.z; bi[2 * i + 1] = v.w;
  }
}
DI void s5_step(const uint4& ua, const uint4& ub, int t, const float (&br)[16], const float (&bi)[16], float ax, float ay,
                float& xr, float& xi) {
  unsigned uu[8] = {(unsigned)__builtin_amdgcn_readlane((int)ua.x, t), (unsigned)__builtin_amdgcn_readlane((int)ua.y, t),
                    (unsigned)__builtin_amdgcn_readlane((int)ua.z, t), (unsigned)__builtin_amdgcn_readlane((int)ua.w, t),
                    (unsigned)__builtin_amdgcn_readlane((int)ub.x, t), (unsigned)__builtin_amdgcn_readlane((int)ub.y, t),
                    (unsigned)__builtin_amdgcn_readlane((int)ub.z, t), (unsigned)__builtin_amdgcn_readlane((int)ub.w, t)};
  float sr = 0.f, si = 0.f;
#pragma unroll
  for (int i = 0; i < 8; ++i) {
    float a = bflo(uu[i]), b = bfhi(uu[i]);
    sr += br[2 * i] * a + br[2 * i + 1] * b;
    si += bi[2 * i] * a + bi[2 * i + 1] * b;
  }
  float nr = ax * xr - ay * xi + sr, ni = ax * xi + ay * xr + si;
  xr = nr; xi = ni;
}

DI void p2_s5a(const P& p, int job) {
  const int gq = job & 15, nc = job >> 4;
  const int n = nc / 43, c = nc - n * 43;
  const int tid = threadIdx.x, g = gq * 4 + (tid >> 6), pp = tid & 63;
  float br[16], bi[16];
  s5_load_bbar(p, g, pp, br, bi);
  const float2 ab = ((const float2*)(p.ws + OFF_ABAR))[g * 64 + pp];
  const u16* U = unitp(p, 5) + (size_t)(n * LP + c * 48) * 1024 + g * 16;
  float xr = 0.f, xi = 0.f;
  uint4 ua, ub;
  {
    const u16* r = U + (size_t)min(pp, 47) * 1024;
    ua = *(const uint4*)r;
    ub = *(const uint4*)(r + 8);
  }
#pragma unroll 4
  for (int t = 0; t < 48; ++t) s5_step(ua, ub, t, br, bi, ab.x, ab.y, xr, xi);
  float2* E = (float2*)((char*)p.out + OOFF_E);
  E[((size_t)(n * 43 + c) * 64 + g) * 64 + pp] = make_float2(xr, xi);
}
constexpr int NJ2_H = 2064, NJ2_S = 8 * 43 * 16;
constexpr int NJ2 = NJ2_H + NJ2_S;

#define SEQ_GLOAD(cg_, P)                                                                              \
  {                                                                                                    \
    const int cgv = (cg_);                                                                             \
    P##rq = *(const uint4*)(QT + (size_t)(cgv * 16 + (tid >> 4)) * 1024 + h * 128 + (tid & 15) * 8);  \
    P##rk = *(const uint4*)(KTT + ((size_t)cgv * 1024 + h * 128) * 16 + tid * 8);                      \
    if (tid < 32) P##rd = *(const float4*)(DEC + (size_t)cgv * 1024 + h * 128 + tid * 4);              \
    size_t vi0 = ((size_t)cgv * 1024 + h * 128 + wave * 32 + fr) * 16 + 4 * fq;                        \
    P##rv0 = *(const s16x4*)(VT + vi0);                                                                \
    P##rv1 = *(const s16x4*)(VT + vi0 + 256);                                                          \
    P##ro0 = *(const s16x4*)(OIN + vi0);                                                               \
    P##ro1 = *(const s16x4*)(OIN + vi0 + 256);                                                         \
  }
#define SEQ_LSTORE(b_, P)                                                  \
  {                                                                        \
    char* lb_ = smem + (b_) * 8960;                                        \
    *(uint4*)(lb_ + (tid >> 4) * 272 + (tid & 15) * 16) = P##rq;           \
    *(uint4*)(lb_ + 4352 + tid * 16) = P##rk;                              \
    if (tid < 32) *(float4*)(lb_ + 8448 + tid * 16) = P##rd;               \
  }
#define SEQ_BODY(c_, X, Y)                                                                                   \
  {                                                                                                          \
    const int c = (c_);                                                                                      \
    const int b = c & 1;                                                                                     \
    const int tok0 = (cg0 + c) * 16;                                                                         \
    if (c + 2 < NCHK) SEQ_GLOAD(cg0 + c + 2, X)                                                              \
    const char* base = smem + b * 8960;                                                                      \
    f32x4 o0 = f32x4{0.f, 0.f, 0.f, 0.f}, o1 = f32x4{0.f, 0.f, 0.f, 0.f};                                    \
    _Pragma("unroll") for (int ks = 0; ks < 4; ++ks) {                                                       \
      s16x4 qa = *(const s16x4*)(base + fr * 272 + (ks * 32 + 4 * fq) * 2);                                  \
      s16x4 qb = *(const s16x4*)(base + fr * 272 + (ks * 32 + 16 + 4 * fq) * 2);                             \
      s16x8 Af = __builtin_shufflevector(qa, qb, 0, 1, 2, 3, 4, 5, 6, 7);                                    \
      s16x8 B0 = pack8(S[2 * ks][0], S[2 * ks + 1][0]), B1 = pack8(S[2 * ks][1], S[2 * ks + 1][1]);          \
      asm volatile("s_nop 7" : "+v"(B0), "+v"(B1), "+v"(Af));                                                \
      o0 = mfma32(Af, B0, o0);                                                                               \
      o1 = mfma32(Af, B1, o1);                                                                               \
    }                                                                                                        \
    asm volatile("s_nop 15\n\ts_nop 15" : "+v"(o0), "+v"(o1));                                               \
    _Pragma("unroll") for (int j = 0; j < 4; ++j) {                                                          \
      u16* orow = ORAW + (size_t)(tok0 + 4 * fq + j) * 1024 + h * 128 + wave * 32 + fr;                      \
      orow[0] = f2bf(o0[j] + bf2f((u16)co0[j]));                                                             \
      orow[16] = f2bf(o1[j] + bf2f((u16)co1[j]));                                                            \
    }                                                                                                        \
    _Pragma("unroll") for (int mt = 0; mt < 8; ++mt) {                                                       \
      f32x4 d = *(const f32x4*)(base + 8448 + (mt * 16 + 4 * fq) * 4);                                       \
      s16x4 ka = *(const s16x4*)(base + 4352 + (mt * 16 + fr) * 32 + fq * 8);                                \
      f32x4 s0 = S[mt][0] * d, s1 = S[mt][1] * d;                                                            \
      asm volatile("s_nop 7" : "+v"(s0), "+v"(s1), "+v"(ka));                                                \
      S[mt][0] = mfma16(ka, cv0, s0);                                                                        \
      S[mt][1] = mfma16(ka, cv1, s1);                                                                        \
    }                                                                                                        \
    asm volatile("s_nop 15\n\ts_nop 15" : "+v"(S[0][0]), "+v"(S[0][1]), "+v"(S[1][0]), "+v"(S[1][1]), "+v"(S[2][0]), "+v"(S[2][1]), "+v"(S[3][0]), "+v"(S[3][1]), "+v"(S[4][0]), "+v"(S[4][1]), "+v"(S[5][0]), "+v"(S[5][1]), "+v"(S[6][0]), "+v"(S[6][1]), "+v"(S[7][0]), "+v"(S[7][1])); \
    if (c + 1 < NCHK) SEQ_LSTORE(b ^ 1, Y)                                                                   \
    asm volatile("s_waitcnt lgkmcnt(0)\n\ts_barrier" ::: "memory");                                         \
    if (c + 1 < NCHK) { cv0 = Y##rv0; cv1 = Y##rv1; co0 = Y##ro0; co1 = Y##ro1; }                            \
  }
DI void p3_hgrn_seq(const P& p, int job, char* smem) {
  const int tid = threadIdx.x, wave = tid >> 6, lane = tid & 63, fr = lane & 15, fq = lane >> 4;
  const int n = job >> 3, h = job & 7;
  const u16* QT = unitp(p, 1);
  const u16* KTT = (const u16*)((const char*)p.out + OOFF_KTT);
  const float* DEC = (const float*)((const char*)p.out + OOFF_DEC);
  const u16* VT = unitp(p, 3);
  const u16* OIN = unitp(p, 0);
  u16* ORAW = unitp(p, 2);
  f32x4 S[8][2];
#pragma unroll
  for (int mt = 0; mt < 8; ++mt) { S[mt][0] = f32x4{0.f, 0.f, 0.f, 0.f}; S[mt][1] = f32x4{0.f, 0.f, 0.f, 0.f}; }
  const int cg0 = n * NCHK;
  uint4 Arq, Ark, Brq, Brk;
  float4 Ard = make_float4(0.f, 0.f, 0.f, 0.f), Brd = make_float4(0.f, 0.f, 0.f, 0.f);
  s16x4 Arv0, Arv1, Aro0, Aro1, Brv0, Brv1, Bro0, Bro1, cv0, cv1, co0, co1;
  SEQ_GLOAD(cg0, A)
  SEQ_LSTORE(0, A)
  cv0 = Arv0; cv1 = Arv1; co0 = Aro0; co1 = Aro1;
  SEQ_GLOAD(cg0 + 1, B)
  __syncthreads();
  for (int cc = 0; cc < NCHK - 1; cc += 2) {
    SEQ_BODY(cc, A, B)
    SEQ_BODY(cc + 1, B, A)
  }
  SEQ_BODY(NCHK - 1, A, B)
  float* HG = p.out + O_HGP + ((size_t)(n * 8 + h) * 128) * 128;
#pragma unroll
  for (int mt = 0; mt < 8; ++mt)
#pragma unroll
    for (int nt = 0; nt < 2; ++nt)
#pragma unroll
      for (int j = 0; j < 4; ++j) HG[(size_t)(mt * 16 + 4 * fq + j) * 128 + wave * 32 + nt * 16 + fr] = S[mt][nt][j];
}

DI void p3_hgrn_sample(const P& p, int job, char* smem) {
  const int tid = threadIdx.x;
  const int ns = job >> 3, h = job & 7;
  const int v = tid & 127, kh = tid >> 7;
  const u16* R1 = unitp(p, 1);
  const u16* R2 = unitp(p, 2 + 0);
  const u16* VT = unitp(p, 3);
  u16* ORAW = unitp(p, 2);
  const float* LB = (const float*)(p.ws + OFF_LB);
  float* sg = (float*)smem;
  float* skk = sg + 512;
  float* sq = skk + 512;
  float* so = sq + 512;
  const int tokb = TP + ns * 4;
  float fraw[4];
  if (tid < 128) {
    const float lb = LB[h * 128 + tid];
#pragma unroll
    for (int t = 0; t < 4; ++t) {
      size_t gi = (size_t)(tokb + t) * 1024 + h * 128 + tid;
      float f = bf2f(R2[gi]);
      fraw[t] = f;
      float e = __expf(-f);
      sg[t * 128 + tid] = lb + (1.f - lb) / (1.f + e);
      skk[t * 128 + tid] = (1.f - lb) * e / (1.f + e);
      sq[t * 128 + tid] = bf2f(R1[gi]);
    }
  }
  (void)fraw;
  float S[64];
  const float* st = p.state_hgrn + ((size_t)(ns * 8 + h) * 128 + kh * 64) * 128 + v;
#pragma unroll
  for (int i = 0; i < 64; ++i) S[i] = st[(size_t)i * 128];
  float vt[4];
#pragma unroll
  for (int t = 0; t < 4; ++t) {
    int tok = tokb + t;
    vt[t] = bf2f(VT[((size_t)(tok >> 4) * 1024 + h * 128 + v) * 16 + (tok & 15)]);
  }
  __syncthreads();
#pragma unroll
  for (int t = 0; t < 4; ++t) {
    float op = 0.f;
#pragma unroll
    for (int i = 0; i < 64; ++i) {
      int k = t * 128 + kh * 64 + i;
      S[i] = sg[k] * S[i] + skk[k] * vt[t];
      op += sq[k] * S[i];
    }
    so[(t * 2 + kh) * 128 + v] = op;
  }
  float* HG = p.out + O_HGS + ((size_t)(ns * 8 + h) * 128 + kh * 64) * 128 + v;
#pragma unroll
  for (int i = 0; i < 64; ++i) HG[(size_t)i * 128] = S[i];
  __syncthreads();
  if (tid < 128) {
#pragma unroll
    for (int t = 0; t < 4; ++t)
      ORAW[(size_t)(tokb + t) * 1024 + h * 128 + tid] = f2bf(so[(t * 2) * 128 + tid] + so[(t * 2 + 1) * 128 + tid]);
  }
  __syncthreads();
}

DI void p3_s5c(const P& p, int mode, int seq, int c, int gq, char* smem) {
  const int tid = threadIdx.x, wave = tid >> 6, lane = tid & 63, fr = lane & 15, fq = lane >> 4;
  const int g = gq * 4 + wave, pp = lane;
  float br[16], bi[16];
  s5_load_bbar(p, g, pp, br, bi);
  const float2 ab = ((const float2*)(p.ws + OFF_ABAR))[g * 64 + pp];
  float xr, xi;
  int tok0, ntok;
  if (mode == 0) {
    const float2 ap = ((const float2*)(p.ws + OFF_APOW))[g * 64 + pp];
    const float2* E = (const float2*)((const char*)p.out + OOFF_E) + ((size_t)(seq * 43) * 64 + g) * 64 + pp;
    xr = 0.f; xi = 0.f;
    for (int j0 = 0; j0 < c; j0 += 8) {
      float2 e[8];
#pragma unroll
      for (int i = 0; i < 8; ++i) e[i] = E[(size_t)min(j0 + i, c - 1) * 4096];
#pragma unroll
      for (int i = 0; i < 8; ++i)
        if (j0 + i < c) {
          float nr = ap.x * xr - ap.y * xi + e[i].x, ni = ap.x * xi + ap.y * xr + e[i].y;
          xr = nr; xi = ni;
        }
    }
    tok0 = seq * LP + c * 48;
    ntok = 48;
  } else {
    xr = p.ssm_re[((size_t)seq * 64 + g) * 64 + pp];
    xi = p.ssm_im[((size_t)seq * 64 + g) * 64 + pp];
    tok0 = TP + seq * 4;
    ntok = 4;
  }
  s16x8 cf[4];
#pragma unroll
  for (int ks = 0; ks < 4; ++ks) {
    int p0 = ks * 32 + fq * 8;
    const float* src = (p0 < 64 ? p.c_re : p.c_im) + ((size_t)g * 16 + fr) * 64 + (p0 & 63);
    float sgn = p0 < 64 ? 1.f : -1.f;
    float4 a = *(const float4*)src, b = *(const float4*)(src + 4);
    uint4 u = make_uint4(pack2(sgn * a.x, sgn * a.y), pack2(sgn * a.z, sgn * a.w), pack2(sgn * b.x, sgn * b.y),
                         pack2(sgn * b.z, sgn * b.w));
    cf[ks] = __builtin_bit_cast(s16x8, u);
  }
  const float dsk = p.ssm_d[g * 16 + fr];
  u16* U = unitp(p, 5);
  char* xs = smem + wave * 4352;
  const int nsub = (ntok + 15) >> 4;
  uint4 ua, ub;
  {
    const u16* r = U + (size_t)(tok0 + min(pp, ntok - 1)) * 1024 + g * 16;
    ua = *(const uint4*)r;
    ub = *(const uint4*)(r + 8);
  }
  for (int sc = 0; sc < nsub; ++sc) {
    const int tb = tok0 + sc * 16;
    const int nt = min(16, ntok - sc * 16);
#pragma unroll 4
    for (int t = 0; t < 16; ++t) {
      if (t < nt) {
        s5_step(ua, ub, sc * 16 + t, br, bi, ab.x, ab.y, xr, xi);
        *(u16*)(xs + t * 272 + pp * 2) = f2bf(xr);
        *(u16*)(xs + t * 272 + 128 + pp * 2) = f2bf(xi);
      } else {
        *(u16*)(xs + t * 272 + pp * 2) = 0;
        *(u16*)(xs + t * 272 + 128 + pp * 2) = 0;
      }
    }
    __syncthreads();
    f32x4 y = {0.f, 0.f, 0.f, 0.f};
#pragma unroll
    for (int ks = 0; ks < 4; ++ks) {
      s16x8 a = *(const s16x8*)(xs + fr * 272 + ks * 64 + fq * 16);
      y = mfma32(a, cf[ks], y);
    }
    asm volatile("s_nop 15\n\ts_nop 15" : "+v"(y));
#pragma unroll
    for (int j = 0; j < 4; ++j) {
      int t = 4 * fq + j;
      if (t < nt) {
        size_t gi = (size_t)(tb + t) * 1024 + g * 16 + fr;
        float uu = bf2f(U[gi]);
        U[gi] = f2bf(geluf_(y[j] + dsk * uu));
      }
    }
    __syncthreads();
  }
  if (mode == 0) {
    if (c == 42) {
      p.out[O_SRP + ((size_t)seq * 64 + g) * 64 + pp] = xr;
      p.out[O_SIP + ((size_t)seq * 64 + g) * 64 + pp] = xi;
    }
  } else {
    p.out[O_SRS + ((size_t)seq * 64 + g) * 64 + pp] = xr;
    p.out[O_SIS + ((size_t)seq * 64 + g) * 64 + pp] = xi;
  }
}
DI void p3_s5chain(const P& p, int job, char* smem) {
  const int tid = threadIdx.x, wave = tid >> 6, lane = tid & 63, fr = lane & 15, fq = lane >> 4;
  const int n = job >> 4, gq = job & 15;
  const int g = gq * 4 + wave, pp = lane;
  const float2 ab = ((const float2*)(p.ws + OFF_ABAR))[g * 64 + pp];
  s16x4 bb[8];
#pragma unroll
  for (int nt = 0; nt < 8; ++nt) {
    const float4* src = (const float4*)((const float2*)(p.ws + OFF_BBAR) + ((size_t)g * 64 + (nt & 3) * 16 + fr) * 16 + 4 * fq);
    float4 v0 = src[0], v1 = src[1];
    f32x4 sel = (nt < 4) ? f32x4{v0.x, v0.z, v1.x, v1.z} : f32x4{v0.y, v0.w, v1.y, v1.w};
    bb[nt] = pack4(sel);
  }
  s16x8 cf[4];
#pragma unroll
  for (int ks = 0; ks < 4; ++ks) {
    int p0 = ks * 32 + fq * 8;
    const float* src = (p0 < 64 ? p.c_re : p.c_im) + ((size_t)g * 16 + fr) * 64 + (p0 & 63);
    float sgn = p0 < 64 ? 1.f : -1.f;
    float4 a = *(const float4*)src, b = *(const float4*)(src + 4);
    uint4 u = make_uint4(pack2(sgn * a.x, sgn * a.y), pack2(sgn * a.z, sgn * a.w), pack2(sgn * b.x, sgn * b.y),
                         pack2(sgn * b.z, sgn * b.w));
    cf[ks] = __builtin_bit_cast(s16x8, u);
  }
  const float dsk = p.ssm_d[g * 16 + fr];
  u16* U = unitp(p, 5);
  char* xs = smem + wave * 12800;
  float* bu = (float*)(xs + 4352);
  float xr = 0.f, xi = 0.f;
  const int tokb = n * LP;
  s16x4 ua[3], na[3];
  u16 us[3][4], ns[3][4];
#pragma unroll
  for (int sc = 0; sc < 3; ++sc) {
    ua[sc] = *(const s16x4*)(U + (size_t)(tokb + sc * 16 + fr) * 1024 + g * 16 + 4 * fq);
#pragma unroll
    for (int j = 0; j < 4; ++j) us[sc][j] = U[(size_t)(tokb + sc * 16 + 4 * fq + j) * 1024 + g * 16 + fr];
  }
  for (int c = 0; c < 43; ++c) {
#pragma unroll
    for (int sc = 0; sc < 3; ++sc) {
      na[sc] = ua[sc];
#pragma unroll
      for (int j = 0; j < 4; ++j) ns[sc][j] = us[sc][j];
      if (c + 1 < 43) {
        na[sc] = *(const s16x4*)(U + (size_t)(tokb + (c + 1) * 48 + sc * 16 + fr) * 1024 + g * 16 + 4 * fq);
#pragma unroll
        for (int j = 0; j < 4; ++j) ns[sc][j] = U[(size_t)(tokb + (c + 1) * 48 + sc * 16 + 4 * fq + j) * 1024 + g * 16 + fr];
      }
    }
#pragma unroll
    for (int sc = 0; sc < 3; ++sc) {
      const int tb = tokb + c * 48 + sc * 16;
      s16x4 au = ua[sc];
      asm volatile("s_nop 3" : "+v"(au));
      f32x4 r[8];
#pragma unroll
      for (int nt = 0; nt < 8; ++nt) r[nt] = mfma16(au, bb[nt], f32x4{0.f, 0.f, 0.f, 0.f});
      asm volatile("s_nop 15" : "+v"(r[0]), "+v"(r[1]), "+v"(r[2]), "+v"(r[3]), "+v"(r[4]), "+v"(r[5]), "+v"(r[6]), "+v"(r[7]));
#pragma unroll
      for (int nt = 0; nt < 8; ++nt)
#pragma unroll
        for (int j = 0; j < 4; ++j) bu[(4 * fq + j) * 132 + nt * 16 + fr] = r[nt][j];
      __builtin_amdgcn_wave_barrier();
      float bre[16], bim[16];
#pragma unroll
      for (int t = 0; t < 16; ++t) { bre[t] = bu[t * 132 + pp]; bim[t] = bu[t * 132 + 64 + pp]; }
#pragma unroll
      for (int t = 0; t < 16; ++t) {
        float nr = ab.x * xr - ab.y * xi + bre[t], ni = ab.x * xi + ab.y * xr + bim[t];
        xr = nr; xi = ni;
        *(u16*)(xs + t * 272 + pp * 2) = f2bf(xr);
        *(u16*)(xs + t * 272 + 128 + pp * 2) = f2bf(xi);
      }
      __builtin_amdgcn_wave_barrier();
      f32x4 y = {0.f, 0.f, 0.f, 0.f};
#pragma unroll
      for (int ks = 0; ks < 4; ++ks) {
        s16x8 a = *(const s16x8*)(xs + fr * 272 + ks * 64 + fq * 16);
        y = mfma32(a, cf[ks], y);
      }
      asm volatile("s_nop 15\n\ts_nop 15" : "+v"(y));
#pragma unroll
      for (int j = 0; j < 4; ++j) {
        size_t gi = (size_t)(tb + 4 * fq + j) * 1024 + g * 16 + fr;
        U[gi] = f2bf(geluf_(y[j] + dsk * bf2f(us[sc][j])));
      }
    }
#pragma unroll
    for (int sc = 0; sc < 3; ++sc) {
      ua[sc] = na[sc];
#pragma unroll
      for (int j = 0; j < 4; ++j) us[sc][j] = ns[sc][j];
    }
  }
  p.out[O_SRP + ((size_t)n * 64 + g) * 64 + pp] = xr;
  p.out[O_SIP + ((size_t)n * 64 + g) * 64 + pp] = xi;
}
constexpr int NJ3_A = 64, NJ3_CH = 128, NJ3_B = 1024, NJ3_D = 128 * 16;
constexpr int NJ3_REST = NJ3_B + NJ3_D;
DI void phase3rest(const P& p, int job, char* smem) {
  if (job < NJ3_B) p3_hgrn_sample(p, job, smem);
  else { int j = job - NJ3_B; p3_s5c(p, 1, j >> 4, 0, j & 15, smem); }
}

DI void p4_onorm(const P& p, int job) {
  const int lane = threadIdx.x & 63;
  const int tk = job * 4 + (threadIdx.x >> 6);
  u16* O = unitp(p, 2) + (size_t)tk * 1024 + lane * 16;
  const u16* SG = unitp(p, 4) + (size_t)tk * 1024 + lane * 16;
  uint4 a0 = *(const uint4*)O, a1 = *(const uint4*)(O + 8);
  uint4 g0 = *(const uint4*)SG, g1 = *(const uint4*)(SG + 8);
  unsigned ov[8] = {a0.x, a0.y, a0.z, a0.w, a1.x, a1.y, a1.z, a1.w};
  unsigned gv[8] = {g0.x, g0.y, g0.z, g0.w, g1.x, g1.y, g1.z, g1.w};
  float ss = 0.f;
#pragma unroll
  for (int i = 0; i < 8; ++i) { float a = bflo(ov[i]), b = bfhi(ov[i]); ss += a * a + b * b; }
  ss += __shfl_xor(ss, 1);
  ss += __shfl_xor(ss, 2);
  ss += __shfl_xor(ss, 4);
  const float rs = rsqrtf(ss * (1.f / 128.f) + EPS);
  const float* gw = p.g_norm_w + (lane & 7) * 16;
  unsigned r[8];
#pragma unroll
  for (int i = 0; i < 8; ++i) {
    float a = bflo(ov[i]) * rs * gw[2 * i] * bflo(gv[i]);
    float b = bfhi(ov[i]) * rs * gw[2 * i + 1] * bfhi(gv[i]);
    r[i] = pack2(a, b);
  }
  *(uint4*)O = make_uint4(r[0], r[1], r[2], r[3]);
  *(uint4*)(O + 8) = make_uint4(r[4], r[5], r[6], r[7]);
}
DI void p4_glu(const P& p, int job, char* smem) {
  const int pm = job >> 3, pn = job & 7;
  const int brow = pm * 128, bcol = pn * 128;
  f32x4 acc[4][4];
  ZERO_ACC(acc);
  const u16* Y = unitp(p, 5);
  gemm_core(Y, 1024, (const u16*)(p.ws + OFF_WTGLU), 1024, 1024, brow, bcol, smem, acc);
  EPI_VARS;
  u16* Z = unitp(p, 1);
  EPI_BASE(1024, brow, bcol);
  EPI_LOOP {
    float bb = p.b_glu[bcol + wc * 64 + n * 16 + fr];
#pragma unroll
    for (int j = 0; j < 4; ++j) {
      int gi = idx0 + (m * 16 + j) * 1024 + n * 16;
      Z[gi] = f2bf(bf2f(Y[gi]) * sigmoidf_(acc[m][n][j] + bb));
    }
  }
}
constexpr int NJ4_A = T / 4, NJ4 = NJ4_A + 133 * 8;

DI void phase5(const P& p, int job, char* smem, const int mode, unsigned* flag) {
  const int pm = job >> 3, pn = job & 7;
  const int brow = pm * 128, bcol = pn * 128;
  EPI_VARS;
  u16* MX = unitp(p, 3);
#pragma unroll 1
  for (int pass = (mode == 2 ? 1 : 0); pass < (mode == 1 ? 1 : 2); ++pass) {
    f32x4 acc[4][4];
    ZERO_ACC(acc);
    gemm_core(unitp(p, pass ? 1 : 2), 1024, (const u16*)(p.ws + (pass ? OFF_WTB : OFF_WTA)), 1024, 1024, brow, bcol,
              smem, acc);
    if (mode == 2) {
      if (tid == 0) {
        while (__hip_atomic_load(flag, __ATOMIC_RELAXED, __HIP_MEMORY_SCOPE_AGENT) == 0u) __builtin_amdgcn_s_sleep(1);
        __builtin_amdgcn_fence(__ATOMIC_ACQUIRE, "agent");
        asm volatile("s_waitcnt vmcnt(0)" ::: "memory");
      }
      __syncthreads();
    }
    const u16* GT = unitp(p, 6 + pass);
    EPI_BASE(1024, brow, bcol);
    EPI_LOOP {
#pragma unroll
      for (int j = 0; j < 4; ++j) {
        int gi = idx0 + (m * 16 + j) * 1024 + n * 16;
        float prev = pass ? bf2f(MX[gi]) : 0.f;
        MX[gi] = f2bf(prev + acc[m][n][j] * bf2f(GT[gi]));
      }
    }
    if (mode == 1) {
      asm volatile("s_waitcnt vmcnt(0)" ::: "memory");
      __syncthreads();
      if (tid == 0) {
        __builtin_amdgcn_fence(__ATOMIC_RELEASE, "agent");
        asm volatile("s_waitcnt vmcnt(0)" ::: "memory");
        __hip_atomic_store(flag, 1u, __ATOMIC_RELAXED, __HIP_MEMORY_SCOPE_AGENT);
      }
    }
  }
}
constexpr int NJ5 = 133 * 8;

DI void phase6(const P& p, int job, char* smem) {
  const int pm = job >> 3, pn = job & 7;
  const int brow = pm * 128, bcol = pn * 128;
  EPI_VARS;
  f32x4 acc[4][4];
  ZERO_ACC(acc);
  gemm_core(unitp(p, 3), 1024, (const u16*)(p.ws + OFF_WTOUT), 1024, 1024, brow, bcol, smem, acc);
  float* X1 = (float*)unitp(p, 0);
  int rb = brow + wr * 64 + fq * 4, cbv = bcol + wc * 64 + fr;
  asm volatile("" : "+v"(rb), "+v"(cbv));
#pragma unroll
  for (int m = 0; m < 4; ++m) {
#pragma unroll
    for (int j = 0; j < 4; ++j) {
      const int row = rb + m * 16 + j;
      const float* xr = xrow(p, row) + cbv;
      float* xo = X1 + (size_t)row * 1024 + cbv;
#pragma unroll
      for (int n = 0; n < 4; ++n) xo[n * 16] = xr[n * 16] + acc[m][n][j];
    }
  }
}
constexpr int NJ6 = 133 * 8;

DI void phase7(const P& p, int job) {
  int tk = job * 4 + (threadIdx.x >> 6);
  rms_row_to_bf16((const float*)unitp(p, 0) + (size_t)tk * 1024, p.norm2_w, unitp(p, 2) + (size_t)tk * 1024,
                  threadIdx.x & 63);
}
constexpr int NJ7 = T / 4;
DI void convert_tables(const P& p, int j) {
  const float* src = (j < 4096 ? p.peer_u : p.peer_v) + (size_t)(j & 4095) * 4096 + threadIdx.x * 16;
  const float sc = j < 4096 ? 64.f : 16.f;
  unsigned char* dst = (j < 4096 ? (unsigned char*)(p.ws + OFF_UT8) + (size_t)j * 4096
                                 : (unsigned char*)unitp(p, 6) + (size_t)(j - 4096) * 4096) + threadIdx.x * 16;
  unsigned w[4];
#pragma unroll
  for (int i = 0; i < 4; ++i) {
    float4 a = *(const float4*)(src + 4 * i);
    int d = __builtin_amdgcn_cvt_pk_fp8_f32(a.x * sc, a.y * sc, 0, false);
    d = __builtin_amdgcn_cvt_pk_fp8_f32(a.z * sc, a.w * sc, d, true);
    w[i] = (unsigned)d;
  }
  *(uint4*)dst = make_uint4(w[0], w[1], w[2], w[3]);
}

DI void phase8(const P& p, int job, char* smem) {
  const int pm = job >> 4, pn = job & 15;
  const int brow = pm * 128, bcol = pn * 128;
  EPI_VARS;
  f32x4 acc[4][4];
  ZERO_ACC(acc);
  gemm_core(unitp(p, 2), 1024, (const u16*)(p.ws + OFF_WTQ), 1024, 1024, brow, bcol, smem, acc);
  u16* Q = unitp(p, 3);
  EPI_BASE(2048, brow, bcol);
  EPI_LOOP {
#pragma unroll
    for (int j = 0; j < 4; ++j) Q[idx0 + (m * 16 + j) * 2048 + n * 16] = f2bf(acc[m][n][j]);
  }
}
constexpr int NJ8 = 133 * 16;

DI int f2key(float f) { int s = __float_as_int(f); return s ^ ((s >> 31) & 0x7fffffff); }
DI float key2f(int k) { return __int_as_float(k ^ ((k >> 31) & 0x7fffffff)); }
DI int rowmax16(int x) {
  x = max(x, __builtin_amdgcn_update_dpp(0, x, 0x128, 0xf, 0xf, false));
  x = max(x, __builtin_amdgcn_update_dpp(0, x, 0x124, 0xf, 0xf, false));
  x = max(x, __builtin_amdgcn_update_dpp(0, x, 0x122, 0xf, 0xf, false));
  x = max(x, __builtin_amdgcn_update_dpp(0, x, 0x121, 0xf, 0xf, false));
  return x;
}
DI void phase9(const P& p, int job) {
  const int tid = threadIdx.x, wave = tid >> 6, lane = tid & 63, fr = lane & 15, fq = lane >> 4;
  const int tile = job >> 1, h = (job & 1) * 4 + wave;
  const int tok0 = tile * 16;
  const u16* QRY = unitp(p, 3);
  int* EXPI = (int*)unitp(p, 5);
  float* GATE = (float*)((char*)unitp(p, 5) + (size_t)T * 128 * 4);
  float v12[2][4];
  int i12[2][4];
#pragma unroll
  for (int half = 0; half < 2; ++half) {
    f32x4 acc[8];
#pragma unroll
    for (int nt = 0; nt < 8; ++nt) acc[nt] = f32x4{0.f, 0.f, 0.f, 0.f};
    const u16* Kb = (const u16*)(p.ws + (half ? OFF_K2 : OFF_K1)) + (size_t)h * 128 * 128;
#pragma unroll
    for (int ks = 0; ks < 4; ++ks) {
      s16x8 a = *(const s16x8*)(QRY + (size_t)(tok0 + fr) * 2048 + h * 256 + half * 128 + ks * 32 + fq * 8);
#pragma unroll
      for (int nt = 0; nt < 8; ++nt) {
        s16x8 b = *(const s16x8*)(Kb + (size_t)(nt * 16 + fr) * 128 + ks * 32 + fq * 8);
        acc[nt] = mfma32(a, b, acc[nt]);
      }
    }
    asm volatile("s_nop 15\n\ts_nop 15" : "+v"(acc[0]), "+v"(acc[1]), "+v"(acc[2]), "+v"(acc[3]), "+v"(acc[4]), "+v"(acc[5]), "+v"(acc[6]), "+v"(acc[7]));
#pragma unroll
    for (int j = 0; j < 4; ++j) {
      int keys[8];
#pragma unroll
      for (int nt = 0; nt < 8; ++nt) keys[nt] = (f2key(acc[nt][j]) & ~127) | (127 - (nt * 16 + fr));
#define CX(a, b) { int hi_ = max(keys[a], keys[b]), lo_ = min(keys[a], keys[b]); keys[a] = hi_; keys[b] = lo_; }
      CX(0, 1) CX(2, 3) CX(4, 5) CX(6, 7)
      CX(0, 2) CX(1, 3) CX(4, 6) CX(5, 7)
      CX(1, 2) CX(5, 6)
      CX(0, 4) CX(1, 5) CX(2, 6) CX(3, 7)
      CX(2, 4) CX(3, 5)
      CX(1, 2) CX(3, 4) CX(5, 6)
#undef CX
      int mine = 0;
      for (int r = 0; r < 16; ++r) {
        int wk = rowmax16(keys[0]);
        if (fr == r) mine = wk;
        if (keys[0] == wk) {
#pragma unroll
          for (int nt = 0; nt < 7; ++nt) keys[nt] = keys[nt + 1];
          keys[7] = (int)0x80000000;
        }
      }
      v12[half][j] = key2f(mine & ~127);
      i12[half][j] = 127 - (mine & 127);
    }
  }
#pragma unroll
  for (int j = 0; j < 4; ++j) {
    const float v1 = v12[0][j], v2 = v12[1][j];
    const int e1 = i12[0][j], e2 = i12[1][j];
    int ptr = 0;
    float sc = 0.f;
    int ex = 0;
    const int gbase = lane & ~15;
    for (int r = 0; r < 16; ++r) {
      int pc = min(ptr, 15);
      float v2p = __shfl(v2, gbase + pc);
      int e2p = __shfl(e2, gbase + pc);
      int key = ptr < 16 ? ((f2key(v1 + v2p) & ~255) | (255 - (fr * 16 + ptr))) : (int)0x80000000;
      int wk = rowmax16(key);
      int pos = 255 - (wk & 255);
      int wi = pos >> 4;
      int myexp = e1 * 128 + e2p;
      int wexp = __shfl(myexp, gbase + wi);
      if (fr == r) { sc = key2f(wk & ~255); ex = wexp; }
      if (fr == wi) ptr++;
    }
    float mx = sc;
    mx = fmaxf(mx, __shfl_xor(mx, 1));
    mx = fmaxf(mx, __shfl_xor(mx, 2));
    mx = fmaxf(mx, __shfl_xor(mx, 4));
    mx = fmaxf(mx, __shfl_xor(mx, 8));
    float e = __expf(sc - mx);
    float sm = e;
    sm += __shfl_xor(sm, 1);
    sm += __shfl_xor(sm, 2);
    sm += __shfl_xor(sm, 4);
    sm += __shfl_xor(sm, 8);
    size_t oi = (size_t)(tok0 + 4 * fq + j) * 128 + h * 16 + fr;
    EXPI[oi] = ex;
    GATE[oi] = e / sm;
  }
}
constexpr int NJ9 = 1064 * 2;

typedef float f32x2v __attribute__((ext_vector_type(2)));
DI void unpack16(const uint4& a, float (&x)[16]) {
  const unsigned w[4] = {a.x, a.y, a.z, a.w};
#pragma unroll
  for (int i = 0; i < 4; ++i) {
    f32x2v lo = __builtin_amdgcn_cvt_pk_f32_fp8((int)w[i], false);
    f32x2v hi = __builtin_amdgcn_cvt_pk_f32_fp8((int)w[i], true);
    x[4 * i] = lo[0]; x[4 * i + 1] = lo[1]; x[4 * i + 2] = hi[0]; x[4 * i + 3] = hi[1];
  }
}
#define LANE_OF(k) ((((k) >> 3) & 1) * 32 + (((k) >> 2) & 1) * 16 + (((k) >> 1) & 1) * 8 + ((k)&1) * 4)
DI void phase10(const P& p, int job) {
  const int lane = threadIdx.x & 63;
  const int tk = job * 4 + (threadIdx.x >> 6);
  float* dst;
  if (tk < TP) {
    int n = tk / LP, l = tk - n * LP;
    if (l < 16) return;
    dst = p.out + O_YP + ((size_t)n * 2048 + (l - 16)) * 1024;
  } else {
    dst = p.out + O_YS + (size_t)(tk - TP) * 1024;
  }
  const float* X1 = (const float*)unitp(p, 0) + (size_t)tk * 1024;
  const u16* H2 = unitp(p, 2) + (size_t)tk * 1024;
  const int* EXPI = (const int*)unitp(p, 5) + (size_t)tk * 128;
  const float* GATE = (const float*)((const char*)unitp(p, 5) + (size_t)T * 128 * 4) + (size_t)tk * 128;
  const unsigned char* UT = (const unsigned char*)(p.ws + OFF_UT8);
  const unsigned char* VTB = (const unsigned char*)unitp(p, 6);
  float hv[16];
  {
    uint4 a = *(const uint4*)(H2 + lane * 16), b = *(const uint4*)(H2 + lane * 16 + 8);
    hv[0] = bflo(a.x); hv[1] = bfhi(a.x); hv[2] = bflo(a.y); hv[3] = bfhi(a.y);
    hv[4] = bflo(a.z); hv[5] = bfhi(a.z); hv[6] = bflo(a.w); hv[7] = bfhi(a.w);
    hv[8] = bflo(b.x); hv[9] = bfhi(b.x); hv[10] = bflo(b.y); hv[11] = bfhi(b.y);
    hv[12] = bflo(b.z); hv[13] = bfhi(b.z); hv[14] = bflo(b.w); hv[15] = bfhi(b.w);
  }
  float ov[16];
#pragma unroll
  for (int i = 0; i < 16; ++i) ov[i] = 0.f;
  const int kmine = ((lane >> 5) & 1) * 8 + ((lane >> 4) & 1) * 4 + ((lane >> 3) & 1) * 2 + ((lane >> 2) & 1);
  const bool b5 = lane & 32, b4 = lane & 16, b3 = lane & 8, b2 = lane & 4;
  for (int h = 0; h < 8; ++h) {
    const int e_l = EXPI[h * 16 + kmine];
    const float g_l = GATE[h * 16 + kmine];
    float part[16];
#pragma unroll
    for (int k = 0; k < 16; ++k) {
      int e = __builtin_amdgcn_readlane(e_l, LANE_OF(k));
      uint4 a = *(const uint4*)(UT + (size_t)e * 1024 + lane * 16);
      float x[16];
      unpack16(a, x);
      float d = 0.f;
#pragma unroll
      for (int i = 0; i < 16; ++i) d += x[i] * hv[i];
      part[k] = d;
    }
    float r8[8], r4[4], r2[2];
#pragma unroll
    for (int i = 0; i < 8; ++i) {
      float send = b5 ? part[i] : part[i + 8], keep = b5 ? part[i + 8] : part[i];
      r8[i] = keep + __shfl_xor(send, 32);
    }
#pragma unroll
    for (int i = 0; i < 4; ++i) {
      float send = b4 ? r8[i] : r8[i + 4], keep = b4 ? r8[i + 4] : r8[i];
      r4[i] = keep + __shfl_xor(send, 16);
    }
#pragma unroll
    for (int i = 0; i < 2; ++i) {
      float send = b3 ? r4[i] : r4[i + 2], keep = b3 ? r4[i + 2] : r4[i];
      r2[i] = keep + __shfl_xor(send, 8);
    }
    float d;
    {
      float send = b2 ? r2[0] : r2[1], keep = b2 ? r2[1] : r2[0];
      d = keep + __shfl_xor(send, 4);
    }
    d += __shfl_xor(d, 2);
    d += __shfl_xor(d, 1);
    const float w_l = g_l * geluf_(d * (1.f / 64.f)) * (1.f / 16.f);
#pragma unroll
    for (int k = 0; k < 16; ++k) {
      int e = __builtin_amdgcn_readlane(e_l, LANE_OF(k));
      float w = __builtin_bit_cast(float, __builtin_amdgcn_readlane(__builtin_bit_cast(int, w_l), LANE_OF(k)));
      uint4 a = *(const uint4*)(VTB + (size_t)e * 1024 + lane * 16);
      float x[16];
      unpack16(a, x);
#pragma unroll
      for (int i = 0; i < 16; ++i) ov[i] += w * x[i];
    }
  }
  float ss = 0.f;
#pragma unroll
  for (int i = 0; i < 4; ++i) {
    float4 x = *(const float4*)(X1 + lane * 16 + i * 4);
    ov[4 * i] += x.x; ov[4 * i + 1] += x.y; ov[4 * i + 2] += x.z; ov[4 * i + 3] += x.w;
    ss += ov[4 * i] * ov[4 * i] + ov[4 * i + 1] * ov[4 * i + 1] + ov[4 * i + 2] * ov[4 * i + 2] + ov[4 * i + 3] * ov[4 * i + 3];
  }
  ss = wave_sum(ss);
  const float rs = rsqrtf(ss * (1.f / 1024.f) + EPS);
#pragma unroll
  for (int i = 0; i < 4; ++i) {
    int eo = lane * 16 + i * 4;
    float4 w = *(const float4*)(p.final_w + eo);
    *(float4*)(dst + eo) =
        make_float4(ov[4 * i] * rs * w.x, ov[4 * i + 1] * rs * w.y, ov[4 * i + 2] * rs * w.z, ov[4 * i + 3] * rs * w.w);
  }
}
constexpr int NJ10 = T / 4;


#define XB_TMO      128
#define XB_XCNT(j)  (256  + 64 * (j))
#define XB_XSUB(j)  (1280 + 64 * (j))
#define XB_XGEN(j)  (2304 + 64 * (j))
#define XB_TOP      3328
#define XB_TOPGEN   3392
#define XCD_BAR_WORDS 3456
#define XB_SPIN_CAP (1u << 18)
#define LAS __attribute__((address_space(3)))

__device__ __forceinline__ unsigned xb_ld(unsigned* p)              { return __hip_atomic_load(p, __ATOMIC_RELAXED, __HIP_MEMORY_SCOPE_AGENT); }
__device__ __forceinline__ unsigned xb_add(unsigned* p, unsigned v) { return __hip_atomic_fetch_add(p, v, __ATOMIC_RELAXED, __HIP_MEMORY_SCOPE_AGENT); }
__device__ __forceinline__ unsigned xb_xcc_id() { return (unsigned)__builtin_amdgcn_s_getreg((3 << 11) | 20) & 0xFu; }
#define XB_SPIN(cond, bar) do { unsigned _sp = 0; while (cond) { __builtin_amdgcn_s_sleep(1); \
    if ((++_sp & 255u) == 0u) { if (xb_ld(&(bar)[XB_TMO])) break; if (_sp > XB_SPIN_CAP) { atomicAdd(&(bar)[XB_TMO], 1u); break; } } } } while (0)

struct XcdBarrier {
    unsigned* bar; unsigned x;
    volatile LAS unsigned* st;
};

__device__ __forceinline__ XcdBarrier xcd_barrier_post(unsigned* bar, volatile LAS unsigned* st) {
    XcdBarrier b; b.bar = bar; b.x = xb_xcc_id(); b.st = st;
    if (threadIdx.x == 0) (void)xb_add(&bar[XB_XCNT(b.x)], 1u);
    return b;
}
__device__ __forceinline__ void xcd_barrier_complete(unsigned* bar, unsigned x, unsigned& nloc, unsigned& nx) {
    const unsigned G = gridDim.x * gridDim.y * gridDim.z;
    unsigned sum, cnt, mine, sp = 0u;
    for (;;) {
        sum = 0u; cnt = 0u; mine = 0u;
#pragma unroll
        for (unsigned j = 0; j < 16; ++j) { const unsigned c = xb_ld(&bar[XB_XCNT(j)]); sum += c; cnt += (c > 0u) ? 1u : 0u; mine = (j == x) ? c : mine; }
        if (sum == G) break;
        __builtin_amdgcn_s_sleep(1);
        if ((++sp & 255u) == 0u) { if (xb_ld(&bar[XB_TMO])) break; if (sp > XB_SPIN_CAP) { atomicAdd(&bar[XB_TMO], 1u); break; } }
    }
    nloc = mine > 0u ? mine : 1u; nx = cnt > 0u ? cnt : 1u;
}

__device__ __forceinline__ void xcd_barrier(const XcdBarrier& b) {
    asm volatile("s_waitcnt vmcnt(0)" ::: "memory");
    __syncthreads();
    if (threadIdx.x == 0) {
        unsigned* bar = b.bar;
        __builtin_amdgcn_s_waitcnt(0);
        unsigned nloc = b.st[0], nx = b.st[1];
        if (nloc == 0u) { xcd_barrier_complete(bar, b.x, nloc, nx); b.st[0] = nloc; b.st[1] = nx; }
        const unsigned old = xb_add(&bar[XB_XSUB(b.x)], 1u);
        const unsigned gen = old / nloc;
        if (old + 1u == (gen + 1u) * nloc) {
            __builtin_amdgcn_fence(__ATOMIC_RELEASE, "agent");
            asm volatile("s_waitcnt vmcnt(0)" ::: "memory");
            const unsigned og = xb_add(&bar[XB_TOP], 1u);
            const unsigned tg = og / nx;
            if (og + 1u == (tg + 1u) * nx) xb_add(&bar[XB_TOPGEN], 1u);
            else XB_SPIN(xb_ld(&bar[XB_TOPGEN]) == tg, bar);
            __builtin_amdgcn_fence(__ATOMIC_ACQUIRE, "agent");
            xb_add(&bar[XB_XGEN(b.x)], 1u);
            asm volatile("s_waitcnt vmcnt(0)" ::: "memory");
        } else {
            XB_SPIN(xb_ld(&bar[XB_XGEN(b.x)]) == gen, bar);
            __builtin_amdgcn_fence(__ATOMIC_ACQUIRE, "agent");
            asm volatile("s_waitcnt vmcnt(0)" ::: "memory");
        }
    }
    __syncthreads();
}


DI void my_sync(unsigned* bar, unsigned target) {
  asm volatile("s_waitcnt vmcnt(0)" ::: "memory");
  __syncthreads();
  if (threadIdx.x == 0) {
    __builtin_amdgcn_fence(__ATOMIC_RELEASE, "agent");
    asm volatile("s_waitcnt vmcnt(0)" ::: "memory");
    __hip_atomic_fetch_add(bar, 1u, __ATOMIC_RELAXED, __HIP_MEMORY_SCOPE_AGENT);
    while (__hip_atomic_load(bar, __ATOMIC_RELAXED, __HIP_MEMORY_SCOPE_AGENT) < target) __builtin_amdgcn_s_sleep(2);
    __builtin_amdgcn_fence(__ATOMIC_ACQUIRE, "agent");
    asm volatile("s_waitcnt vmcnt(0)" ::: "memory");
  }
  __syncthreads();
}
__global__ void __launch_bounds__(256, 2) mega(P p, int ph_lo, int ph_hi) {
  __shared__ __attribute__((aligned(16))) char smem[SMEM_BYTES];
  cg::grid_group grid = cg::this_grid();
  const int G = gridDim.x, B = blockIdx.x;
#define RUN_PHASE(n) if ((ONLY < 0 || ONLY == n) && ph_lo <= n && n < ph_hi)
  __shared__ uint4 xb_words;
  if (threadIdx.x == 0) xb_words = make_uint4(0u, 0u, 0u, 0u);
  __syncthreads();
  XcdBarrier xb = xcd_barrier_post((unsigned*)(p.ws + OFF_BAR), (volatile LAS unsigned*)&xb_words);
  if (ph_hi > 1000) grid.sync();
#define SYNC_IF(n) if (n > ph_lo) { xcd_barrier(xb); }
  RUN_PHASE(0) {
    for (int j = B; j < NJ0 - 1536; j += G) phase0(p, j < 1792 ? j : j + 1536, smem); }
  RUN_PHASE(1) { SYNC_IF(1) for (int j = B; j < NJ1; j += G) phase1(p, j, smem); }
  RUN_PHASE(2) { SYNC_IF(2)
    for (int j = B; j < NJ2_H; j += G) p2_hgrn_pre(p, j, smem); }
  RUN_PHASE(3) { SYNC_IF(3)
    if (B < NJ3_A) p3_hgrn_seq(p, B, smem);
    else if (B < NJ3_A + NJ3_CH) p3_s5chain(p, B - NJ3_A, smem);
    else for (int j = B - (NJ3_A + NJ3_CH); j < NJ3_REST + 1536; j += G - (NJ3_A + NJ3_CH)) {
      if (j < NJ3_REST) phase3rest(p, j, smem); else phase0(p, 1792 + (j - NJ3_REST), smem); } }
  RUN_PHASE(4) { SYNC_IF(4)
    for (int j = B; j < 1064; j += G) p4_glu(p, j, smem);
    { const int extra = 1064 % G;
      if (B >= extra) for (int j = B - extra; j < NJ4_A; j += G - extra) p4_onorm(p, j); } }
  RUN_PHASE(5) { SYNC_IF(5)
    { const int nfull = (NJ5 / G) * G, L = NJ5 - nfull;
      unsigned* fl = (unsigned*)(p.ws + OFF_BAR + 16384);
      for (int j = B; j < nfull; j += G) phase5(p, j, smem, 0, fl);
      if (B < L) phase5(p, nfull + B, smem, 1, fl + B);
      else if (B < 2 * L) phase5(p, nfull + B - L, smem, 2, fl + (B - L));
      else for (int j = B - 2 * L; j < 4096; j += G - 2 * L) convert_tables(p, j); } }
  RUN_PHASE(6) { SYNC_IF(6) for (int j = B; j < NJ6; j += G) phase6(p, j, smem);
    { const int extra = NJ6 % G;
      if (B >= extra) for (int j = 4096 + B - extra; j < 8192; j += G - extra) convert_tables(p, j); } }
  RUN_PHASE(7) { SYNC_IF(7) for (int j = B; j < NJ7; j += G) phase7(p, j); }
  RUN_PHASE(8) { SYNC_IF(8) for (int j = B; j < NJ8; j += G) phase8(p, j, smem); }
  RUN_PHASE(9) { SYNC_IF(9) for (int j = B; j < NJ9; j += G) phase9(p, j); }
  RUN_PHASE(10) { SYNC_IF(10) for (int j = B; j < NJ10; j += G) phase10(p, j); }
}

extern "C" void kernel_launch(void* const* d_in, const int* in_sizes, int n_in, void* d_out, int out_size, void* d_ws,
                              size_t ws_size, hipStream_t stream) {
  static int grid_blocks = 0;
  if (!grid_blocks) {
    int dev = 0, cus = 0, per_cu = 0;
    hipGetDevice(&dev);
    hipDeviceGetAttribute(&cus, hipDeviceAttributeMultiprocessorCount, dev);
    hipOccupancyMaxActiveBlocksPerMultiprocessor(&per_cu, mega, 256, 0);
    if (per_cu < 1) per_cu = 1;
    grid_blocks = cus * per_cu;
  }
  P p{};
  const float** pf = (const float**)&p;
  for (int i = 0; i < 30; ++i) pf[i] = (const float*)d_in[i];
  p.out = (float*)d_out;
  p.ws = (char*)d_ws;
#if SINGLE_LAUNCH
  hipMemsetAsync((char*)d_ws + OFF_BAR, 0, 16384 + 1024, stream);
  int lo = 0, hi = 11;
  void* args[] = {&p, &lo, &hi};
  hipError_t e = hipLaunchCooperativeKernel((void*)mega, dim3(grid_blocks), dim3(256), args, 0, stream);
  if (e != hipSuccess) fprintf(stderr, "cooperative launch failed: %s (grid %d)\n", hipGetErrorString(e), grid_blocks);
#else
  for (int ph = 0; ph < 11; ++ph) hipLaunchKernelGGL(mega, dim3(grid_blocks), dim3(256), 0, stream, p, ph, ph + 1);
#endif
}
```
